# Optimizing an MI355X kernel written in HIP

```python
import math
import jax, jax.numpy as jnp
from jax import lax
import numpy as np

D_MODEL = 1024
BATCH = 16
SEQ = 2048
DEPTH = 4

GRID_W = 64
CTX_LEN = 256
HEAD_DIM = 64
ROPE_BASE = 10000.0
EPS = 1e-6
Q_BLOCK = 128
N_MOD = 6
D_FF = 4 * D_MODEL
N_EVEN = (DEPTH + 1) // 2
N_ODD = DEPTH // 2

GQA_Q_HEADS = 12
GQA_KV_HEADS = 4
GQA_GROUP = GQA_Q_HEADS // GQA_KV_HEADS
GQA_Q_W = GQA_Q_HEADS * HEAD_DIM
GQA_KV_W = GQA_KV_HEADS * HEAD_DIM
SSM_WIDTH = 256
SSM_GROUP = 16
SSM_GROUPS = SSM_WIDTH // SSM_GROUP
SSM_STATE = 64
SSM_DT_MIN = 0.001
SSM_DT_MAX = 0.1
EVEN_IN_W = GQA_Q_W + 2 * GQA_KV_W + SSM_WIDTH
EVEN_MIX_W = GQA_Q_W + SSM_WIDTH

MLA_HEADS = 8
MLA_Q_RANK = 512
MLA_KV_RANK = 256
MLA_NOPE = 64
MLA_ROPE = 32
MLA_QK = MLA_NOPE + MLA_ROPE
MLA_V = 64
NA_HEADS = 8
NA_W = NA_HEADS * HEAD_DIM
NA_WIN_R = 8
NA_WIN_C = 16
ODD_IN_W = MLA_Q_RANK + MLA_KV_RANK + MLA_ROPE + 3 * NA_W
ODD_MIX_W = MLA_HEADS * MLA_V + NA_W

kernel_name = 'hybrid_diffusion_gqa_s5_mla_natten'


def rms_norm(x, g):
    xf = x.astype(jnp.float32)
    y = xf * lax.rsqrt(jnp.mean(jnp.square(xf), axis=-1, keepdims=True) + EPS)
    return (y * g.astype(jnp.float32)).astype(x.dtype)


def modulate(x, g, shift, scale):
    return rms_norm(x, g) * (1 + scale) + shift


def axial_rope_tables(n_tokens, rot_dim):
    t = jnp.arange(n_tokens)
    rows = (t // GRID_W).astype(jnp.float32)
    cols = (t % GRID_W).astype(jnp.float32)
    axis_dim = rot_dim // 2
    freqs = ROPE_BASE ** (-jnp.arange(0, axis_dim, 2, dtype=jnp.float32) / axis_dim)
    ang_r = rows[:, None] * freqs
    ang_c = cols[:, None] * freqs
    ang = jnp.concatenate([ang_r, ang_r, ang_c, ang_c], axis=-1)
    return jnp.cos(ang), jnp.sin(ang)


def apply_axial_rope(x, cos, sin):
    xf = x.astype(jnp.float32)
    x1, x2, x3, x4 = jnp.split(xf, 4, axis=-1)
    rot = jnp.concatenate([-x2, x1, -x4, x3], axis=-1)
    return (xf * cos[:, None, :] + rot * sin[:, None, :]).astype(x.dtype)


def blocked_attention(q, k, v, scale):
    b, n = q.shape[:2]
    nb = n // Q_BLOCK
    qb = jnp.swapaxes(q.reshape((b, nb, Q_BLOCK) + q.shape[2:]), 0, 1)

    def one_block(qblk):
        s = jnp.einsum('bqkgd,bskd->bkgqs', qblk, k, preferred_element_type=jnp.float32) * scale
        p = jax.nn.softmax(s, axis=-1).astype(v.dtype)
        return jnp.einsum('bkgqs,bskd->bqkgd', p, v)

    out = lax.map(one_block, qb)
    return jnp.swapaxes(out, 0, 1).reshape((b, n) + out.shape[3:])


def s5_discretize(lam_re, lam_im, log_dt, b_re, b_im):
    f32 = jnp.float32
    lam_re, lam_im = lam_re.astype(f32), lam_im.astype(f32)
    dt = jnp.exp(log_dt.astype(f32))[:, None]
    mag = jnp.exp(lam_re * dt)
    a_re = mag * jnp.cos(lam_im * dt)
    a_im = mag * jnp.sin(lam_im * dt)
    den = jnp.square(lam_re) + jnp.square(lam_im)
    f_re = ((a_re - 1.0) * lam_re + a_im * lam_im) / den
    f_im = (a_im * lam_re - (a_re - 1.0) * lam_im) / den
    b_re, b_im = b_re.astype(f32), b_im.astype(f32)
    bb_re = f_re[..., None] * b_re - f_im[..., None] * b_im
    bb_im = f_re[..., None] * b_im + f_im[..., None] * b_re
    return a_re, a_im, bb_re, bb_im


def _complex_affine_combine(e1, e2):
    a1r, a1i, b1r, b1i = e1
    a2r, a2i, b2r, b2i = e2
    return (a2r * a1r - a2i * a1i, a2r * a1i + a2i * a1r,
            a2r * b1r - a2i * b1i + b2r, a2r * b1i + a2i * b1r + b2i)


def s5_scan(u, a_re, a_im, bb_re, bb_im, h0=None):
    n = u.shape[1]
    bu_re = jnp.einsum('bngp,gsp->bngs', u, bb_re)
    bu_im = jnp.einsum('bngp,gsp->bngs', u, bb_im)
    shape = (1, n) + a_re.shape
    ar = jnp.broadcast_to(a_re, shape)
    ai = jnp.broadcast_to(a_im, shape)
    p_re, p_im, h_re, h_im = lax.associative_scan(_complex_affine_combine, (ar, ai, bu_re, bu_im), axis=1)
    if h0 is not None:
        h0_re, h0_im = h0[0][:, None], h0[1][:, None]
        h_re = h_re + p_re * h0_re - p_im * h0_im
        h_im = h_im + p_re * h0_im + p_im * h0_re
    return h_re, h_im


def s5_readout(h_re, h_im, c_re, c_im):
    return jnp.einsum('bngs,gps->bngp', h_re, c_re) - jnp.einsum('bngs,gps->bngp', h_im, c_im)


def maybe_flip(t, d):
    return t[:, ::-1] if d == 1 else t


def s5_mixer(u_lat, u_ctx, lam_re, lam_im, log_dt, b_re, b_im, c_re, c_im, d_skip, w_glu, b_glu, need_ctx):
    f32 = jnp.float32
    out_dtype = u_lat.dtype

    def grouped(u):
        return u.astype(f32).reshape(u.shape[:2] + (SSM_GROUPS, SSM_GROUP))

    ul, uc = grouped(u_lat), grouped(u_ctx)
    d_g = d_skip.astype(f32).reshape(SSM_GROUPS, SSM_GROUP)
    y_lat = d_g * ul
    y_ctx = d_g * uc if need_ctx else None
    for d in range(2):
        a_re, a_im, bb_re, bb_im = s5_discretize(lam_re[d], lam_im[d], log_dt[d], b_re[d], b_im[d])
        cr, ci = c_re[d].astype(f32), c_im[d].astype(f32)
        hc_re, hc_im = s5_scan(maybe_flip(uc, d), a_re, a_im, bb_re, bb_im)
        hl_re, hl_im = s5_scan(maybe_flip(ul, d), a_re, a_im, bb_re, bb_im, h0=(hc_re[:, -1], hc_im[:, -1]))
        y_lat = y_lat + maybe_flip(s5_readout(hl_re, hl_im, cr, ci), d)
        if need_ctx:
            y_ctx = y_ctx + maybe_flip(s5_readout(hc_re, hc_im, cr, ci), d)
    wg, bg = w_glu.astype(f32), b_glu.astype(f32)

    def glu(y):
        y = jax.nn.gelu(y.reshape(y.shape[:2] + (SSM_WIDTH,)))
        return (y * jax.nn.sigmoid(y @ wg + bg)).astype(out_dtype)

    return glu(y_lat), (glu(y_ctx) if need_ctx else None)


def even_mixer(h_lat, h_ctx, w_in, w_out, g_q, g_k, lam_re, lam_im, log_dt, b_re, b_im, c_re, c_im,
               d_skip, w_glu, b_glu, need_ctx):
    b, n, _ = h_lat.shape
    n_ctx = h_ctx.shape[1]
    cos, sin = axial_rope_tables(n, HEAD_DIM)
    cuts = [GQA_Q_W, GQA_Q_W + GQA_KV_W, GQA_Q_W + 2 * GQA_KV_W]

    def project(h):
        t = h.shape[:2]
        q, k, v, u = jnp.split(h @ w_in, cuts, axis=-1)
        q = rms_norm(q.reshape(t + (GQA_Q_HEADS, HEAD_DIM)), g_q)
        k = rms_norm(k.reshape(t + (GQA_KV_HEADS, HEAD_DIM)), g_k)
        v = v.reshape(t + (GQA_KV_HEADS, HEAD_DIM))
        return q, k, v, u

    def grouped_q(q):
        return q.reshape(q.shape[:2] + (GQA_KV_HEADS, GQA_GROUP, HEAD_DIM))

    q_l, k_l, v_l, u_l = project(h_lat)
    q_c, k_c, v_c, u_c = project(h_ctx)
    q_l = apply_axial_rope(q_l, cos, sin)
    k_l = apply_axial_rope(k_l, cos, sin)
    scale = HEAD_DIM ** -0.5
    att_l = blocked_attention(grouped_q(q_l), jnp.concatenate([k_c, k_l], axis=1),
                              jnp.concatenate([v_c, v_l], axis=1), scale).reshape(b, n, GQA_Q_W)
    ssm_l, ssm_c = s5_mixer(u_l, u_c, lam_re, lam_im, log_dt, b_re, b_im, c_re, c_im, d_skip, w_glu, b_glu, need_ctx)
    out_l = jnp.concatenate([att_l, ssm_l], axis=-1) @ w_out
    out_c = None
    if need_ctx:
        att_c = blocked_attention(grouped_q(q_c), k_c, v_c, scale).reshape(b, n_ctx, GQA_Q_W)
        out_c = jnp.concatenate([att_c, ssm_c], axis=-1) @ w_out
    return out_l, out_c


def neighbourhood_attention(q, k, v, k_ctx, v_ctx, rpb, rows):
    b, n, h, dh = q.shape
    wr = min(NA_WIN_R, rows)
    n_loc = wr * NA_WIN_C
    scale = dh ** -0.5
    kg = k.reshape(b, rows, GRID_W, h, dh)
    vg = v.reshape(b, rows, GRID_W, h, dh)
    qg = jnp.swapaxes(q.reshape(b, rows, GRID_W, h, dh), 0, 1)
    row_start = jnp.clip(jnp.arange(rows) - wr // 2, 0, rows - wr)
    q_col = jnp.arange(GRID_W)
    col_idx = jnp.clip(q_col - NA_WIN_C // 2, 0, GRID_W - NA_WIN_C)[:, None] + jnp.arange(NA_WIN_C)
    col_bias = rpb[:, :, col_idx - q_col[:, None] + (NA_WIN_C - 1)]

    def one_row(args):
        r, q_row = args
        rs = row_start[r]
        kw = lax.dynamic_slice_in_dim(kg, rs, wr, axis=1)[:, :, col_idx]
        vw = lax.dynamic_slice_in_dim(vg, rs, wr, axis=1)[:, :, col_idx]
        bias = jnp.transpose(col_bias[:, rs + jnp.arange(wr) - r + (NA_WIN_R - 1)], (0, 2, 1, 3))
        s_loc = jnp.einsum('bqhd,bjqchd->bhqjc', q_row, kw, preferred_element_type=jnp.float32) * scale + bias
        s_ctx = jnp.einsum('bqhd,bshd->bhqs', q_row, k_ctx, preferred_element_type=jnp.float32) * scale
        s = jnp.concatenate([s_loc.reshape(b, h, GRID_W, n_loc), s_ctx], axis=-1)
        p = jax.nn.softmax(s, axis=-1).astype(v.dtype)
        p_loc = p[..., :n_loc].reshape(b, h, GRID_W, wr, NA_WIN_C)
        return (jnp.einsum('bhqjc,bjqchd->bqhd', p_loc, vw)
                + jnp.einsum('bhqs,bshd->bqhd', p[..., n_loc:], v_ctx))

    out = lax.map(one_row, (jnp.arange(rows), qg))
    return jnp.swapaxes(out, 0, 1).reshape(b, n, h * dh)


def odd_mixer(h_lat, h_ctx, w_in, w_out, g_cq, g_ckv, w_uq, w_ukv, g_mq, g_mk, g_nq, g_nk, rpb, need_ctx):
    b, n, _ = h_lat.shape
    n_ctx = h_ctx.shape[1]
    rows = n // GRID_W
    cos, sin = axial_rope_tables(n, MLA_ROPE)
    c1 = MLA_Q_RANK
    c2 = c1 + MLA_KV_RANK
    c3 = c2 + MLA_ROPE
    cuts = [c1, c2, c3, c3 + NA_W, c3 + 2 * NA_W]

    def project(h):
        t = h.shape[:2]
        cq, ckv, kr, nq, nk, nv = jnp.split(h @ w_in, cuts, axis=-1)
        q = (rms_norm(cq, g_cq) @ w_uq).reshape(t + (MLA_HEADS, MLA_QK))
        kv = (rms_norm(ckv, g_ckv) @ w_ukv).reshape(t + (MLA_HEADS, MLA_NOPE + MLA_V))
        k = jnp.concatenate([kv[..., :MLA_NOPE],
                             jnp.broadcast_to(kr[:, :, None, :], t + (MLA_HEADS, MLA_ROPE))], axis=-1)
        mla = (rms_norm(q, g_mq), rms_norm(k, g_mk), kv[..., MLA_NOPE:])
        na = (rms_norm(nq.reshape(t + (NA_HEADS, HEAD_DIM)), g_nq),
              rms_norm(nk.reshape(t + (NA_HEADS, HEAD_DIM)), g_nk),
              nv.reshape(t + (NA_HEADS, HEAD_DIM)))
        return mla, na

    def rope_tail(t):
        return jnp.concatenate([t[..., :MLA_NOPE], apply_axial_rope(t[..., MLA_NOPE:], cos, sin)], axis=-1)

    (mq_l, mk_l, mv_l), (nq_l, nk_l, nv_l) = project(h_lat)
    (mq_c, mk_c, mv_c), (nq_c, nk_c, nv_c) = project(h_ctx)
    mq_l, mk_l = rope_tail(mq_l), rope_tail(mk_l)
    mla_scale = MLA_QK ** -0.5
    mla_l = blocked_attention(mq_l[:, :, :, None], jnp.concatenate([mk_c, mk_l], axis=1),
                              jnp.concatenate([mv_c, mv_l], axis=1), mla_scale).reshape(b, n, MLA_HEADS * MLA_V)
    na_l = neighbourhood_attention(nq_l, nk_l, nv_l, nk_c, nv_c, rpb, rows)
    out_l = jnp.concatenate([mla_l, na_l], axis=-1) @ w_out
    out_c = None
    if need_ctx:
        mla_c = blocked_attention(mq_c[:, :, :, None], mk_c, mv_c, mla_scale).reshape(b, n_ctx, MLA_HEADS * MLA_V)
        na_c = blocked_attention(nq_c[:, :, :, None], nk_c, nv_c, HEAD_DIM ** -0.5).reshape(b, n_ctx, NA_W)
        out_c = jnp.concatenate([mla_c, na_c], axis=-1) @ w_out
    return out_l, out_c


def sq_relu_mlp(h, w1, w2):
    return jnp.square(jax.nn.relu(h @ w1)) @ w2


def setup_inputs(seed: int = 0) -> dict:
    key = jax.random.key(seed)
    keys = iter(jax.random.split(key, 40))
    f32 = jnp.float32

    def normal(shape, scale):
        return scale * jax.random.normal(next(keys), shape, f32)

    def gain(shape):
        return 1.0 + 0.01 * jax.random.normal(next(keys), shape, f32)

    ne, no = N_EVEN, N_ODD
    G, N, P = SSM_GROUPS, SSM_STATE, SSM_GROUP
    return {
        'x': normal((BATCH, SEQ, D_MODEL), 1.0),
        'c': normal((BATCH, D_MODEL), 1.0),
        'ctx': normal((BATCH, CTX_LEN, D_MODEL), 1.0),
        'c_ctx': normal((D_MODEL,), 1.0),
        'w_mod': normal((DEPTH, D_MODEL, N_MOD * D_MODEL), D_MODEL ** -0.5),
        'b_mod': normal((DEPTH, N_MOD * D_MODEL), 0.01),
        'g_norm1': gain((DEPTH, D_MODEL)),
        'g_norm2': gain((DEPTH, D_MODEL)),
        'w_ff1': normal((DEPTH, D_MODEL, D_FF), D_MODEL ** -0.5),
        'w_ff2': normal((DEPTH, D_FF, D_MODEL), D_FF ** -0.5),
        'e_w_in': normal((ne, D_MODEL, EVEN_IN_W), D_MODEL ** -0.5),
        'e_w_out': normal((ne, EVEN_MIX_W, D_MODEL), EVEN_MIX_W ** -0.5),
        'e_g_q': gain((ne, HEAD_DIM)),
        'e_g_k': gain((ne, HEAD_DIM)),
        'ssm_lam_re': -0.5 + normal((ne, 2, G, N), 0.01),
        'ssm_lam_im': jnp.pi * jnp.arange(N, dtype=f32) + normal((ne, 2, G, N), 0.01),
        'ssm_log_dt': jax.random.uniform(next(keys), (ne, 2, G), f32, math.log(SSM_DT_MIN), math.log(SSM_DT_MAX)),
        'ssm_b_re': normal((ne, 2, G, N, P), (2 * P) ** -0.5),
        'ssm_b_im': normal((ne, 2, G, N, P), (2 * P) ** -0.5),
        'ssm_c_re': normal((ne, 2, G, P, N), 0.5),
        'ssm_c_im': normal((ne, 2, G, P, N), 0.5),
        'ssm_d': normal((ne, SSM_WIDTH), 0.5),
        'ssm_w_glu': normal((ne, SSM_WIDTH, SSM_WIDTH), SSM_WIDTH ** -0.5),
        'ssm_b_glu': normal((ne, SSM_WIDTH), 0.01),
        'o_w_in': normal((no, D_MODEL, ODD_IN_W), D_MODEL ** -0.5),
        'o_w_out': normal((no, ODD_MIX_W, D_MODEL), ODD_MIX_W ** -0.5),
        'mla_g_cq': gain((no, MLA_Q_RANK)),
        'mla_g_ckv': gain((no, MLA_KV_RANK)),
        'mla_w_uq': normal((no, MLA_Q_RANK, MLA_HEADS * MLA_QK), MLA_Q_RANK ** -0.5),
        'mla_w_ukv': normal((no, MLA_KV_RANK, MLA_HEADS * (MLA_NOPE + MLA_V)), MLA_KV_RANK ** -0.5),
        'mla_g_q': gain((no, MLA_QK)),
        'mla_g_k': gain((no, MLA_QK)),
        'na_g_q': gain((no, HEAD_DIM)),
        'na_g_k': gain((no, HEAD_DIM)),
        'na_rpb': normal((no, NA_HEADS, 2 * NA_WIN_R - 1, 2 * NA_WIN_C - 1), 0.1),
    }


def reference(x, c, ctx, c_ctx, w_mod, b_mod, g_norm1, g_norm2, w_ff1, w_ff2,
              e_w_in, e_w_out, e_g_q, e_g_k, ssm_lam_re, ssm_lam_im, ssm_log_dt, ssm_b_re, ssm_b_im,
              ssm_c_re, ssm_c_im, ssm_d, ssm_w_glu, ssm_b_glu,
              o_w_in, o_w_out, mla_g_cq, mla_g_ckv, mla_w_uq, mla_w_ukv, mla_g_q, mla_g_k,
              na_g_q, na_g_k, na_rpb):
    cond_lat = jax.nn.silu(c)[:, None, :]
    cond_ctx = jax.nn.silu(c_ctx)[None, None, :]
    xc = ctx
    for i in range(DEPTH):
        need_ctx = i < DEPTH - 1
        j = i // 2
        m_lat = jnp.split(cond_lat @ w_mod[i] + b_mod[i], N_MOD, axis=-1)
        m_ctx = jnp.split(cond_ctx @ w_mod[i] + b_mod[i], N_MOD, axis=-1)
        a_lat = modulate(x, g_norm1[i], m_lat[0], m_lat[1])
        a_ctx = modulate(xc, g_norm1[i], m_ctx[0], m_ctx[1])
        if i % 2 == 0:
            o_lat, o_ctx = even_mixer(a_lat, a_ctx, e_w_in[j], e_w_out[j], e_g_q[j], e_g_k[j],
                                      ssm_lam_re[j], ssm_lam_im[j], ssm_log_dt[j], ssm_b_re[j], ssm_b_im[j],
                                      ssm_c_re[j], ssm_c_im[j], ssm_d[j], ssm_w_glu[j], ssm_b_glu[j], need_ctx)
        else:
            o_lat, o_ctx = odd_mixer(a_lat, a_ctx, o_w_in[j], o_w_out[j], mla_g_cq[j], mla_g_ckv[j],
                                     mla_w_uq[j], mla_w_ukv[j], mla_g_q[j], mla_g_k[j],
                                     na_g_q[j], na_g_k[j], na_rpb[j], need_ctx)
        x = x + m_lat[2] * o_lat
        x = x + m_lat[5] * sq_relu_mlp(modulate(x, g_norm2[i], m_lat[3], m_lat[4]), w_ff1[i], w_ff2[i])
        if need_ctx:
            xc = xc + m_ctx[2] * o_ctx
            xc = xc + m_ctx[5] * sq_relu_mlp(modulate(xc, g_norm2[i], m_ctx[3], m_ctx[4]), w_ff1[i], w_ff2[i])
    return x
```

```cpp
#include <hip/hip_runtime.h>
#include <hip/hip_cooperative_groups.h>
#include <cstdio>
namespace cg = cooperative_groups;

typedef unsigned short u16;
using bf16x8 = __attribute__((ext_vector_type(8))) short;
using f32x16 = __attribute__((ext_vector_type(16))) float;
using f32x4 = __attribute__((ext_vector_type(4))) float;
typedef __attribute__((ext_vector_type(2))) __bf16 bf2_t;
using u32x4 = __attribute__((ext_vector_type(4))) unsigned;
#define DI __device__ __forceinline__
#define MFMA32(a, b, c) __builtin_amdgcn_mfma_f32_32x32x16_bf16((a), (b), (c), 0, 0, 0)
#define MFMA16(a, b, c) __builtin_amdgcn_mfma_f32_16x16x32_bf16((a), (b), (c), 0, 0, 0)

constexpr int NTHR = 256;
constexpr int NLAT = 32768, NTOK = 36864, SP = 2304;
constexpr float EPSF = 1e-6f;
constexpr float LOG2E = 1.4426950408889634f;
constexpr int SMEM_BYTES = 73728;
constexpr int CP = 132;

constexpr size_t SZ_EIN = 1536ull * 1024 * 2, SZ_SQ = 1024ull * 1024 * 2, SZ_OIN = 2432ull * 1024 * 2;
constexpr size_t SZ_UQ = 1024ull * 512 * 2, SZ_UKV = 1024ull * 256 * 2, SZ_GLU = 256ull * 256 * 2;
constexpr size_t OFF_EIN = 0;
constexpr size_t OFF_EOUT = OFF_EIN + 2 * SZ_EIN;
constexpr size_t OFF_OIN = OFF_EOUT + 2 * SZ_SQ;
constexpr size_t OFF_OOUT = OFF_OIN + 2 * SZ_OIN;
constexpr size_t OFF_UQ = OFF_OOUT + 2 * SZ_SQ;
constexpr size_t OFF_UKV = OFF_UQ + 2 * SZ_UQ;
constexpr size_t OFF_GLU = OFF_UKV + 2 * SZ_UKV;
constexpr size_t OFF_FF1 = OFF_GLU + 2 * SZ_GLU;
constexpr size_t OFF_FF2 = OFF_FF1 + 4096ull * 1024 * 2;
constexpr size_t OFF_MODV = OFF_FF2 + 4096ull * 1024 * 2;
constexpr size_t OFF_ROPE = OFF_MODV + 4ull * 17 * 6144 * 4;
constexpr size_t OFF_SA = OFF_ROPE + 16384;
constexpr size_t OFF_SAL = OFF_SA + 4096 * 8;
constexpr size_t OFF_SBB = OFF_SAL + 4096 * 8;
constexpr size_t OFF_XC = OFF_SBB + 4096ull * 32 * 4;
constexpr size_t OFF_ABUF = OFF_XC + 4096ull * 1024 * 4;
constexpr size_t OFF_R1 = OFF_ABUF + (size_t)NTOK * 1024 * 2;
constexpr size_t E_Q = OFF_R1;
constexpr size_t E_K = E_Q + 16ull * 12 * SP * 64 * 2;
constexpr size_t E_VT = E_K + 16ull * 4 * SP * 64 * 2;
constexpr size_t E_U = E_VT + 16ull * 4 * SP * 64 * 2;
constexpr size_t E_E = E_U + (size_t)NTOK * 256 * 4;
constexpr size_t E_YG = E_E + 16ull * 16 * 2 * 36 * 64 * 8;
constexpr size_t O_CQ = OFF_R1;
constexpr size_t O_CKV = O_CQ + (size_t)NTOK * 512 * 2;
constexpr size_t O_KR = O_CKV + (size_t)NTOK * 256 * 2;
constexpr size_t O_PS = O_KR + (size_t)NTOK * 32 * 4;
constexpr size_t O_NQ = O_PS + (size_t)NTOK * 8 * 4;
constexpr size_t O_NK = O_NQ + 16ull * 8 * SP * 64 * 2;
constexpr size_t O_NVT = O_NK + 16ull * 8 * SP * 64 * 2;
constexpr size_t O_MQ = O_NVT + 16ull * 8 * SP * 64 * 2;
constexpr size_t O_MK = O_MQ + 16ull * 8 * SP * 96 * 2;
constexpr size_t O_MVT = O_MK + 16ull * 8 * SP * 96 * 2;
constexpr size_t O_END = O_MVT + 16ull * 8 * SP * 64 * 2;
constexpr size_t OFF_H = OFF_R1;

struct P {
  const float *x, *c, *ctx, *c_ctx, *w_mod, *b_mod, *g_norm1, *g_norm2, *w_ff1, *w_ff2;
  const float *e_w_in, *e_w_out, *e_g_q, *e_g_k, *lam_re, *lam_im, *log_dt, *b_re, *b_im, *c_re, *c_im, *ssm_d, *w_glu, *b_glu;
  const float *o_w_in, *o_w_out, *g_cq, *g_ckv, *w_uq, *w_ukv, *g_mq, *g_mk, *g_nq, *g_nk, *rpb;
  float* out;
  char* ws;
};

DI unsigned pack2(float a, float b) { bf2_t v; v[0] = (__bf16)a; v[1] = (__bf16)b; return __builtin_bit_cast(unsigned, v); }
DI u16 f2bf(float a) { __bf16 v = (__bf16)a; return __builtin_bit_cast(u16, v); }
DI float bf2f(u16 v) { return __uint_as_float(((unsigned)v) << 16); }
DI int otid() { int t = threadIdx.x; asm volatile("" : "+v"(t)); return t; }
DI int tok_row(int b, int pos) { return pos < 256 ? NLAT + b * 256 + pos : b * 2048 + pos - 256; }

DI int map_col(int mapk, int n, int N) {
  if (mapk == 0) return n < N ? n : -1;
  if (mapk == 1) { if (n < 768) return n; if (n < 2304) return n + 32; if (n < 2336) return n - 2304 + 768; return -1; }
  int h = n >> 7, jj = n & 127; return jj < 96 ? h * 96 + jj : -1;
}
DI void tr_tile(const float* __restrict__ src, int K, int N, int Npad, int mapk, const float* __restrict__ ks,
                        u16* __restrict__ dst, int tile, char* smem) {
  float* tl = (float*)smem;
  const int tid = otid();
  const int tnn = Npad >> 6;
  const int n0 = (tile % tnn) * 64, k0 = (tile / tnn) * 64;
  const int nn = tid & 63;
  const int sn = map_col(mapk, n0 + nn, N);
#pragma unroll 4
  for (int i = 0; i < 16; ++i) {
    int kk = (tid >> 6) + 4 * i;
    float v = 0.f;
    if (sn >= 0) { v = src[(size_t)(k0 + kk) * N + sn]; if (ks) v *= ks[k0 + kk]; }
    tl[kk * 65 + nn] = v;
  }
  __syncthreads();
#pragma unroll 4
  for (int i = 0; i < 16; ++i) {
    int n2 = (tid >> 6) + 4 * i, kk = tid & 63;
    dst[(size_t)(n0 + n2) * K + k0 + kk] = f2bf(tl[kk * 65 + n2]);
  }
  __syncthreads();
}

DI void ff_convert(const P& p, int layer, char* smem) {
  u16* f1 = (u16*)(p.ws + OFF_FF1);
  u16* f2 = (u16*)(p.ws + OFF_FF2);
  const float* s1 = p.w_ff1 + (size_t)layer * 1024 * 4096;
  const float* s2 = p.w_ff2 + (size_t)layer * 4096 * 1024;
  for (int t = gridDim.x - 1 - blockIdx.x; t < 2048; t += gridDim.x) {
    if (t < 1024) tr_tile(s1, 1024, 4096, 4096, 0, nullptr, f1, t, smem);
    else tr_tile(s2, 4096, 1024, 1024, 0, nullptr, f2, t - 1024, smem);
  }
}

DI void prologue(const P& p, char* smem) {
  const int tid = otid();
  float* modv = (float*)(p.ws + OFF_MODV);
  for (int it = blockIdx.x; it < 384; it += gridDim.x) {
    float* cond = (float*)smem;
    for (int idx = tid; idx < 17 * 1024; idx += NTHR) {
      int bb = idx >> 10, k = idx & 1023;
      float v = bb < 16 ? p.c[bb * 1024 + k] : p.c_ctx[k];
      cond[idx] = v / (1.f + __expf(-v));
    }
    __syncthreads();
    const int l = it / 96, n = (it % 96) * 64 + (tid & 63), kq = tid >> 6;
    float acc[17];
#pragma unroll
    for (int i = 0; i < 17; ++i) acc[i] = 0.f;
    const float* wp = p.w_mod + ((size_t)l * 1024 + kq * 256) * 6144 + n;
    for (int k4 = 0; k4 < 64; ++k4) {
      float w0 = wp[(size_t)(k4 * 4 + 0) * 6144], w1 = wp[(size_t)(k4 * 4 + 1) * 6144];
      float w2 = wp[(size_t)(k4 * 4 + 2) * 6144], w3 = wp[(size_t)(k4 * 4 + 3) * 6144];
#pragma unroll
      for (int bb = 0; bb < 17; ++bb) {
        float4 c4 = *(const float4*)(cond + bb * 1024 + kq * 256 + k4 * 4);
        acc[bb] += c4.x * w0 + c4.y * w1 + c4.z * w2 + c4.w * w3;
      }
    }
    __syncthreads();
    float* red = (float*)smem;
#pragma unroll
    for (int bb = 0; bb < 17; ++bb) red[(kq * 17 + bb) * 64 + (tid & 63)] = acc[bb];
    __syncthreads();
    for (int o = tid; o < 17 * 64; o += NTHR) {
      int bb = o >> 6, nn = o & 63;
      int ncol = (it % 96) * 64 + nn;
      float s = red[(0 * 17 + bb) * 64 + nn] + red[(1 * 17 + bb) * 64 + nn] + red[(2 * 17 + bb) * 64 + nn] + red[(3 * 17 + bb) * 64 + nn];
      modv[((size_t)l * 17 + bb) * 6144 + ncol] = s + p.b_mod[l * 6144 + ncol];
    }
    __syncthreads();
  }
  {
    float* rt = (float*)(p.ws + OFF_ROPE);
    for (int idx = blockIdx.x * NTHR + tid; idx < 1024 + 512; idx += gridDim.x * NTHR) {
      if (idx < 1024) {
        int pos = idx >> 4, i = idx & 15;
        float f = powf(10000.f, -(float)(2 * i) / 32.f);
        float a = (float)pos * f;
        rt[idx] = cosf(a); rt[1024 + idx] = sinf(a);
      } else {
        int q = idx - 1024; int pos = q >> 3, i = q & 7;
        float f = powf(10000.f, -(float)(2 * i) / 16.f);
        float a = (float)pos * f;
        rt[2048 + q] = cosf(a); rt[2560 + q] = sinf(a);
      }
    }
    float2* SA = (float2*)(p.ws + OFF_SA);
    float2* SAL = (float2*)(p.ws + OFF_SAL);
    float* SBB = (float*)(p.ws + OFF_SBB);
    for (int idx = blockIdx.x * NTHR + tid; idx < 4096; idx += gridDim.x * NTHR) {
      float lre = p.lam_re[idx], lim = p.lam_im[idx];
      float dt = expf(p.log_dt[idx >> 6]);
      float mag = expf(lre * dt);
      float are = mag * cosf(lim * dt), aim = mag * sinf(lim * dt);
      float den = lre * lre + lim * lim;
      float fre = ((are - 1.f) * lre + aim * lim) / den;
      float fim = (aim * lre - (are - 1.f) * lim) / den;
      SA[idx] = make_float2(are, aim);
      float pr = are, pi = aim;
#pragma unroll
      for (int q = 0; q < 6; ++q) { float nr = pr * pr - pi * pi, ni = 2.f * pr * pi; pr = nr; pi = ni; }
      SAL[idx] = make_float2(pr, pi);
#pragma unroll
      for (int q = 0; q < 16; ++q) {
        float br = p.b_re[(size_t)idx * 16 + q], bi = p.b_im[(size_t)idx * 16 + q];
        SBB[(size_t)idx * 32 + q] = fre * br - fim * bi;
        SBB[(size_t)idx * 32 + 16 + q] = fre * bi + fim * br;
      }
    }
  }
  for (int t = gridDim.x - 1 - blockIdx.x; t < 3424; t += gridDim.x) {
    int j = t / 1712, r = t % 1712;
    if (r < 384) tr_tile(p.e_w_in + (size_t)j * 1024 * 1536, 1024, 1536, 1536, 0, nullptr, (u16*)(p.ws + OFF_EIN + j * SZ_EIN), r, smem);
    else if (r < 640) tr_tile(p.e_w_out + (size_t)j * 1024 * 1024, 1024, 1024, 1024, 0, nullptr, (u16*)(p.ws + OFF_EOUT + j * SZ_SQ), r - 384, smem);
    else if (r < 1248) tr_tile(p.o_w_in + (size_t)j * 1024 * 2336, 1024, 2336, 2432, 1, nullptr, (u16*)(p.ws + OFF_OIN + j * SZ_OIN), r - 640, smem);
    else if (r < 1504) tr_tile(p.o_w_out + (size_t)j * 1024 * 1024, 1024, 1024, 1024, 0, nullptr, (u16*)(p.ws + OFF_OOUT + j * SZ_SQ), r - 1248, smem);
    else if (r < 1632) tr_tile(p.w_uq + (size_t)j * 512 * 768, 512, 768, 1024, 2, p.g_cq + j * 512, (u16*)(p.ws + OFF_UQ + j * SZ_UQ), r - 1504, smem);
    else if (r < 1696) tr_tile(p.w_ukv + (size_t)j * 256 * 1024, 256, 1024, 1024, 0, p.g_ckv + j * 256, (u16*)(p.ws + OFF_UKV + j * SZ_UKV), r - 1632, smem);
    else tr_tile(p.w_glu + (size_t)j * 256 * 256, 256, 256, 256, 0, nullptr, (u16*)(p.ws + OFF_GLU + j * SZ_GLU), r - 1696, smem);
  }
}

DI void norm_phase(const float* __restrict__ xl, const float* __restrict__ xc, const float* __restrict__ g,
                           const float* __restrict__ modl, int shift_i, int scale_i, int nrows, u16* __restrict__ dst) {
  const int tid_ = otid();
  const int lane = tid_ & 63;
  const int gw = blockIdx.x * 4 + (tid_ >> 6);
  for (int R = gw; R < nrows; R += gridDim.x * 4) {
    const float* src = R < NLAT ? xl + (size_t)R * 1024 : xc + (size_t)(R - NLAT) * 1024;
    const int mrow = R < NLAT ? (R >> 11) : 16;
    float4 v[4];
    float ss = 0.f;
#pragma unroll
    for (int i = 0; i < 4; ++i) {
      v[i] = *(const float4*)(src + lane * 4 + 256 * i);
      ss += v[i].x * v[i].x + v[i].y * v[i].y + v[i].z * v[i].z + v[i].w * v[i].w;
    }
#pragma unroll
    for (int o = 32; o >= 1; o >>= 1) ss += __shfl_xor(ss, o);
    const float rstd = rsqrtf(ss * (1.f / 1024.f) + EPSF);
    const float* sh = modl + (size_t)mrow * 6144 + shift_i * 1024;
    const float* sc = modl + (size_t)mrow * 6144 + scale_i * 1024;
#pragma unroll
    for (int i = 0; i < 4; ++i) {
      int col = lane * 4 + 256 * i;
      float4 gg = *(const float4*)(g + col), s4 = *(const float4*)(sh + col), c4 = *(const float4*)(sc + col);
      float y0 = v[i].x * rstd * gg.x * (1.f + c4.x) + s4.x;
      float y1 = v[i].y * rstd * gg.y * (1.f + c4.y) + s4.y;
      float y2 = v[i].z * rstd * gg.z * (1.f + c4.z) + s4.z;
      float y3 = v[i].w * rstd * gg.w * (1.f + c4.w) + s4.w;
      uint2 o2; o2.x = pack2(y0, y1); o2.y = pack2(y2, y3);
      *(uint2*)(dst + (size_t)R * 1024 + col) = o2;
    }
  }
}

enum { EPI_EVEN_IN = 0, EPI_ODD_IN, EPI_UQ, EPI_UKV, EPI_GLU, EPI_RESID, EPI_RELU2 };

struct EpiArgs {
  int j;
  const float* gate;
  const float* src_lat; const float* src_ctx; float* dst_lat; float* dst_ctx;
};

DI void store16(u16* dst, const float* y) {
  uint4 a, b;
  a.x = pack2(y[0], y[1]); a.y = pack2(y[2], y[3]); a.z = pack2(y[4], y[5]); a.w = pack2(y[6], y[7]);
  b.x = pack2(y[8], y[9]); b.y = pack2(y[10], y[11]); b.z = pack2(y[12], y[13]); b.w = pack2(y[14], y[15]);
  *(uint4*)dst = a; *(uint4*)(dst + 8) = b;
}
DI void load16(const float* s, float* v) {
#pragma unroll
  for (int q = 0; q < 4; ++q) { float4 t = *(const float4*)(s + 4 * q); v[4 * q] = t.x; v[4 * q + 1] = t.y; v[4 * q + 2] = t.z; v[4 * q + 3] = t.w; }
}

DI void epi_head64(const P& p, const float* Cs, int b, int pos0, bool isctx, const float* __restrict__ g, bool rope,
                   u16* __restrict__ dstbase, int H, int head0) {
  const int tid = otid(), sub = tid & 7, hh = sub >> 2, jq = sub & 3;
  const float* rt = (const float*)(p.ws + OFF_ROPE);
#pragma unroll 1
  for (int pass = 0; pass < 4; ++pass) {
    const int row = pass * 32 + (tid >> 3);
    float v[16], pv[16];
    load16(Cs + row * CP + 16 * sub, v);
    float ss = 0.f;
#pragma unroll
    for (int i = 0; i < 16; ++i) ss += v[i] * v[i];
    ss += __shfl_xor(ss, 1); ss += __shfl_xor(ss, 2);
    const float rs = rsqrtf(ss * (1.f / 64.f) + EPSF);
#pragma unroll
    for (int i = 0; i < 16; ++i) v[i] = v[i] * rs * g[16 * jq + i];
    const int pos = pos0 + row;
    if (rope && !isctx) {
      load16(Cs + row * CP + 16 * (sub ^ 1), pv);
      const int lp = pos - 256;
      const int ti = (jq < 2) ? (lp >> 6) : (lp & 63);
      const float sgn = (jq & 1) ? 1.f : -1.f;
#pragma unroll
      for (int i = 0; i < 16; ++i) {
        float pn = pv[i] * rs * g[16 * (jq ^ 1) + i];
        float cs = rt[ti * 16 + i], sn = rt[1024 + ti * 16 + i];
        v[i] = v[i] * cs + sgn * pn * sn;
      }
    }
    store16(dstbase + (((size_t)b * H + head0 + hh) * SP + pos) * 64 + 16 * jq, v);
  }
}

DI void epi_vt(const float* Cs, int b, int pos0, u16* __restrict__ dstbase, int H, int head0, int c0, int ncols, float mul_unused) {
  const int tid = otid();
  const int cl = tid % ncols, tg = tid / ncols, ngrp = NTHR / ncols;
  const int col = c0 + cl;
  const int head = head0 + (cl >> 6), d = cl & 63;
  u16* drow = dstbase + (((size_t)b * H + head) * 64 + d) * SP + pos0;
  for (int tk = tg; tk < 16; tk += ngrp) {
    float y[8];
#pragma unroll
    for (int e = 0; e < 8; ++e) y[e] = Cs[(tk * 8 + e) * CP + col];
    uint4 a; a.x = pack2(y[0], y[1]); a.y = pack2(y[2], y[3]); a.z = pack2(y[4], y[5]); a.w = pack2(y[6], y[7]);
    *(uint4*)(drow + tk * 8) = a;
  }
}

template <int EPI>
DI void epilogue(const P& p, const EpiArgs& ea, float* Cs, int mtile, int ntile) {
  const int tid = otid();
  const int m0 = mtile * 128, n0 = ntile * 128;
  const bool isctx = m0 >= NLAT;
  const int b = isctx ? ((m0 - NLAT) >> 8) : (m0 >> 11);
  const int pos0 = isctx ? ((m0 - NLAT) & 255) : 256 + (m0 & 2047);
  const int mrow = isctx ? 16 : b;
  char* ws = p.ws;
  if (EPI == EPI_RESID || EPI == EPI_RELU2 || EPI == EPI_GLU) {
    const int c4 = (tid & 31) * 4;
    const int n = n0 + c4;
#pragma unroll 2
    for (int pass = 0; pass < 16; ++pass) {
      const int row = pass * 8 + (tid >> 5);
      const int R = m0 + row;
      float4 a = *(const float4*)(Cs + row * CP + c4);
      if (EPI == EPI_RESID) {
        const float* src = isctx ? ea.src_ctx + (size_t)(R - NLAT) * 1024 : ea.src_lat + (size_t)R * 1024;
        float* dst = isctx ? ea.dst_ctx + (size_t)(R - NLAT) * 1024 : ea.dst_lat + (size_t)R * 1024;
        float4 xv = *(const float4*)(src + n);
        float4 gv = *(const float4*)(ea.gate + (size_t)mrow * 6144 + n);
        float4 o; o.x = xv.x + gv.x * a.x; o.y = xv.y + gv.y * a.y; o.z = xv.z + gv.z * a.z; o.w = xv.w + gv.w * a.w;
        *(float4*)(dst + n) = o;
      } else if (EPI == EPI_RELU2) {
        float r0 = fmaxf(a.x, 0.f), r1 = fmaxf(a.y, 0.f), r2 = fmaxf(a.z, 0.f), r3 = fmaxf(a.w, 0.f);
        uint2 o; o.x = pack2(r0 * r0, r1 * r1); o.y = pack2(r2 * r2, r3 * r3);
        *(uint2*)((u16*)(ws + OFF_H) + (size_t)R * 4096 + n) = o;
      } else {
        const u16* yg = (const u16*)(ws + E_YG) + (size_t)R * 256 + n;
        uint2 yv = *(const uint2*)yg;
        float4 bg = *(const float4*)(p.b_glu + ea.j * 256 + n);
        float y0 = __uint_as_float(yv.x << 16), y1 = __uint_as_float(yv.x & 0xffff0000u);
        float y2 = __uint_as_float(yv.y << 16), y3 = __uint_as_float(yv.y & 0xffff0000u);
        float o0 = y0 / (1.f + __expf(-(a.x + bg.x))), o1 = y1 / (1.f + __expf(-(a.y + bg.y)));
        float o2 = y2 / (1.f + __expf(-(a.z + bg.z))), o3 = y3 / (1.f + __expf(-(a.w + bg.w)));
        uint2 o; o.x = pack2(o0, o1); o.y = pack2(o2, o3);
        *(uint2*)((u16*)(ws + OFF_ABUF) + (size_t)R * 1024 + 768 + n) = o;
      }
    }
  } else if (EPI == EPI_EVEN_IN) {
    if (ntile < 6) epi_head64(p, Cs, b, pos0, isctx, p.e_g_q + ea.j * 64, true, (u16*)(ws + E_Q), 12, ntile * 2);
    else if (ntile < 8) epi_head64(p, Cs, b, pos0, isctx, p.e_g_k + ea.j * 64, true, (u16*)(ws + E_K), 4, (ntile - 6) * 2);
    else if (ntile < 10) epi_vt(Cs, b, pos0, (u16*)(ws + E_VT), 4, (ntile - 8) * 2, 0, 128, 1.f);
    else {
      const int c4 = (tid & 31) * 4;
      float* U = (float*)(ws + E_U);
      for (int pass = 0; pass < 16; ++pass) {
        const int row = pass * 8 + (tid >> 5);
        *(float4*)(U + (size_t)(m0 + row) * 256 + (ntile - 10) * 128 + c4) = *(const float4*)(Cs + row * CP + c4);
      }
    }
  } else if (EPI == EPI_ODD_IN) {
    if (ntile < 6) {
      const int c4 = (tid & 31) * 4;
      float* PS = (float*)(ws + O_PS);
      for (int pass = 0; pass < 16; ++pass) {
        const int row = pass * 8 + (tid >> 5);
        const int R = m0 + row;
        float4 a = *(const float4*)(Cs + row * CP + c4);
        float ss = a.x * a.x + a.y * a.y + a.z * a.z + a.w * a.w;
#pragma unroll
        for (int o = 16; o >= 1; o >>= 1) ss += __shfl_xor(ss, o);
        if ((tid & 31) == 0) PS[(size_t)R * 8 + ntile] = ss;
        uint2 o; o.x = pack2(a.x, a.y); o.y = pack2(a.z, a.w);
        if (ntile < 4) *(uint2*)((u16*)(ws + O_CQ) + (size_t)R * 512 + n0 + c4) = o;
        else *(uint2*)((u16*)(ws + O_CKV) + (size_t)R * 256 + (n0 - 512) + c4) = o;
      }
    } else if (ntile < 10) epi_head64(p, Cs, b, pos0, isctx, p.g_nq + ea.j * 64, false, (u16*)(ws + O_NQ), 8, (ntile - 6) * 2);
    else if (ntile < 14) epi_head64(p, Cs, b, pos0, isctx, p.g_nk + ea.j * 64, false, (u16*)(ws + O_NK), 8, (ntile - 10) * 2);
    else if (ntile < 18) epi_vt(Cs, b, pos0, (u16*)(ws + O_NVT), 8, (ntile - 14) * 2, 0, 128, 1.f);
    else {
      float* KR = (float*)(ws + O_KR);
      const int c4 = (tid & 7) * 4;
      for (int pass = 0; pass < 4; ++pass) {
        const int row = pass * 32 + (tid >> 3);
        *(float4*)(KR + (size_t)(m0 + row) * 32 + c4) = *(const float4*)(Cs + row * CP + c4);
      }
    }
  } else if (EPI == EPI_UQ || EPI == EPI_UKV) {
    const int sub = tid & 7;
    const float* PS = (const float*)(ws + O_PS);
    const float* rt = (const float*)(ws + OFF_ROPE);
    const float* gm = (EPI == EPI_UQ ? p.g_mq : p.g_mk) + ea.j * 96;
    u16* dstb = (u16*)(ws + (EPI == EPI_UQ ? O_MQ : O_MK));
    const float* KR = (const float*)(ws + O_KR);
#pragma unroll 1
    for (int pass = 0; pass < 4; ++pass) {
      const int row = pass * 32 + (tid >> 3);
      const int R = m0 + row;
      float rstd;
      if (EPI == EPI_UQ) {
        float4 ps = *(const float4*)(PS + (size_t)R * 8);
        rstd = rsqrtf((ps.x + ps.y + ps.z + ps.w) * (1.f / 512.f) + EPSF);
      } else {
        float2 ps = *(const float2*)(PS + (size_t)R * 8 + 4);
        rstd = rsqrtf((ps.x + ps.y) * (1.f / 256.f) + EPSF);
      }
      float v[16];
      if (EPI == EPI_UQ) {
        load16(Cs + row * CP + 16 * sub, v);
#pragma unroll
        for (int i = 0; i < 16; ++i) v[i] *= rstd;
      } else {
        if (sub < 4) {
          load16(Cs + row * CP + 16 * sub, v);
#pragma unroll
          for (int i = 0; i < 16; ++i) v[i] *= rstd;
        } else if (sub < 6) {
          load16(KR + (size_t)R * 32 + 16 * (sub - 4), v);
        } else {
#pragma unroll
          for (int i = 0; i < 16; ++i) v[i] = 0.f;
        }
      }
      float ss = 0.f;
#pragma unroll
      for (int i = 0; i < 16; ++i) ss += v[i] * v[i];
      ss += __shfl_xor(ss, 1); ss += __shfl_xor(ss, 2); ss += __shfl_xor(ss, 4);
      const float rs = rsqrtf(ss * (1.f / 96.f) + EPSF);
      if (sub < 6) {
#pragma unroll
        for (int i = 0; i < 16; ++i) v[i] = v[i] * rs * gm[16 * sub + i];
        const int pos = pos0 + row;
        if (sub >= 4 && !isctx) {
          const int lp = pos - 256;
          const int ti = (sub == 4) ? (lp >> 6) : (lp & 63);
#pragma unroll
          for (int i = 0; i < 8; ++i) {
            float cs = rt[2048 + ti * 8 + i], sn = rt[2560 + ti * 8 + i];
            float x1 = v[i], x2 = v[i + 8];
            v[i] = x1 * cs - x2 * sn;
            v[i + 8] = x2 * cs + x1 * sn;
          }
        }
        store16(dstb + (((size_t)b * 8 + ntile) * SP + pos) * 96 + 16 * sub, v);
      }
    }
    if (EPI == EPI_UKV) {
      const int cl = tid & 63, tg = tid >> 6;
      u16* drow = (u16*)(ws + O_MVT) + (((size_t)b * 8 + ntile) * 64 + cl) * SP + pos0;
      for (int tk = tg; tk < 16; tk += 4) {
        float y[8];
#pragma unroll
        for (int e = 0; e < 8; ++e) {
          const int R = m0 + tk * 8 + e;
          float2 ps = *(const float2*)(PS + (size_t)R * 8 + 4);
          float rstd = rsqrtf((ps.x + ps.y) * (1.f / 256.f) + EPSF);
          y[e] = Cs[(tk * 8 + e) * CP + 64 + cl] * rstd;
        }
        uint4 a; a.x = pack2(y[0], y[1]); a.y = pack2(y[2], y[3]); a.z = pack2(y[4], y[5]); a.w = pack2(y[6], y[7]);
        *(uint4*)(drow + tk * 8) = a;
      }
    }
  }
}

template <int EPI>
DI void gemm_phase(const P& p, const u16* __restrict__ A, const u16* __restrict__ Bt, int K, int mt, int ntn, int band,
                           const EpiArgs& ea, char* smem) {
  const int tid = otid(), lane = tid & 63, w = tid >> 6, wm = w >> 1, wn = w & 1, r = lane & 31, h = lane >> 5;
  u16* As = (u16*)smem;
  u16* Bs = As + 2 * 9216;
  float* Cs = (float*)smem;
  const int total = mt * ntn;
  const int mper = mt >> 3;
  const int nk = K >> 6;
  const int lrow = tid >> 3, lkc = (tid & 7) * 8;
  for (int t = blockIdx.x; t < total; t += gridDim.x) {
    const int xcd = t & 7, L = t >> 3;
    const int bandsz = band * ntn;
    const int bi = L / bandsz, rr = L - bi * bandsz;
    const int full = (ntn >> 3) * (band * 8);
    int mi_, ni_;
    if (rr < full) { int ch = rr / (band * 8); int wv = rr - ch * (band * 8); mi_ = wv % band; ni_ = ch * 8 + wv / band; }
    else { int r2 = rr - full; mi_ = r2 % band; ni_ = (ntn >> 3) * 8 + r2 / band; }
    const int mtile = xcd * mper + bi * band + mi_;
    const int ntile = ni_;
    const u16* Ag = A + (size_t)(mtile * 128 + lrow) * K + lkc;
    const u16* Bg = Bt + (size_t)(ntile * 128 + lrow) * K + lkc;
    f32x16 acc[2][2];
#pragma unroll
    for (int a = 0; a < 2; ++a)
#pragma unroll
      for (int c = 0; c < 2; ++c)
#pragma unroll
        for (int i = 0; i < 16; ++i) acc[a][c][i] = 0.f;
    uint4 ra[4], rb[4];
#pragma unroll
    for (int i = 0; i < 4; ++i) { ra[i] = *(const uint4*)(Ag + (size_t)(32 * i) * K); rb[i] = *(const uint4*)(Bg + (size_t)(32 * i) * K); }
#pragma unroll
    for (int i = 0; i < 4; ++i) { *(uint4*)(As + (lrow + 32 * i) * 72 + lkc) = ra[i]; *(uint4*)(Bs + (lrow + 32 * i) * 72 + lkc) = rb[i]; }
    __syncthreads();
    for (int kt = 0; kt < nk; ++kt) {
      const int buf = kt & 1;
      if (kt + 1 < nk) {
#pragma unroll
        for (int i = 0; i < 4; ++i) {
          ra[i] = *(const uint4*)(Ag + (size_t)(32 * i) * K + (kt + 1) * 64);
          rb[i] = *(const uint4*)(Bg + (size_t)(32 * i) * K + (kt + 1) * 64);
        }
      }
      const u16* as = As + buf * 9216 + (wm * 64 + r) * 72 + h * 8;
      const u16* bs = Bs + buf * 9216 + (wn * 64 + r) * 72 + h * 8;
#pragma unroll
      for (int kk = 0; kk < 4; ++kk) {
        bf16x8 a0 = *(const bf16x8*)(as + kk * 16), a1 = *(const bf16x8*)(as + 32 * 72 + kk * 16);
        bf16x8 b0 = *(const bf16x8*)(bs + kk * 16), b1 = *(const bf16x8*)(bs + 32 * 72 + kk * 16);
        acc[0][0] = MFMA32(a0, b0, acc[0][0]);
        acc[0][1] = MFMA32(a0, b1, acc[0][1]);
        acc[1][0] = MFMA32(a1, b0, acc[1][0]);
        acc[1][1] = MFMA32(a1, b1, acc[1][1]);
      }
      if (kt + 1 < nk) {
        u16* ad = As + (buf ^ 1) * 9216; u16* bd = Bs + (buf ^ 1) * 9216;
#pragma unroll
        for (int i = 0; i < 4; ++i) { *(uint4*)(ad + (lrow + 32 * i) * 72 + lkc) = ra[i]; *(uint4*)(bd + (lrow + 32 * i) * 72 + lkc) = rb[i]; }
      }
      __syncthreads();
    }
#pragma unroll
    for (int a = 0; a < 2; ++a)
#pragma unroll
      for (int c = 0; c < 2; ++c)
#pragma unroll
        for (int i = 0; i < 16; ++i)
          Cs[(wm * 64 + a * 32 + (i & 3) + 8 * (i >> 2) + 4 * h) * CP + wn * 64 + c * 32 + r] = acc[a][c][i];
    __syncthreads();
    epilogue<EPI>(p, ea, Cs, mtile, ntile);
    __syncthreads();
  }
}

template <int DQK, bool NA>
DI void attn_phase(const u16* __restrict__ Q, const u16* __restrict__ Kb, const u16* __restrict__ Vt, int HQ, int HK,
                           float scale, u16* __restrict__ mix, int coloff, bool do_ctx, const float* __restrict__ rpb, char* smem) {
  constexpr int KP = DQK + 8;
  constexpr int NKK = DQK / 16;
  constexpr int KCH = DQK / 32;
  const int tid = otid(), lane = tid & 63, w = tid >> 6, r = lane & 31, h = lane >> 5;
  u16* Ks = (u16*)smem;
  u16* Vs = (u16*)(smem + 13312);
  float* rpbs = (float*)(smem + 22528);
  const int grp_heads = HQ / HK;
  const int nqb = 16 + (do_ctx ? 2 : 0);
  const int upg = grp_heads * nqb;
  const int total = 16 * HK * upg;
  const float sl2 = scale * LOG2E;
  for (int u = blockIdx.x; u < total; u += gridDim.x) {
    const int xcd = u & 7, L = u >> 3;
    const int grp = (L / upg) * 8 + xcd, wi = L % upg;
    const int b = grp / HK, hk = grp % HK;
    const int hq = hk * grp_heads + wi / nqb, qb = wi % nqb;
    const bool lat = qb < 16;
    const int qpos0 = lat ? 256 + 128 * qb : 128 * (qb - 16);
    int ntiles = lat ? 36 : 4;
    int rs0 = 0, rw = 0, rsw = 0;
    if (NA && lat) {
      int r0 = 2 * qb;
      rs0 = min(max(r0 - 4, 0), 24);
      int rs1 = min(max(r0 + 1 - 4, 0), 24);
      ntiles = 4 + (rs1 + 8 - rs0);
      rw = r0 + (w >> 1);
      rsw = min(max(rw - 4, 0), 24);
    }
    const int qpos = qpos0 + w * 32 + r;
    bf16x8 qf[NKK];
    {
      const u16* qp = Q + (((size_t)b * HQ + hq) * SP + qpos) * DQK + 8 * h;
#pragma unroll
      for (int kk = 0; kk < NKK; ++kk) qf[kk] = *(const bf16x8*)(qp + 16 * kk);
    }
    f32x16 o0, o1;
#pragma unroll
    for (int i = 0; i < 16; ++i) { o0[i] = 0.f; o1[i] = 0.f; }
    float m = -1e30f, l = 0.f;
    const u16* kbase = Kb + ((size_t)b * HK + hk) * SP * DQK;
    const u16* vbase = Vt + ((size_t)b * HK + hk) * 64 * SP;
    uint4 rk0, rk1, rk2 = make_uint4(0, 0, 0, 0), rv0, rv1;
#define KPOS_OF(i) ((NA && lat && (i) >= 4) ? 256 + 64 * (rs0 + (i) - 4) : 64 * (i))
#define ATT_GLOAD(kp) do { \
      rk0 = *(const uint4*)(kbase + (size_t)(kp) * DQK + tid * 8); \
      rk1 = *(const uint4*)(kbase + (size_t)(kp) * DQK + (tid + 256) * 8); \
      if (KCH > 2) rk2 = *(const uint4*)(kbase + (size_t)(kp) * DQK + (tid + 512) * 8); \
      rv0 = *(const uint4*)(vbase + (size_t)(tid >> 3) * SP + (kp) + (tid & 7) * 8); \
      rv1 = *(const uint4*)(vbase + (size_t)((tid >> 3) + 32) * SP + (kp) + (tid & 7) * 8); } while (0)
    { const int kp0 = KPOS_OF(0); ATT_GLOAD(kp0); }
    for (int ti = 0; ti < ntiles; ++ti) {
      __syncthreads();
      { int c = tid; *(uint4*)(Ks + (c / (DQK / 8)) * KP + (c % (DQK / 8)) * 8) = rk0; }
      { int c = tid + 256; *(uint4*)(Ks + (c / (DQK / 8)) * KP + (c % (DQK / 8)) * 8) = rk1; }
      if (KCH > 2) { int c = tid + 512; *(uint4*)(Ks + (c / (DQK / 8)) * KP + (c % (DQK / 8)) * 8) = rk2; }
      *(uint4*)(Vs + (tid >> 3) * 72 + (tid & 7) * 8) = rv0;
      *(uint4*)(Vs + ((tid >> 3) + 32) * 72 + (tid & 7) * 8) = rv1;
      if (NA && ti == 0) { for (int q = tid; q < 465; q += NTHR) rpbs[q] = rpb[hq * 465 + q]; }
      __syncthreads();
      if (ti + 1 < ntiles) { const int kp1 = KPOS_OF(ti + 1); ATT_GLOAD(kp1); }
      bool active = true;
      int jrow = 0;
      if (NA && lat && ti >= 4) { jrow = rs0 + ti - 4; active = (jrow >= rsw) && (jrow < rsw + 8); }
      if (active) {
        f32x16 s0, s1;
#pragma unroll
        for (int i = 0; i < 16; ++i) { s0[i] = 0.f; s1[i] = 0.f; }
#pragma unroll
        for (int kk = 0; kk < NKK; ++kk) {
          bf16x8 k0 = *(const bf16x8*)(Ks + r * KP + 16 * kk + 8 * h);
          bf16x8 k1 = *(const bf16x8*)(Ks + (32 + r) * KP + 16 * kk + 8 * h);
          s0 = MFMA32(k0, qf[kk], s0);
          s1 = MFMA32(k1, qf[kk], s1);
        }
        if (NA && lat && ti >= 4) {
          const int qc = (w & 1) * 32 + r;
          const int cs = min(max(qc - 8, 0), 48);
          const float* brow = rpbs + (jrow - rw + 7) * 31 + (15 - qc);
#pragma unroll
          for (int i = 0; i < 16; ++i) {
            int kc0 = (i & 3) + 8 * (i >> 2) + 4 * h, kc1 = kc0 + 32;
            bool v0 = (kc0 >= cs) && (kc0 < cs + 16), v1 = (kc1 >= cs) && (kc1 < cs + 16);
            float b0 = v0 ? brow[kc0] : 0.f, b1 = v1 ? brow[kc1] : 0.f;
            s0[i] = v0 ? (s0[i] * sl2 + b0 * LOG2E) : -1e30f;
            s1[i] = v1 ? (s1[i] * sl2 + b1 * LOG2E) : -1e30f;
          }
        } else {
#pragma unroll
          for (int i = 0; i < 16; ++i) { s0[i] *= sl2; s1[i] *= sl2; }
        }
        float tm = s0[0];
#pragma unroll
        for (int i = 1; i < 16; ++i) tm = fmaxf(tm, s0[i]);
#pragma unroll
        for (int i = 0; i < 16; ++i) tm = fmaxf(tm, s1[i]);
        tm = fmaxf(tm, __shfl_xor(tm, 32));
        const float mn = fmaxf(m, tm);
        const float alpha = __builtin_amdgcn_exp2f(m - mn);
        m = mn;
        float ps = 0.f;
#pragma unroll
        for (int i = 0; i < 16; ++i) { s0[i] = __builtin_amdgcn_exp2f(s0[i] - mn); ps += s0[i]; s1[i] = __builtin_amdgcn_exp2f(s1[i] - mn); ps += s1[i]; }
        l = l * alpha + ps;
#pragma unroll
        for (int i = 0; i < 16; ++i) { o0[i] *= alpha; o1[i] *= alpha; }
#pragma unroll
        for (int kt = 0; kt < 2; ++kt) {
#pragma unroll
          for (int sp = 0; sp < 2; ++sp) {
            u32x4 pu;
            pu[0] = pack2(kt ? s1[8 * sp + 0] : s0[8 * sp + 0], kt ? s1[8 * sp + 1] : s0[8 * sp + 1]);
            pu[1] = pack2(kt ? s1[8 * sp + 2] : s0[8 * sp + 2], kt ? s1[8 * sp + 3] : s0[8 * sp + 3]);
            pu[2] = pack2(kt ? s1[8 * sp + 4] : s0[8 * sp + 4], kt ? s1[8 * sp + 5] : s0[8 * sp + 5]);
            pu[3] = pack2(kt ? s1[8 * sp + 6] : s0[8 * sp + 6], kt ? s1[8 * sp + 7] : s0[8 * sp + 7]);
            const bf16x8 pfv = __builtin_bit_cast(bf16x8, pu);
            const int ko = 32 * kt + 16 * sp + 4 * h;
            const uint2 a0 = *(const uint2*)(Vs + r * 72 + ko), a1 = *(const uint2*)(Vs + r * 72 + ko + 8);
            const uint2 c0 = *(const uint2*)(Vs + (32 + r) * 72 + ko), c1 = *(const uint2*)(Vs + (32 + r) * 72 + ko + 8);
            u32x4 vau, vbu;
            vau[0] = a0.x; vau[1] = a0.y; vau[2] = a1.x; vau[3] = a1.y;
            vbu[0] = c0.x; vbu[1] = c0.y; vbu[2] = c1.x; vbu[3] = c1.y;
            const bf16x8 vav = __builtin_bit_cast(bf16x8, vau), vbv = __builtin_bit_cast(bf16x8, vbu);
            o0 = MFMA32(vav, pfv, o0);
            o1 = MFMA32(vbv, pfv, o1);
          }
        }
      }
    }
    l += __shfl_xor(l, 32);
    const float inv = 1.f / l;
    const int R = tok_row(b, qpos);
    u16* op = mix + (size_t)R * 1024 + coloff + hq * 64 + 4 * h;
#pragma unroll
    for (int g4 = 0; g4 < 4; ++g4) {
      uint2 a, c;
      a.x = pack2(o0[4 * g4] * inv, o0[4 * g4 + 1] * inv); a.y = pack2(o0[4 * g4 + 2] * inv, o0[4 * g4 + 3] * inv);
      c.x = pack2(o1[4 * g4] * inv, o1[4 * g4 + 1] * inv); c.y = pack2(o1[4 * g4 + 2] * inv, o1[4 * g4 + 3] * inv);
      *(uint2*)(op + 8 * g4) = a;
      *(uint2*)(op + 32 + 8 * g4) = c;
    }
  }
  __syncthreads();
}

DI void s5_pass1(const P& p, int j, char* smem) {
  const int tid = otid(), lane = tid & 63, w = tid >> 6;
  const float* U = (const float*)(p.ws + E_U);
  float2* E = (float2*)(p.ws + E_E);
  const float2* SA = (const float2*)(p.ws + OFF_SA);
  const float* SBB = (const float*)(p.ws + OFF_SBB);
  float* us = (float*)smem + w * 1024;
  for (int item = blockIdx.x; item < 4608; item += gridDim.x) {
    const int unit = item * 4 + w;
    const int c = unit % 36; const int t1 = unit / 36; const int dir = t1 & 1; const int t2 = t1 >> 1; const int g = t2 & 15; const int b = t2 >> 4;
#pragma unroll
    for (int i = 0; i < 4; ++i) {
      int idx = lane + 64 * i; int step = idx >> 2, quad = idx & 3;
      int tau = 64 * c + step;
      int pos = dir ? (tau < 256 ? 255 - tau : 2559 - tau) : tau;
      int row = tok_row(b, pos);
      *(float4*)(us + step * 16 + quad * 4) = *(const float4*)(U + (size_t)row * 256 + 16 * g + 4 * quad);
    }
    const int tidx = ((j * 2 + dir) * 16 + g) * 64 + lane;
    const float2 a = SA[tidx];
    float bbr[16], bbi[16];
#pragma unroll
    for (int q = 0; q < 4; ++q) {
      float4 t = *(const float4*)(SBB + (size_t)tidx * 32 + 4 * q); bbr[4 * q] = t.x; bbr[4 * q + 1] = t.y; bbr[4 * q + 2] = t.z; bbr[4 * q + 3] = t.w;
      float4 t2_ = *(const float4*)(SBB + (size_t)tidx * 32 + 16 + 4 * q); bbi[4 * q] = t2_.x; bbi[4 * q + 1] = t2_.y; bbi[4 * q + 2] = t2_.z; bbi[4 * q + 3] = t2_.w;
    }
    __builtin_amdgcn_wave_barrier();
    float hr = 0.f, hi = 0.f;
#pragma unroll 4
    for (int step = 0; step < 64; ++step) {
      float bur = 0.f, bui = 0.f;
#pragma unroll
      for (int q = 0; q < 4; ++q) {
        float4 uv = *(const float4*)(us + step * 16 + 4 * q);
        bur += bbr[4 * q] * uv.x + bbr[4 * q + 1] * uv.y + bbr[4 * q + 2] * uv.z + bbr[4 * q + 3] * uv.w;
        bui += bbi[4 * q] * uv.x + bbi[4 * q + 1] * uv.y + bbi[4 * q + 2] * uv.z + bbi[4 * q + 3] * uv.w;
      }
      float nr = a.x * hr - a.y * hi + bur;
      float ni = a.x * hi + a.y * hr + bui;
      hr = nr; hi = ni;
    }
    E[((((size_t)b * 16 + g) * 2 + dir) * 36 + c) * 64 + lane] = make_float2(hr, hi);
    __syncthreads();
  }
}

DI void s5_pass2(const P& p, int j, char* smem) {
  const int tid = otid(), lane = tid & 63, w = tid >> 6;
  const float* U = (const float*)(p.ws + E_U);
  const float2* E = (const float2*)(p.ws + E_E);
  const float2* SA = (const float2*)(p.ws + OFF_SA);
  const float2* SAL = (const float2*)(p.ws + OFF_SAL);
  const float* SBB = (const float*)(p.ws + OFF_SBB);
  u16* YG = (u16*)(p.ws + E_YG);
  char* wb = smem + w * 12544;
  float* us = (float*)wb; u16* Hs = (u16*)(wb + 4096); float* ys = (float*)(wb + 4096 + 4352);
  const int pcol = lane & 15, fq = lane >> 4;
  for (int item = blockIdx.x; item < 4608; item += gridDim.x) {
    const int Pc = item % 36; const int t1 = item / 36; const int gp = t1 & 7; const int b = t1 >> 3;
    const int g = gp * 2 + (w >> 1), dir = w & 1;
#pragma unroll
    for (int i = 0; i < 4; ++i) {
      int idx = lane + 64 * i; int k = idx >> 2, quad = idx & 3;
      int lt = dir ? 63 - k : k;
      int row = tok_row(b, 64 * Pc + lt);
      *(float4*)(us + k * 16 + quad * 4) = *(const float4*)(U + (size_t)row * 256 + 16 * g + 4 * quad);
    }
    const int tidx = ((j * 2 + dir) * 16 + g) * 64 + lane;
    const float2 a = SA[tidx], aL = SAL[tidx];
    float bbr[16], bbi[16];
#pragma unroll
    for (int q = 0; q < 4; ++q) {
      float4 t = *(const float4*)(SBB + (size_t)tidx * 32 + 4 * q); bbr[4 * q] = t.x; bbr[4 * q + 1] = t.y; bbr[4 * q + 2] = t.z; bbr[4 * q + 3] = t.w;
      float4 t2_ = *(const float4*)(SBB + (size_t)tidx * 32 + 16 + 4 * q); bbi[4 * q] = t2_.x; bbi[4 * q + 1] = t2_.y; bbi[4 * q + 2] = t2_.z; bbi[4 * q + 3] = t2_.w;
    }
    const int c = dir ? (Pc < 4 ? 3 - Pc : 39 - Pc) : Pc;
    float hr = 0.f, hi = 0.f;
    {
      const float2* Eb = E + ((((size_t)b * 16 + g) * 2 + dir) * 36) * 64 + lane;
      for (int cc = 0; cc < c; ++cc) {
        float2 e = Eb[(size_t)cc * 64];
        float nr = aL.x * hr - aL.y * hi + e.x;
        float ni = aL.x * hi + aL.y * hr + e.y;
        hr = nr; hi = ni;
      }
    }
    bf16x8 cf[4];
    {
      const size_t cbase = ((size_t)((j * 2 + dir) * 16 + g) * 16 + pcol) * 64;
#pragma unroll
      for (int ks = 0; ks < 4; ++ks) {
        const float* src = (ks < 2 ? p.c_re : p.c_im) + cbase + 32 * (ks & 1) + 8 * fq;
        float4 t0 = *(const float4*)src, t1_ = *(const float4*)(src + 4);
        const float sg = ks < 2 ? 1.f : -1.f;
        u32x4 cu;
        cu[0] = pack2(sg * t0.x, sg * t0.y); cu[1] = pack2(sg * t0.z, sg * t0.w);
        cu[2] = pack2(sg * t1_.x, sg * t1_.y); cu[3] = pack2(sg * t1_.z, sg * t1_.w);
        cf[ks] = __builtin_bit_cast(bf16x8, cu);
      }
    }
    __builtin_amdgcn_wave_barrier();
#pragma unroll 1
    for (int sub = 0; sub < 4; ++sub) {
#pragma unroll 4
      for (int k16 = 0; k16 < 16; ++k16) {
        const int k = sub * 16 + k16;
        float bur = 0.f, bui = 0.f;
#pragma unroll
        for (int q = 0; q < 4; ++q) {
          float4 uv = *(const float4*)(us + k * 16 + 4 * q);
          bur += bbr[4 * q] * uv.x + bbr[4 * q + 1] * uv.y + bbr[4 * q + 2] * uv.z + bbr[4 * q + 3] * uv.w;
          bui += bbi[4 * q] * uv.x + bbi[4 * q + 1] * uv.y + bbi[4 * q + 2] * uv.z + bbi[4 * q + 3] * uv.w;
        }
        float nr = a.x * hr - a.y * hi + bur;
        float ni = a.x * hi + a.y * hr + bui;
        hr = nr; hi = ni;
        Hs[k16 * 136 + lane] = f2bf(hr);
        Hs[k16 * 136 + 64 + lane] = f2bf(hi);
      }
      __builtin_amdgcn_wave_barrier();
      f32x4 acc = {0.f, 0.f, 0.f, 0.f};
#pragma unroll
      for (int ks = 0; ks < 4; ++ks) {
        bf16x8 af = *(const bf16x8*)(Hs + pcol * 136 + 32 * ks + 8 * fq);
        acc = MFMA16(af, cf[ks], acc);
      }
#pragma unroll
      for (int jj = 0; jj < 4; ++jj) {
        int k = sub * 16 + 4 * fq + jj;
        int lt = dir ? 63 - k : k;
        ys[lt * 16 + pcol] = acc[jj];
      }
      __builtin_amdgcn_wave_barrier();
    }
    __syncthreads();
#pragma unroll
    for (int i = 0; i < 8; ++i) {
      int idx = tid + 256 * i; int gi = idx >> 10, lt = (idx >> 4) & 63, pp = idx & 15;
      const char* w0 = smem + (2 * gi) * 12544; const char* w1 = smem + (2 * gi + 1) * 12544;
      const int gg = gp * 2 + gi;
      float y = ((const float*)(w0 + 8448))[lt * 16 + pp] + ((const float*)(w1 + 8448))[lt * 16 + pp]
              + p.ssm_d[j * 256 + 16 * gg + pp] * ((const float*)w0)[lt * 16 + pp];
      float t = 0.7978845608028654f * (y + 0.044715f * y * y * y);
      float ge = 0.5f * y * (1.f + tanhf(t));
      int row = tok_row(b, 64 * Pc + lt);
      YG[(size_t)row * 256 + 16 * gg + pp] = f2bf(ge);
    }
    __syncthreads();
  }
}

__global__ void __launch_bounds__(NTHR, 2) fwd_megakernel(P p) {
  __shared__ __attribute__((aligned(16))) char smem[SMEM_BYTES];
  cg::grid_group grid = cg::this_grid();
  char* ws = p.ws;
  float* XC = (float*)(ws + OFF_XC);
  u16* ABUF = (u16*)(ws + OFF_ABUF);
  const float* modv = (const float*)(ws + OFF_MODV);

  prologue(p, smem);
  grid.sync();

  for (int layer = 0; layer < 4; ++layer) {
    const int j = layer >> 1;
    const bool need_ctx = layer < 3;
    const float* xs_lat = layer == 0 ? p.x : p.out;
    const float* xs_ctx = layer == 0 ? p.ctx : XC;
    const float* modl = modv + (size_t)layer * 17 * 6144;
    EpiArgs ea;
    ea.j = j; ea.gate = modl + 2 * 1024; ea.src_lat = xs_lat; ea.src_ctx = xs_ctx; ea.dst_lat = p.out; ea.dst_ctx = XC;

    norm_phase(xs_lat, xs_ctx, p.g_norm1 + layer * 1024, modl, 0, 1, NTOK, ABUF);
    ff_convert(p, layer, smem);
    grid.sync();

    if ((layer & 1) == 0) {
      gemm_phase<EPI_EVEN_IN>(p, ABUF, (const u16*)(ws + OFF_EIN + j * SZ_EIN), 1024, 288, 12, 6, ea, smem);
      grid.sync();
      s5_pass1(p, j, smem);
      attn_phase<64, false>((const u16*)(ws + E_Q), (const u16*)(ws + E_K), (const u16*)(ws + E_VT), 12, 4, 0.125f, ABUF, 0, need_ctx, nullptr, smem);
      grid.sync();
      s5_pass2(p, j, smem);
      grid.sync();
      gemm_phase<EPI_GLU>(p, (const u16*)(ws + E_YG), (const u16*)(ws + OFF_GLU + j * SZ_GLU), 256, 288, 2, 6, ea, smem);
      grid.sync();
    } else {
      gemm_phase<EPI_ODD_IN>(p, ABUF, (const u16*)(ws + OFF_OIN + j * SZ_OIN), 1024, 288, 19, 6, ea, smem);
      grid.sync();
      gemm_phase<EPI_UQ>(p, (const u16*)(ws + O_CQ), (const u16*)(ws + OFF_UQ + j * SZ_UQ), 512, 288, 8, 6, ea, smem);
      gemm_phase<EPI_UKV>(p, (const u16*)(ws + O_CKV), (const u16*)(ws + OFF_UKV + j * SZ_UKV), 256, 288, 8, 6, ea, smem);
      attn_phase<64, true>((const u16*)(ws + O_NQ), (const u16*)(ws + O_NK), (const u16*)(ws + O_NVT), 8, 8, 0.125f, ABUF, 512, need_ctx,
                           p.rpb + (size_t)j * 8 * 465, smem);
      grid.sync();
      attn_phase<96, false>((const u16*)(ws + O_MQ), (const u16*)(ws + O_MK), (const u16*)(ws + O_MVT), 8, 8, 0.10206207261596577f, ABUF, 0,
                            need_ctx, nullptr, smem);
      grid.sync();
    }
    const int mt = need_ctx ? 288 : 256;
    const int band = need_ctx ? 6 : 8;
    gemm_phase<EPI_RESID>(p, ABUF, (const u16*)(ws + ((layer & 1) ? OFF_OOUT : OFF_EOUT) + j * SZ_SQ), 1024, mt, 8, band, ea, smem);
    grid.sync();
    norm_phase(p.out, XC, p.g_norm2 + layer * 1024, modl, 3, 4, need_ctx ? NTOK : NLAT, ABUF);
    grid.sync();
    gemm_phase<EPI_RELU2>(p, ABUF, (const u16*)(ws + OFF_FF1), 1024, mt, 32, band, ea, smem);
    grid.sync();
    ea.gate = modl + 5 * 1024; ea.src_lat = p.out; ea.src_ctx = XC;
    gemm_phase<EPI_RESID>(p, (const u16*)(ws + OFF_H), (const u16*)(ws + OFF_FF2), 4096, mt, 8, band, ea, smem);
    grid.sync();
  }
}

extern "C" void kernel_launch(void* const* d_in, const int* in_sizes, int n_in, void* d_out, int out_size, void* d_ws, size_t ws_size,
                              hipStream_t stream) {
  static int grid_blocks = 0;
  if (!grid_blocks) {
    int dev = 0, cus = 0, per_cu = 0;
    hipGetDevice(&dev);
    hipDeviceGetAttribute(&cus, hipDeviceAttributeMultiprocessorCount, dev);
    hipOccupancyMaxActiveBlocksPerMultiprocessor(&per_cu, fwd_megakernel, NTHR, 0);
    if (per_cu > 2) per_cu = 2;
    if (per_cu < 1) per_cu = 1;
    grid_blocks = cus * per_cu;
    grid_blocks &= ~7;
  }
  P p{};
  const float** f = (const float**)&p;
  for (int i = 0; i < 35; ++i) f[i] = (const float*)d_in[i];
  p.out = (float*)d_out;
  p.ws = (char*)d_ws;
  void* args[] = {&p};
  hipError_t e = hipLaunchCooperativeKernel((void*)fwd_megakernel, dim3(grid_blocks), dim3(NTHR), args, 0, stream);
  if (e != hipSuccess) fprintf(stderr, "cooperative launch failed: %s (grid %d)\n", hipGetErrorString(e), grid_blocks);
}
```

```cpp
#include <hip/hip_runtime.h>
#include <hip/hip_cooperative_groups.h>
#include <cstdio>
namespace cg = cooperative_groups;

typedef unsigned short u16;
using bf16x8 = __attribute__((ext_vector_type(8))) short;
using f32x16 = __attribute__((ext_vector_type(16))) float;
using f32x4 = __attribute__((ext_vector_type(4))) float;
typedef __attribute__((ext_vector_type(2))) __bf16 bf2_t;
using u32x4 = __attribute__((ext_vector_type(4))) unsigned;
#define DI __device__ __forceinline__
#define MFMA32(a, b, c) __builtin_amdgcn_mfma_f32_32x32x16_bf16((a), (b), (c), 0, 0, 0)
#define MFMA16(a, b, c) __builtin_amdgcn_mfma_f32_16x16x32_bf16((a), (b), (c), 0, 0, 0)

#ifndef DUP_MASK
#define DUP_MASK 0
#endif
#define DUPN(bit) (((DUP_MASK) >> (bit)) & 1 ? 2 : 1)
constexpr int NTHR = 256;
constexpr int NLAT = 32768, NTOK = 36864, SP = 2304;
constexpr float EPSF = 1e-6f;
constexpr float LOG2E = 1.4426950408889634f;
constexpr int SMEM_BYTES = 73728;
constexpr int CP = 132;

constexpr size_t SZ_EIN = 1536ull * 1024 * 2, SZ_SQ = 1024ull * 1024 * 2, SZ_OIN = 2432ull * 1024 * 2;
constexpr size_t SZ_UQ = 1024ull * 512 * 2, SZ_UKV = 1024ull * 256 * 2, SZ_GLU = 256ull * 256 * 2;
constexpr size_t OFF_EIN = 0;
constexpr size_t OFF_EOUT = OFF_EIN + 2 * SZ_EIN;
constexpr size_t OFF_OIN = OFF_EOUT + 2 * SZ_SQ;
constexpr size_t OFF_OOUT = OFF_OIN + 2 * SZ_OIN;
constexpr size_t OFF_UQ = OFF_OOUT + 2 * SZ_SQ;
constexpr size_t OFF_UKV = OFF_UQ + 2 * SZ_UQ;
constexpr size_t OFF_GLU = OFF_UKV + 2 * SZ_UKV;
constexpr size_t OFF_FF1 = OFF_GLU + 2 * SZ_GLU;
constexpr size_t OFF_FF2 = OFF_FF1 + 4096ull * 1024 * 2;
constexpr size_t OFF_MODV = OFF_FF2 + 4096ull * 1024 * 2;
constexpr size_t OFF_ROPE = OFF_MODV + 4ull * 17 * 6144 * 4;
constexpr size_t OFF_SA = OFF_ROPE + 16384;
constexpr size_t OFF_SAL = OFF_SA + 4096 * 8;
constexpr size_t OFF_SBB = OFF_SAL + 4096 * 8;
constexpr size_t OFF_XC = OFF_SBB + 4096ull * 32 * 4;
constexpr size_t OFF_ABUF = OFF_XC + 4096ull * 1024 * 4;
constexpr size_t OFF_R1 = OFF_ABUF + (size_t)NTOK * 1024 * 2;
constexpr size_t E_Q = OFF_R1;
constexpr size_t E_K = E_Q + 16ull * 12 * SP * 64 * 2;
constexpr size_t E_VT = E_K + 16ull * 4 * SP * 64 * 2;
constexpr size_t E_U = E_VT + 16ull * 4 * SP * 64 * 2;
constexpr size_t E_E = E_U + (size_t)NTOK * 256 * 4;
constexpr size_t E_YG = E_E + 16ull * 16 * 2 * 36 * 64 * 8;
constexpr size_t O_CQ = OFF_R1;
constexpr size_t O_CKV = O_CQ + (size_t)NTOK * 512 * 2;
constexpr size_t O_KR = O_CKV + (size_t)NTOK * 256 * 2;
constexpr size_t O_PS = O_KR + (size_t)NTOK * 32 * 4;
constexpr size_t O_NQ = O_PS + (size_t)NTOK * 8 * 4;
constexpr size_t O_NK = O_NQ + 16ull * 8 * SP * 64 * 2;
constexpr size_t O_NVT = O_NK + 16ull * 8 * SP * 64 * 2;
constexpr size_t O_MQ = O_NVT + 16ull * 8 * SP * 64 * 2;
constexpr size_t O_MK = O_MQ + 16ull * 8 * SP * 96 * 2;
constexpr size_t O_MVT = O_MK + 16ull * 8 * SP * 96 * 2;
constexpr size_t O_END = O_MVT + 16ull * 8 * SP * 64 * 2;
constexpr size_t OFF_H = OFF_R1;

struct P {
  const float *x, *c, *ctx, *c_ctx, *w_mod, *b_mod, *g_norm1, *g_norm2, *w_ff1, *w_ff2;
  const float *e_w_in, *e_w_out, *e_g_q, *e_g_k, *lam_re, *lam_im, *log_dt, *b_re, *b_im, *c_re, *c_im, *ssm_d, *w_glu, *b_glu;
  const float *o_w_in, *o_w_out, *g_cq, *g_ckv, *w_uq, *w_ukv, *g_mq, *g_mk, *g_nq, *g_nk, *rpb;
  float* out;
  char* ws;
};

DI unsigned pack2(float a, float b) { bf2_t v; v[0] = (__bf16)a; v[1] = (__bf16)b; return __builtin_bit_cast(unsigned, v); }
DI u16 f2bf(float a) { __bf16 v = (__bf16)a; return __builtin_bit_cast(u16, v); }
DI float bf2f(u16 v) { return __uint_as_float(((unsigned)v) << 16); }
DI int otid() { int t = threadIdx.x; asm volatile("" : "+v"(t)); return t; }
DI int tok_row(int b, int pos) { return pos < 256 ? NLAT + b * 256 + pos : b * 2048 + pos - 256; }

DI int map_col(int mapk, int n, int N) {
  if (mapk == 0) return n < N ? n : -1;
  if (mapk == 1) { if (n < 768) return n; if (n < 2304) return n + 32; if (n < 2336) return n - 2304 + 768; return -1; }
  int h = n >> 7, jj = n & 127; return jj < 96 ? h * 96 + jj : -1;
}
DI void tr_tile(const float* __restrict__ src, int K, int N, int Npad, int mapk, const float* __restrict__ ks,
                        u16* __restrict__ dst, int tile, char* smem) {
  float* tl = (float*)smem;
  const int tid = otid();
  const int tnn = Npad >> 6;
  const int n0 = (tile % tnn) * 64, k0 = (tile / tnn) * 64;
  const int nn = tid & 63;
  const int sn = map_col(mapk, n0 + nn, N);
#pragma unroll 4
  for (int i = 0; i < 16; ++i) {
    int kk = (tid >> 6) + 4 * i;
    float v = 0.f;
    if (sn >= 0) { v = src[(size_t)(k0 + kk) * N + sn]; if (ks) v *= ks[k0 + kk]; }
    tl[kk * 65 + nn] = v;
  }
  __syncthreads();
#pragma unroll 4
  for (int i = 0; i < 16; ++i) {
    int n2 = (tid >> 6) + 4 * i, kk = tid & 63;
    dst[(size_t)(n0 + n2) * K + k0 + kk] = f2bf(tl[kk * 65 + n2]);
  }
  __syncthreads();
}

DI void ff_convert(const P& p, int layer, char* smem) {
  u16* f1 = (u16*)(p.ws + OFF_FF1);
  u16* f2 = (u16*)(p.ws + OFF_FF2);
  const float* s1 = p.w_ff1 + (size_t)layer * 1024 * 4096;
  const float* s2 = p.w_ff2 + (size_t)layer * 4096 * 1024;
  for (int t = gridDim.x - 1 - blockIdx.x; t < 2048; t += gridDim.x) {
    if (t < 1024) tr_tile(s1, 1024, 4096, 4096, 0, nullptr, f1, t, smem);
    else tr_tile(s2, 4096, 1024, 1024, 0, nullptr, f2, t - 1024, smem);
  }
}

DI void prologue(const P& p, char* smem) {
  const int tid = otid();
  float* modv = (float*)(p.ws + OFF_MODV);
  for (int it = blockIdx.x; it < 384; it += gridDim.x) {
    float* cond = (float*)smem;
    for (int idx = tid; idx < 17 * 1024; idx += NTHR) {
      int bb = idx >> 10, k = idx & 1023;
      float v = bb < 16 ? p.c[bb * 1024 + k] : p.c_ctx[k];
      cond[idx] = v / (1.f + __expf(-v));
    }
    __syncthreads();
    const int l = it / 96, n = (it % 96) * 64 + (tid & 63), kq = tid >> 6;
    float acc[17];
#pragma unroll
    for (int i = 0; i < 17; ++i) acc[i] = 0.f;
    const float* wp = p.w_mod + ((size_t)l * 1024 + kq * 256) * 6144 + n;
    for (int k4 = 0; k4 < 64; ++k4) {
      float w0 = wp[(size_t)(k4 * 4 + 0) * 6144], w1 = wp[(size_t)(k4 * 4 + 1) * 6144];
      float w2 = wp[(size_t)(k4 * 4 + 2) * 6144], w3 = wp[(size_t)(k4 * 4 + 3) * 6144];
#pragma unroll
      for (int bb = 0; bb < 17; ++bb) {
        float4 c4 = *(const float4*)(cond + bb * 1024 + kq * 256 + k4 * 4);
        acc[bb] += c4.x * w0 + c4.y * w1 + c4.z * w2 + c4.w * w3;
      }
    }
    __syncthreads();
    float* red = (float*)smem;
#pragma unroll
    for (int bb = 0; bb < 17; ++bb) red[(kq * 17 + bb) * 64 + (tid & 63)] = acc[bb];
    __syncthreads();
    for (int o = tid; o < 17 * 64; o += NTHR) {
      int bb = o >> 6, nn = o & 63;
      int ncol = (it % 96) * 64 + nn;
      float s = red[(0 * 17 + bb) * 64 + nn] + red[(1 * 17 + bb) * 64 + nn] + red[(2 * 17 + bb) * 64 + nn] + red[(3 * 17 + bb) * 64 + nn];
      modv[((size_t)l * 17 + bb) * 6144 + ncol] = s + p.b_mod[l * 6144 + ncol];
    }
    __syncthreads();
  }
  {
    float* rt = (float*)(p.ws + OFF_ROPE);
    for (int idx = blockIdx.x * NTHR + tid; idx < 1024 + 512; idx += gridDim.x * NTHR) {
      if (idx < 1024) {
        int pos = idx >> 4, i = idx & 15;
        float f = powf(10000.f, -(float)(2 * i) / 32.f);
        float a = (float)pos * f;
        rt[idx] = cosf(a); rt[1024 + idx] = sinf(a);
      } else {
        int q = idx - 1024; int pos = q >> 3, i = q & 7;
        float f = powf(10000.f, -(float)(2 * i) / 16.f);
        float a = (float)pos * f;
        rt[2048 + q] = cosf(a); rt[2560 + q] = sinf(a);
      }
    }
    float2* SA = (float2*)(p.ws + OFF_SA);
    float2* SAL = (float2*)(p.ws + OFF_SAL);
    float* SBB = (float*)(p.ws + OFF_SBB);
    for (int idx = blockIdx.x * NTHR + tid; idx < 4096; idx += gridDim.x * NTHR) {
      float lre = p.lam_re[idx], lim = p.lam_im[idx];
      float dt = expf(p.log_dt[idx >> 6]);
      float mag = expf(lre * dt);
      float are = mag * cosf(lim * dt), aim = mag * sinf(lim * dt);
      float den = lre * lre + lim * lim;
      float fre = ((are - 1.f) * lre + aim * lim) / den;
      float fim = (aim * lre - (are - 1.f) * lim) / den;
      SA[idx] = make_float2(are, aim);
      float pr = are, pi = aim;
#pragma unroll
      for (int q = 0; q < 6; ++q) { float nr = pr * pr - pi * pi, ni = 2.f * pr * pi; pr = nr; pi = ni; }
      SAL[idx] = make_float2(pr, pi);
#pragma unroll
      for (int q = 0; q < 16; ++q) {
        float br = p.b_re[(size_t)idx * 16 + q], bi = p.b_im[(size_t)idx * 16 + q];
        SBB[(size_t)idx * 32 + q] = fre * br - fim * bi;
        SBB[(size_t)idx * 32 + 16 + q] = fre * bi + fim * br;
      }
    }
  }
  for (int t = gridDim.x - 1 - blockIdx.x; t < 3424; t += gridDim.x) {
    int j = t / 1712, r = t % 1712;
    if (r < 384) tr_tile(p.e_w_in + (size_t)j * 1024 * 1536, 1024, 1536, 1536, 0, nullptr, (u16*)(p.ws + OFF_EIN + j * SZ_EIN), r, smem);
    else if (r < 640) tr_tile(p.e_w_out + (size_t)j * 1024 * 1024, 1024, 1024, 1024, 0, nullptr, (u16*)(p.ws + OFF_EOUT + j * SZ_SQ), r - 384, smem);
    else if (r < 1248) tr_tile(p.o_w_in + (size_t)j * 1024 * 2336, 1024, 2336, 2432, 1, nullptr, (u16*)(p.ws + OFF_OIN + j * SZ_OIN), r - 640, smem);
    else if (r < 1504) tr_tile(p.o_w_out + (size_t)j * 1024 * 1024, 1024, 1024, 1024, 0, nullptr, (u16*)(p.ws + OFF_OOUT + j * SZ_SQ), r - 1248, smem);
    else if (r < 1632) tr_tile(p.w_uq + (size_t)j * 512 * 768, 512, 768, 1024, 2, p.g_cq + j * 512, (u16*)(p.ws + OFF_UQ + j * SZ_UQ), r - 1504, smem);
    else if (r < 1696) tr_tile(p.w_ukv + (size_t)j * 256 * 1024, 256, 1024, 1024, 0, p.g_ckv + j * 256, (u16*)(p.ws + OFF_UKV + j * SZ_UKV), r - 1632, smem);
    else tr_tile(p.w_glu + (size_t)j * 256 * 256, 256, 256, 256, 0, nullptr, (u16*)(p.ws + OFF_GLU + j * SZ_GLU), r - 1696, smem);
  }
}

DI void norm_phase(const float* __restrict__ xl, const float* __restrict__ xc, const float* __restrict__ g,
                           const float* __restrict__ modl, int shift_i, int scale_i, int nrows, u16* __restrict__ dst) {
  const int tid_ = otid();
  const int lane = tid_ & 63;
  const int gw = blockIdx.x * 4 + (tid_ >> 6);
  for (int R = gw; R < nrows; R += gridDim.x * 4) {
    const float* src = R < NLAT ? xl + (size_t)R * 1024 : xc + (size_t)(R - NLAT) * 1024;
    const int mrow = R < NLAT ? (R >> 11) : 16;
    float4 v[4];
    float ss = 0.f;
#pragma unroll
    for (int i = 0; i < 4; ++i) {
      v[i] = *(const float4*)(src + lane * 4 + 256 * i);
      ss += v[i].x * v[i].x + v[i].y * v[i].y + v[i].z * v[i].z + v[i].w * v[i].w;
    }
#pragma unroll
    for (int o = 32; o >= 1; o >>= 1) ss += __shfl_xor(ss, o);
    const float rstd = rsqrtf(ss * (1.f / 1024.f) + EPSF);
    const float* sh = modl + (size_t)mrow * 6144 + shift_i * 1024;
    const float* sc = modl + (size_t)mrow * 6144 + scale_i * 1024;
#pragma unroll
    for (int i = 0; i < 4; ++i) {
      int col = lane * 4 + 256 * i;
      float4 gg = *(const float4*)(g + col), s4 = *(const float4*)(sh + col), c4 = *(const float4*)(sc + col);
      float y0 = v[i].x * rstd * gg.x * (1.f + c4.x) + s4.x;
      float y1 = v[i].y * rstd * gg.y * (1.f + c4.y) + s4.y;
      float y2 = v[i].z * rstd * gg.z * (1.f + c4.z) + s4.z;
      float y3 = v[i].w * rstd * gg.w * (1.f + c4.w) + s4.w;
      uint2 o2; o2.x = pack2(y0, y1); o2.y = pack2(y2, y3);
      *(uint2*)(dst + (size_t)R * 1024 + col) = o2;
    }
  }
}

enum { EPI_EVEN_IN = 0, EPI_ODD_IN, EPI_UQ, EPI_UKV, EPI_GLU, EPI_RESID, EPI_RELU2 };

struct EpiArgs {
  int j;
  const float* gate;
  const float* src_lat; const float* src_ctx; float* dst_lat; float* dst_ctx;
};

DI void store16(u16* dst, const float* y) {
  uint4 a, b;
  a.x = pack2(y[0], y[1]); a.y = pack2(y[2], y[3]); a.z = pack2(y[4], y[5]); a.w = pack2(y[6], y[7]);
  b.x = pack2(y[8], y[9]); b.y = pack2(y[10], y[11]); b.z = pack2(y[12], y[13]); b.w = pack2(y[14], y[15]);
  *(uint4*)dst = a; *(uint4*)(dst + 8) = b;
}
DI void load16(const float* s, float* v) {
#pragma unroll
  for (int q = 0; q < 4; ++q) { float4 t = *(const float4*)(s + 4 * q); v[4 * q] = t.x; v[4 * q + 1] = t.y; v[4 * q + 2] = t.z; v[4 * q + 3] = t.w; }
}

DI void epi_head64(const P& p, const float* Cs, int b, int pos0, bool isctx, const float* __restrict__ g, bool rope,
                   u16* __restrict__ dstbase, int H, int head0) {
  const int tid = otid(), sub = tid & 7, hh = sub >> 2, jq = sub & 3;
  const float* rt = (const float*)(p.ws + OFF_ROPE);
#pragma unroll 1
  for (int pass = 0; pass < 4; ++pass) {
    const int row = pass * 32 + (tid >> 3);
    float v[16], pv[16];
    load16(Cs + row * CP + 16 * sub, v);
    float ss = 0.f;
#pragma unroll
    for (int i = 0; i < 16; ++i) ss += v[i] * v[i];
    ss += __shfl_xor(ss, 1); ss += __shfl_xor(ss, 2);
    const float rs = rsqrtf(ss * (1.f / 64.f) + EPSF);
#pragma unroll
    for (int i = 0; i < 16; ++i) v[i] = v[i] * rs * g[16 * jq + i];
    const int pos = pos0 + row;
    if (rope && !isctx) {
      load16(Cs + row * CP + 16 * (sub ^ 1), pv);
      const int lp = pos - 256;
      const int ti = (jq < 2) ? (lp >> 6) : (lp & 63);
      const float sgn = (jq & 1) ? 1.f : -1.f;
#pragma unroll
      for (int i = 0; i < 16; ++i) {
        float pn = pv[i] * rs * g[16 * (jq ^ 1) + i];
        float cs = rt[ti * 16 + i], sn = rt[1024 + ti * 16 + i];
        v[i] = v[i] * cs + sgn * pn * sn;
      }
    }
    store16(dstbase + (((size_t)b * H + head0 + hh) * SP + pos) * 64 + 16 * jq, v);
  }
}

DI void epi_vt(const float* Cs, int b, int pos0, u16* __restrict__ dstbase, int H, int head0, int c0, int ncols, float mul_unused) {
  const int tid = otid();
  const int cl = tid % ncols, tg = tid / ncols, ngrp = NTHR / ncols;
  const int col = c0 + cl;
  const int head = head0 + (cl >> 6), d = cl & 63;
  u16* drow = dstbase + (((size_t)b * H + head) * 64 + d) * SP + pos0;
  for (int tk = tg; tk < 16; tk += ngrp) {
    float y[8];
#pragma unroll
    for (int e = 0; e < 8; ++e) y[e] = Cs[(tk * 8 + e) * CP + col];
    uint4 a; a.x = pack2(y[0], y[1]); a.y = pack2(y[2], y[3]); a.z = pack2(y[4], y[5]); a.w = pack2(y[6], y[7]);
    *(uint4*)(drow + tk * 8) = a;
  }
}

template <int EPI>
DI void epilogue(const P& p, const EpiArgs& ea, float* Cs, int mtile, int ntile) {
  const int tid = otid();
  const int m0 = mtile * 128, n0 = ntile * 128;
  const bool isctx = m0 >= NLAT;
  const int b = isctx ? ((m0 - NLAT) >> 8) : (m0 >> 11);
  const int pos0 = isctx ? ((m0 - NLAT) & 255) : 256 + (m0 & 2047);
  const int mrow = isctx ? 16 : b;
  char* ws = p.ws;
  if (EPI == EPI_RESID || EPI == EPI_RELU2 || EPI == EPI_GLU) {
    const int c4 = (tid & 31) * 4;
    const int n = n0 + c4;
#pragma unroll 2
    for (int pass = 0; pass < 16; ++pass) {
      const int row = pass * 8 + (tid >> 5);
      const int R = m0 + row;
      float4 a = *(const float4*)(Cs + row * CP + c4);
      if (EPI == EPI_RESID) {
        const float* src = isctx ? ea.src_ctx + (size_t)(R - NLAT) * 1024 : ea.src_lat + (size_t)R * 1024;
        float* dst = isctx ? ea.dst_ctx + (size_t)(R - NLAT) * 1024 : ea.dst_lat + (size_t)R * 1024;
        float4 xv = *(const float4*)(src + n);
        float4 gv = *(const float4*)(ea.gate + (size_t)mrow * 6144 + n);
        float4 o; o.x = xv.x + gv.x * a.x; o.y = xv.y + gv.y * a.y; o.z = xv.z + gv.z * a.z; o.w = xv.w + gv.w * a.w;
        *(float4*)(dst + n) = o;
      } else if (EPI == EPI_RELU2) {
        float r0 = fmaxf(a.x, 0.f), r1 = fmaxf(a.y, 0.f), r2 = fmaxf(a.z, 0.f), r3 = fmaxf(a.w, 0.f);
        uint2 o; o.x = pack2(r0 * r0, r1 * r1); o.y = pack2(r2 * r2, r3 * r3);
        *(uint2*)((u16*)(ws + OFF_H) + (size_t)R * 4096 + n) = o;
      } else {
        const u16* yg = (const u16*)(ws + E_YG) + (size_t)R * 256 + n;
        uint2 yv = *(const uint2*)yg;
        float4 bg = *(const float4*)(p.b_glu + ea.j * 256 + n);
        float y0 = __uint_as_float(yv.x << 16), y1 = __uint_as_float(yv.x & 0xffff0000u);
        float y2 = __uint_as_float(yv.y << 16), y3 = __uint_as_float(yv.y & 0xffff0000u);
        float o0 = y0 / (1.f + __expf(-(a.x + bg.x))), o1 = y1 / (1.f + __expf(-(a.y + bg.y)));
        float o2 = y2 / (1.f + __expf(-(a.z + bg.z))), o3 = y3 / (1.f + __expf(-(a.w + bg.w)));
        uint2 o; o.x = pack2(o0, o1); o.y = pack2(o2, o3);
        *(uint2*)((u16*)(ws + OFF_ABUF) + (size_t)R * 1024 + 768 + n) = o;
      }
    }
  } else if (EPI == EPI_EVEN_IN) {
    if (ntile < 6) epi_head64(p, Cs, b, pos0, isctx, p.e_g_q + ea.j * 64, true, (u16*)(ws + E_Q), 12, ntile * 2);
    else if (ntile < 8) epi_head64(p, Cs, b, pos0, isctx, p.e_g_k + ea.j * 64, true, (u16*)(ws + E_K), 4, (ntile - 6) * 2);
    else if (ntile < 10) epi_vt(Cs, b, pos0, (u16*)(ws + E_VT), 4, (ntile - 8) * 2, 0, 128, 1.f);
    else {
      const int c4 = (tid & 31) * 4;
      float* U = (float*)(ws + E_U);
      for (int pass = 0; pass < 16; ++pass) {
        const int row = pass * 8 + (tid >> 5);
        *(float4*)(U + (size_t)(m0 + row) * 256 + (ntile - 10) * 128 + c4) = *(const float4*)(Cs + row * CP + c4);
      }
    }
  } else if (EPI == EPI_ODD_IN) {
    if (ntile < 6) {
      const int c4 = (tid & 31) * 4;
      float* PS = (float*)(ws + O_PS);
      for (int pass = 0; pass < 16; ++pass) {
        const int row = pass * 8 + (tid >> 5);
        const int R = m0 + row;
        float4 a = *(const float4*)(Cs + row * CP + c4);
        float ss = a.x * a.x + a.y * a.y + a.z * a.z + a.w * a.w;
#pragma unroll
        for (int o = 16; o >= 1; o >>= 1) ss += __shfl_xor(ss, o);
        if ((tid & 31) == 0) PS[(size_t)R * 8 + ntile] = ss;
        uint2 o; o.x = pack2(a.x, a.y); o.y = pack2(a.z, a.w);
        if (ntile < 4) *(uint2*)((u16*)(ws + O_CQ) + (size_t)R * 512 + n0 + c4) = o;
        else *(uint2*)((u16*)(ws + O_CKV) + (size_t)R * 256 + (n0 - 512) + c4) = o;
      }
    } else if (ntile < 10) epi_head64(p, Cs, b, pos0, isctx, p.g_nq + ea.j * 64, false, (u16*)(ws + O_NQ), 8, (ntile - 6) * 2);
    else if (ntile < 14) epi_head64(p, Cs, b, pos0, isctx, p.g_nk + ea.j * 64, false, (u16*)(ws + O_NK), 8, (ntile - 10) * 2);
    else if (ntile < 18) epi_vt(Cs, b, pos0, (u16*)(ws + O_NVT), 8, (ntile - 14) * 2, 0, 128, 1.f);
    else {
      float* KR = (float*)(ws + O_KR);
      const int c4 = (tid & 7) * 4;
      for (int pass = 0; pass < 4; ++pass) {
        const int row = pass * 32 + (tid >> 3);
        *(float4*)(KR + (size_t)(m0 + row) * 32 + c4) = *(const float4*)(Cs + row * CP + c4);
      }
    }
  } else if (EPI == EPI_UQ || EPI == EPI_UKV) {
    const int sub = tid & 7;
    const float* PS = (const float*)(ws + O_PS);
    const float* rt = (const float*)(ws + OFF_ROPE);
    const float* gm = (EPI == EPI_UQ ? p.g_mq : p.g_mk) + ea.j * 96;
    u16* dstb = (u16*)(ws + (EPI == EPI_UQ ? O_MQ : O_MK));
    const float* KR = (const float*)(ws + O_KR);
#pragma unroll 1
    for (int pass = 0; pass < 4; ++pass) {
      const int row = pass * 32 + (tid >> 3);
      const int R = m0 + row;
      float rstd;
      if (EPI == EPI_UQ) {
        float4 ps = *(const float4*)(PS + (size_t)R * 8);
        rstd = rsqrtf((ps.x + ps.y + ps.z + ps.w) * (1.f / 512.f) + EPSF);
      } else {
        float2 ps = *(const float2*)(PS + (size_t)R * 8 + 4);
        rstd = rsqrtf((ps.x + ps.y) * (1.f / 256.f) + EPSF);
      }
      float v[16];
      if (EPI == EPI_UQ) {
        load16(Cs + row * CP + 16 * sub, v);
#pragma unroll
        for (int i = 0; i < 16; ++i) v[i] *= rstd;
      } else {
        if (sub < 4) {
          load16(Cs + row * CP + 16 * sub, v);
#pragma unroll
          for (int i = 0; i < 16; ++i) v[i] *= rstd;
        } else if (sub < 6) {
          load16(KR + (size_t)R * 32 + 16 * (sub - 4), v);
        } else {
#pragma unroll
          for (int i = 0; i < 16; ++i) v[i] = 0.f;
        }
      }
      float ss = 0.f;
#pragma unroll
      for (int i = 0; i < 16; ++i) ss += v[i] * v[i];
      ss += __shfl_xor(ss, 1); ss += __shfl_xor(ss, 2); ss += __shfl_xor(ss, 4);
      const float rs = rsqrtf(ss * (1.f / 96.f) + EPSF);
      if (sub < 6) {
#pragma unroll
        for (int i = 0; i < 16; ++i) v[i] = v[i] * rs * gm[16 * sub + i];
        const int pos = pos0 + row;
        if (sub >= 4 && !isctx) {
          const int lp = pos - 256;
          const int ti = (sub == 4) ? (lp >> 6) : (lp & 63);
#pragma unroll
          for (int i = 0; i < 8; ++i) {
            float cs = rt[2048 + ti * 8 + i], sn = rt[2560 + ti * 8 + i];
            float x1 = v[i], x2 = v[i + 8];
            v[i] = x1 * cs - x2 * sn;
            v[i + 8] = x2 * cs + x1 * sn;
          }
        }
        store16(dstb + (((size_t)b * 8 + ntile) * SP + pos) * 96 + 16 * sub, v);
      }
    }
    if (EPI == EPI_UKV) {
      const int cl = tid & 63, tg = tid >> 6;
      u16* drow = (u16*)(ws + O_MVT) + (((size_t)b * 8 + ntile) * 64 + cl) * SP + pos0;
      for (int tk = tg; tk < 16; tk += 4) {
        float y[8];
#pragma unroll
        for (int e = 0; e < 8; ++e) {
          const int R = m0 + tk * 8 + e;
          float2 ps = *(const float2*)(PS + (size_t)R * 8 + 4);
          float rstd = rsqrtf((ps.x + ps.y) * (1.f / 256.f) + EPSF);
          y[e] = Cs[(tk * 8 + e) * CP + 64 + cl] * rstd;
        }
        uint4 a; a.x = pack2(y[0], y[1]); a.y = pack2(y[2], y[3]); a.z = pack2(y[4], y[5]); a.w = pack2(y[6], y[7]);
        *(uint4*)(drow + tk * 8) = a;
      }
    }
  }
}

template <int EPI>
DI void gemm_phase(const P& p, const u16* __restrict__ A, const u16* __restrict__ Bt, int K, int mt, int ntn, int band,
                           const EpiArgs& ea, char* smem) {
  const int tid = otid(), lane = tid & 63, w = tid >> 6, wm = w >> 1, wn = w & 1, r = lane & 31, h = lane >> 5;
  u16* As = (u16*)smem;
  u16* Bs = As + 2 * 9216;
  float* Cs = (float*)smem;
  const int total = mt * ntn;
  const int mper = mt >> 3;
  const int nk = K >> 6;
  const int lrow = tid >> 3, lkc = (tid & 7) * 8;
  for (int t = blockIdx.x; t < total; t += gridDim.x) {
    const int xcd = t & 7, L = t >> 3;
    const int bandsz = band * ntn;
    const int bi = L / bandsz, rr = L - bi * bandsz;
    const int full = (ntn >> 3) * (band * 8);
    int mi_, ni_;
    if (rr < full) { int ch = rr / (band * 8); int wv = rr - ch * (band * 8); mi_ = wv % band; ni_ = ch * 8 + wv / band; }
    else { int r2 = rr - full; mi_ = r2 % band; ni_ = (ntn >> 3) * 8 + r2 / band; }
    const int mtile = xcd * mper + bi * band + mi_;
    const int ntile = ni_;
    const u16* Ag = A + (size_t)(mtile * 128 + lrow) * K + lkc;
    const u16* Bg = Bt + (size_t)(ntile * 128 + lrow) * K + lkc;
    f32x16 acc[2][2];
#pragma unroll
    for (int a = 0; a < 2; ++a)
#pragma unroll
      for (int c = 0; c < 2; ++c)
#pragma unroll
        for (int i = 0; i < 16; ++i) acc[a][c][i] = 0.f;
    uint4 ra0_0, ra0_1, ra0_2, ra0_3, rb0_0, rb0_1, rb0_2, rb0_3, ra1_0, ra1_1, ra1_2, ra1_3, rb1_0, rb1_1, rb1_2, rb1_3;
#define G_LD1(S, i, kt_) ra##S##_##i = *(const uint4*)(Ag + (size_t)(32 * i) * K + (kt_) * 64); rb##S##_##i = *(const uint4*)(Bg + (size_t)(32 * i) * K + (kt_) * 64);
#define G_LOAD(S, kt_) { G_LD1(S, 0, kt_) G_LD1(S, 1, kt_) G_LD1(S, 2, kt_) G_LD1(S, 3, kt_) }
#define L_ST1(S, i, buf_) *(uint4*)(As + (buf_) * 9216 + (lrow + 32 * i) * 72 + lkc) = ra##S##_##i; *(uint4*)(Bs + (buf_) * 9216 + (lrow + 32 * i) * 72 + lkc) = rb##S##_##i;
#define L_STORE(S, buf_) { L_ST1(S, 0, buf_) L_ST1(S, 1, buf_) L_ST1(S, 2, buf_) L_ST1(S, 3, buf_) }
#define G_COMPUTE(buf_) { \
      const u16* as = As + (buf_) * 9216 + (wm * 64 + r) * 72 + h * 8; \
      const u16* bs = Bs + (buf_) * 9216 + (wn * 64 + r) * 72 + h * 8; \
      _Pragma("unroll") for (int kk = 0; kk < 4; ++kk) { \
        bf16x8 a0 = *(const bf16x8*)(as + kk * 16), a1 = *(const bf16x8*)(as + 32 * 72 + kk * 16); \
        bf16x8 b0 = *(const bf16x8*)(bs + kk * 16), b1 = *(const bf16x8*)(bs + 32 * 72 + kk * 16); \
        acc[0][0] = MFMA32(a0, b0, acc[0][0]); acc[0][1] = MFMA32(a0, b1, acc[0][1]); \
        acc[1][0] = MFMA32(a1, b0, acc[1][0]); acc[1][1] = MFMA32(a1, b1, acc[1][1]); } }
    G_LOAD(0, 0);
    G_LOAD(1, 1);
    L_STORE(0, 0);
    __syncthreads();
    for (int kt = 0; kt < nk; kt += 2) {
      if (kt + 2 < nk) { G_LOAD(0, kt + 2); }
      G_COMPUTE(0);
      L_STORE(1, 1);
      __syncthreads();
      if (kt + 3 < nk) { G_LOAD(1, kt + 3); }
      G_COMPUTE(1);
      if (kt + 2 < nk) { L_STORE(0, 0); }
      __syncthreads();
    }
#pragma unroll
    for (int a = 0; a < 2; ++a)
#pragma unroll
      for (int c = 0; c < 2; ++c)
#pragma unroll
        for (int i = 0; i < 16; ++i)
          Cs[(wm * 64 + a * 32 + (i & 3) + 8 * (i >> 2) + 4 * h) * CP + wn * 64 + c * 32 + r] = acc[a][c][i];
    __syncthreads();
    epilogue<EPI>(p, ea, Cs, mtile, ntile);
    __syncthreads();
  }
}

template <int DQK, bool NA>
DI void attn_phase(const u16* __restrict__ Q, const u16* __restrict__ Kb, const u16* __restrict__ Vt, int HQ, int HK,
                           float scale, u16* __restrict__ mix, int coloff, bool do_ctx, const float* __restrict__ rpb, char* smem) {
  constexpr int KP = DQK + 8;
  constexpr int NKK = DQK / 16;
  constexpr int KCH = DQK / 32;
  const int tid = otid(), lane = tid & 63, w = tid >> 6, r = lane & 31, h = lane >> 5;
  u16* Ks = (u16*)smem;
  u16* Vs = (u16*)(smem + 13312);
  float* rpbs = (float*)(smem + 22528);
  const int grp_heads = HQ / HK;
  const int nqb = 16 + (do_ctx ? 2 : 0);
  const int upg = grp_heads * nqb;
  const int total = 16 * HK * upg;
  const float sl2 = scale * LOG2E;
  for (int u = blockIdx.x; u < total; u += gridDim.x) {
    const int xcd = u & 7, L = u >> 3;
    const int grp = (L / upg) * 8 + xcd, wi = L % upg;
    const int b = grp / HK, hk = grp % HK;
    const int hq = hk * grp_heads + wi / nqb, qb = wi % nqb;
    const bool lat = qb < 16;
    const int qpos0 = lat ? 256 + 128 * qb : 128 * (qb - 16);
    int ntiles = lat ? 36 : 4;
    int rs0 = 0, rw = 0, rsw = 0;
    if (NA && lat) {
      int r0 = 2 * qb;
      rs0 = min(max(r0 - 4, 0), 24);
      int rs1 = min(max(r0 + 1 - 4, 0), 24);
      ntiles = 4 + (rs1 + 8 - rs0);
      rw = r0 + (w >> 1);
      rsw = min(max(rw - 4, 0), 24);
    }
    const int qpos = qpos0 + w * 32 + r;
    bf16x8 qf[NKK];
    {
      const u16* qp = Q + (((size_t)b * HQ + hq) * SP + qpos) * DQK + 8 * h;
#pragma unroll
      for (int kk = 0; kk < NKK; ++kk) qf[kk] = *(const bf16x8*)(qp + 16 * kk);
    }
    f32x16 o0, o1;
#pragma unroll
    for (int i = 0; i < 16; ++i) { o0[i] = 0.f; o1[i] = 0.f; }
    float m = -1e30f, l = 0.f;
    const u16* kbase = Kb + ((size_t)b * HK + hk) * SP * DQK;
    const u16* vbase = Vt + ((size_t)b * HK + hk) * 64 * SP;
    uint4 rk0, rk1, rk2 = make_uint4(0, 0, 0, 0), rv0, rv1;
#define KPOS_OF(i) ((NA && lat && (i) >= 4) ? 256 + 64 * (rs0 + (i) - 4) : 64 * (i))
#define ATT_GLOAD(kp) do { \
      rk0 = *(const uint4*)(kbase + (size_t)(kp) * DQK + tid * 8); \
      rk1 = *(const uint4*)(kbase + (size_t)(kp) * DQK + (tid + 256) * 8); \
      if (KCH > 2) rk2 = *(const uint4*)(kbase + (size_t)(kp) * DQK + (tid + 512) * 8); \
      rv0 = *(const uint4*)(vbase + (size_t)(tid >> 3) * SP + (kp) + (tid & 7) * 8); \
      rv1 = *(const uint4*)(vbase + (size_t)((tid >> 3) + 32) * SP + (kp) + (tid & 7) * 8); } while (0)
    { const int kp0 = KPOS_OF(0); ATT_GLOAD(kp0); }
    for (int ti = 0; ti < ntiles; ++ti) {
      __syncthreads();
      { int c = tid; *(uint4*)(Ks + (c / (DQK / 8)) * KP + (c % (DQK / 8)) * 8) = rk0; }
      { int c = tid + 256; *(uint4*)(Ks + (c / (DQK / 8)) * KP + (c % (DQK / 8)) * 8) = rk1; }
      if (KCH > 2) { int c = tid + 512; *(uint4*)(Ks + (c / (DQK / 8)) * KP + (c % (DQK / 8)) * 8) = rk2; }
      *(uint4*)(Vs + (tid >> 3) * 72 + (tid & 7) * 8) = rv0;
      *(uint4*)(Vs + ((tid >> 3) + 32) * 72 + (tid & 7) * 8) = rv1;
      if (NA && ti == 0) { for (int q = tid; q < 465; q += NTHR) rpbs[q] = rpb[hq * 465 + q]; }
      __syncthreads();
      if (ti + 1 < ntiles) { const int kp1 = KPOS_OF(ti + 1); ATT_GLOAD(kp1); }
      bool active = true;
      int jrow = 0;
      if (NA && lat && ti >= 4) { jrow = rs0 + ti - 4; active = (jrow >= rsw) && (jrow < rsw + 8); }
      if (active) {
        f32x16 s0, s1;
#pragma unroll
        for (int i = 0; i < 16; ++i) { s0[i] = 0.f; s1[i] = 0.f; }
#pragma unroll
        for (int kk = 0; kk < NKK; ++kk) {
          bf16x8 k0 = *(const bf16x8*)(Ks + r * KP + 16 * kk + 8 * h);
          bf16x8 k1 = *(const bf16x8*)(Ks + (32 + r) * KP + 16 * kk + 8 * h);
          s0 = MFMA32(k0, qf[kk], s0);
          s1 = MFMA32(k1, qf[kk], s1);
        }
        if (NA && lat && ti >= 4) {
          const int qc = (w & 1) * 32 + r;
          const int cs = min(max(qc - 8, 0), 48);
          const float* brow = rpbs + (jrow - rw + 7) * 31 + (15 - qc);
#pragma unroll
          for (int i = 0; i < 16; ++i) {
            int kc0 = (i & 3) + 8 * (i >> 2) + 4 * h, kc1 = kc0 + 32;
            bool v0 = (kc0 >= cs) && (kc0 < cs + 16), v1 = (kc1 >= cs) && (kc1 < cs + 16);
            float b0 = v0 ? brow[kc0] : 0.f, b1 = v1 ? brow[kc1] : 0.f;
            s0[i] = v0 ? (s0[i] * sl2 + b0 * LOG2E) : -1e30f;
            s1[i] = v1 ? (s1[i] * sl2 + b1 * LOG2E) : -1e30f;
          }
        } else {
#pragma unroll
          for (int i = 0; i < 16; ++i) { s0[i] *= sl2; s1[i] *= sl2; }
        }
        float tm = s0[0];
#pragma unroll
        for (int i = 1; i < 16; ++i) tm = fmaxf(tm, s0[i]);
#pragma unroll
        for (int i = 0; i < 16; ++i) tm = fmaxf(tm, s1[i]);
        tm = fmaxf(tm, __shfl_xor(tm, 32));
        const float mn = fmaxf(m, tm);
        const float alpha = __builtin_amdgcn_exp2f(m - mn);
        m = mn;
        float ps = 0.f;
#pragma unroll
        for (int i = 0; i < 16; ++i) { s0[i] = __builtin_amdgcn_exp2f(s0[i] - mn); ps += s0[i]; s1[i] = __builtin_amdgcn_exp2f(s1[i] - mn); ps += s1[i]; }
        l = l * alpha + ps;
#pragma unroll
        for (int i = 0; i < 16; ++i) { o0[i] *= alpha; o1[i] *= alpha; }
#pragma unroll
        for (int kt = 0; kt < 2; ++kt) {
#pragma unroll
          for (int sp = 0; sp < 2; ++sp) {
            u32x4 pu;
            pu[0] = pack2(kt ? s1[8 * sp + 0] : s0[8 * sp + 0], kt ? s1[8 * sp + 1] : s0[8 * sp + 1]);
            pu[1] = pack2(kt ? s1[8 * sp + 2] : s0[8 * sp + 2], kt ? s1[8 * sp + 3] : s0[8 * sp + 3]);
            pu[2] = pack2(kt ? s1[8 * sp + 4] : s0[8 * sp + 4], kt ? s1[8 * sp + 5] : s0[8 * sp + 5]);
            pu[3] = pack2(kt ? s1[8 * sp + 6] : s0[8 * sp + 6], kt ? s1[8 * sp + 7] : s0[8 * sp + 7]);
            const bf16x8 pfv = __builtin_bit_cast(bf16x8, pu);
            const int ko = 32 * kt + 16 * sp + 4 * h;
            const uint2 a0 = *(const uint2*)(Vs + r * 72 + ko), a1 = *(const uint2*)(Vs + r * 72 + ko + 8);
            const uint2 c0 = *(const uint2*)(Vs + (32 + r) * 72 + ko), c1 = *(const uint2*)(Vs + (32 + r) * 72 + ko + 8);
            u32x4 vau, vbu;
            vau[0] = a0.x; vau[1] = a0.y; vau[2] = a1.x; vau[3] = a1.y;
            vbu[0] = c0.x; vbu[1] = c0.y; vbu[2] = c1.x; vbu[3] = c1.y;
            const bf16x8 vav = __builtin_bit_cast(bf16x8, vau), vbv = __builtin_bit_cast(bf16x8, vbu);
            o0 = MFMA32(vav, pfv, o0);
            o1 = MFMA32(vbv, pfv, o1);
          }
        }
      }
    }
    l += __shfl_xor(l, 32);
    const float inv = 1.f / l;
    const int R = tok_row(b, qpos);
    u16* op = mix + (size_t)R * 1024 + coloff + hq * 64 + 4 * h;
#pragma unroll
    for (int g4 = 0; g4 < 4; ++g4) {
      uint2 a, c;
      a.x = pack2(o0[4 * g4] * inv, o0[4 * g4 + 1] * inv); a.y = pack2(o0[4 * g4 + 2] * inv, o0[4 * g4 + 3] * inv);
      c.x = pack2(o1[4 * g4] * inv, o1[4 * g4 + 1] * inv); c.y = pack2(o1[4 * g4 + 2] * inv, o1[4 * g4 + 3] * inv);
      *(uint2*)(op + 8 * g4) = a;
      *(uint2*)(op + 32 + 8 * g4) = c;
    }
  }
  __syncthreads();
}

DI void s5_pass1(const P& p, int j, char* smem) {
  const int tid = otid(), lane = tid & 63, w = tid >> 6;
  const float* U = (const float*)(p.ws + E_U);
  float2* E = (float2*)(p.ws + E_E);
  const float2* SA = (const float2*)(p.ws + OFF_SA);
  const float* SBB = (const float*)(p.ws + OFF_SBB);
  float* us = (float*)smem + w * 1024;
  for (int item = blockIdx.x; item < 4608; item += gridDim.x) {
    const int unit = item * 4 + w;
    const int c = unit % 36; const int t1 = unit / 36; const int dir = t1 & 1; const int t2 = t1 >> 1; const int g = t2 & 15; const int b = t2 >> 4;
#pragma unroll
    for (int i = 0; i < 4; ++i) {
      int idx = lane + 64 * i; int step = idx >> 2, quad = idx & 3;
      int tau = 64 * c + step;
      int pos = dir ? (tau < 256 ? 255 - tau : 2559 - tau) : tau;
      int row = tok_row(b, pos);
      *(float4*)(us + step * 16 + quad * 4) = *(const float4*)(U + (size_t)row * 256 + 16 * g + 4 * quad);
    }
    const int tidx = ((j * 2 + dir) * 16 + g) * 64 + lane;
    const float2 a = SA[tidx];
    float bbr[16], bbi[16];
#pragma unroll
    for (int q = 0; q < 4; ++q) {
      float4 t = *(const float4*)(SBB + (size_t)tidx * 32 + 4 * q); bbr[4 * q] = t.x; bbr[4 * q + 1] = t.y; bbr[4 * q + 2] = t.z; bbr[4 * q + 3] = t.w;
      float4 t2_ = *(const float4*)(SBB + (size_t)tidx * 32 + 16 + 4 * q); bbi[4 * q] = t2_.x; bbi[4 * q + 1] = t2_.y; bbi[4 * q + 2] = t2_.z; bbi[4 * q + 3] = t2_.w;
    }
    __builtin_amdgcn_wave_barrier();
    float hr = 0.f, hi = 0.f;
#pragma unroll 4
    for (int step = 0; step < 64; ++step) {
      float bur = 0.f, bui = 0.f;
#pragma unroll
      for (int q = 0; q < 4; ++q) {
        float4 uv = *(const float4*)(us + step * 16 + 4 * q);
        bur += bbr[4 * q] * uv.x + bbr[4 * q + 1] * uv.y + bbr[4 * q + 2] * uv.z + bbr[4 * q + 3] * uv.w;
        bui += bbi[4 * q] * uv.x + bbi[4 * q + 1] * uv.y + bbi[4 * q + 2] * uv.z + bbi[4 * q + 3] * uv.w;
      }
      float nr = a.x * hr - a.y * hi + bur;
      float ni = a.x * hi + a.y * hr + bui;
      hr = nr; hi = ni;
    }
    E[((((size_t)b * 16 + g) * 2 + dir) * 36 + c) * 64 + lane] = make_float2(hr, hi);
    __syncthreads();
  }
}

DI void s5_pass2(const P& p, int j, char* smem) {
  const int tid = otid(), lane = tid & 63, w = tid >> 6;
  const float* U = (const float*)(p.ws + E_U);
  const float2* E = (const float2*)(p.ws + E_E);
  const float2* SA = (const float2*)(p.ws + OFF_SA);
  const float2* SAL = (const float2*)(p.ws + OFF_SAL);
  const float* SBB = (const float*)(p.ws + OFF_SBB);
  u16* YG = (u16*)(p.ws + E_YG);
  char* wb = smem + w * 12544;
  float* us = (float*)wb; u16* Hs = (u16*)(wb + 4096); float* ys = (float*)(wb + 4096 + 4352);
  const int pcol = lane & 15, fq = lane >> 4;
  for (int item = blockIdx.x; item < 4608; item += gridDim.x) {
    const int Pc = item % 36; const int t1 = item / 36; const int gp = t1 & 7; const int b = t1 >> 3;
    const int g = gp * 2 + (w >> 1), dir = w & 1;
#pragma unroll
    for (int i = 0; i < 4; ++i) {
      int idx = lane + 64 * i; int k = idx >> 2, quad = idx & 3;
      int lt = dir ? 63 - k : k;
      int row = tok_row(b, 64 * Pc + lt);
      *(float4*)(us + k * 16 + quad * 4) = *(const float4*)(U + (size_t)row * 256 + 16 * g + 4 * quad);
    }
    const int tidx = ((j * 2 + dir) * 16 + g) * 64 + lane;
    const float2 a = SA[tidx], aL = SAL[tidx];
    float bbr[16], bbi[16];
#pragma unroll
    for (int q = 0; q < 4; ++q) {
      float4 t = *(const float4*)(SBB + (size_t)tidx * 32 + 4 * q); bbr[4 * q] = t.x; bbr[4 * q + 1] = t.y; bbr[4 * q + 2] = t.z; bbr[4 * q + 3] = t.w;
      float4 t2_ = *(const float4*)(SBB + (size_t)tidx * 32 + 16 + 4 * q); bbi[4 * q] = t2_.x; bbi[4 * q + 1] = t2_.y; bbi[4 * q + 2] = t2_.z; bbi[4 * q + 3] = t2_.w;
    }
    const int c = dir ? (Pc < 4 ? 3 - Pc : 39 - Pc) : Pc;
    float hr = 0.f, hi = 0.f;
    {
      const float2* Eb = E + ((((size_t)b * 16 + g) * 2 + dir) * 36) * 64 + lane;
      for (int cc = 0; cc < c; ++cc) {
        float2 e = Eb[(size_t)cc * 64];
        float nr = aL.x * hr - aL.y * hi + e.x;
        float ni = aL.x * hi + aL.y * hr + e.y;
        hr = nr; hi = ni;
      }
    }
    bf16x8 cf[4];
    {
      const size_t cbase = ((size_t)((j * 2 + dir) * 16 + g) * 16 + pcol) * 64;
#pragma unroll
      for (int ks = 0; ks < 4; ++ks) {
        const float* src = (ks < 2 ? p.c_re : p.c_im) + cbase + 32 * (ks & 1) + 8 * fq;
        float4 t0 = *(const float4*)src, t1_ = *(const float4*)(src + 4);
        const float sg = ks < 2 ? 1.f : -1.f;
        u32x4 cu;
        cu[0] = pack2(sg * t0.x, sg * t0.y); cu[1] = pack2(sg * t0.z, sg * t0.w);
        cu[2] = pack2(sg * t1_.x, sg * t1_.y); cu[3] = pack2(sg * t1_.z, sg * t1_.w);
        cf[ks] = __builtin_bit_cast(bf16x8, cu);
      }
    }
    __builtin_amdgcn_wave_barrier();
#pragma unroll 1
    for (int sub = 0; sub < 4; ++sub) {
#pragma unroll 4
      for (int k16 = 0; k16 < 16; ++k16) {
        const int k = sub * 16 + k16;
        float bur = 0.f, bui = 0.f;
#pragma unroll
        for (int q = 0; q < 4; ++q) {
          float4 uv = *(const float4*)(us + k * 16 + 4 * q);
          bur += bbr[4 * q] * uv.x + bbr[4 * q + 1] * uv.y + bbr[4 * q + 2] * uv.z + bbr[4 * q + 3] * uv.w;
          bui += bbi[4 * q] * uv.x + bbi[4 * q + 1] * uv.y + bbi[4 * q + 2] * uv.z + bbi[4 * q + 3] * uv.w;
        }
        float nr = a.x * hr - a.y * hi + bur;
        float ni = a.x * hi + a.y * hr + bui;
        hr = nr; hi = ni;
        Hs[k16 * 136 + lane] = f2bf(hr);
        Hs[k16 * 136 + 64 + lane] = f2bf(hi);
      }
      __builtin_amdgcn_wave_barrier();
      f32x4 acc = {0.f, 0.f, 0.f, 0.f};
#pragma unroll
      for (int ks = 0; ks < 4; ++ks) {
        bf16x8 af = *(const bf16x8*)(Hs + pcol * 136 + 32 * ks + 8 * fq);
        acc = MFMA16(af, cf[ks], acc);
      }
#pragma unroll
      for (int jj = 0; jj < 4; ++jj) {
        int k = sub * 16 + 4 * fq + jj;
        int lt = dir ? 63 - k : k;
        ys[lt * 16 + pcol] = acc[jj];
      }
      __builtin_amdgcn_wave_barrier();
    }
    __syncthreads();
#pragma unroll
    for (int i = 0; i < 8; ++i) {
      int idx = tid + 256 * i; int gi = idx >> 10, lt = (idx >> 4) & 63, pp = idx & 15;
      const char* w0 = smem + (2 * gi) * 12544; const char* w1 = smem + (2 * gi + 1) * 12544;
      const int gg = gp * 2 + gi;
      float y = ((const float*)(w0 + 8448))[lt * 16 + pp] + ((const float*)(w1 + 8448))[lt * 16 + pp]
              + p.ssm_d[j * 256 + 16 * gg + pp] * ((const float*)w0)[lt * 16 + pp];
      float t = 0.7978845608028654f * (y + 0.044715f * y * y * y);
      float ge = 0.5f * y * (1.f + tanhf(t));
      int row = tok_row(b, 64 * Pc + lt);
      YG[(size_t)row * 256 + 16 * gg + pp] = f2bf(ge);
    }
    __syncthreads();
  }
}

__global__ void __launch_bounds__(NTHR, 2) fwd_megakernel(P p) {
  __shared__ __attribute__((aligned(16))) char smem[SMEM_BYTES];
  cg::grid_group grid = cg::this_grid();
  char* ws = p.ws;
  float* XC = (float*)(ws + OFF_XC);
  u16* ABUF = (u16*)(ws + OFF_ABUF);
  const float* modv = (const float*)(ws + OFF_MODV);

  for (int dd = 0; dd < DUPN(3); ++dd) prologue(p, smem);
  grid.sync();

  for (int layer = 0; layer < 4; ++layer) {
    const int j = layer >> 1;
    const bool need_ctx = layer < 3;
    const float* xs_lat = layer == 0 ? p.x : p.out;
    const float* xs_ctx = layer == 0 ? p.ctx : XC;
    const float* modl = modv + (size_t)layer * 17 * 6144;
    EpiArgs ea;
    ea.j = j; ea.gate = modl + 2 * 1024; ea.src_lat = xs_lat; ea.src_ctx = xs_ctx; ea.dst_lat = p.out; ea.dst_ctx = XC;

    for (int dd = 0; dd < DUPN(3); ++dd) norm_phase(xs_lat, xs_ctx, p.g_norm1 + layer * 1024, modl, 0, 1, NTOK, ABUF);
    for (int dd = 0; dd < DUPN(3); ++dd) ff_convert(p, layer, smem);
    grid.sync();

    if ((layer & 1) == 0) {
      for (int dd = 0; dd < DUPN(0); ++dd) gemm_phase<EPI_EVEN_IN>(p, ABUF, (const u16*)(ws + OFF_EIN + j * SZ_EIN), 1024, 288, 12, 6, ea, smem);
      grid.sync();
      for (int dd = 0; dd < DUPN(2); ++dd) s5_pass1(p, j, smem);
      for (int dd = 0; dd < DUPN(1); ++dd) attn_phase<64, false>((const u16*)(ws + E_Q), (const u16*)(ws + E_K), (const u16*)(ws + E_VT), 12, 4, 0.125f, ABUF, 0, need_ctx, nullptr, smem);
      grid.sync();
      for (int dd = 0; dd < DUPN(2); ++dd) s5_pass2(p, j, smem);
      grid.sync();
      for (int dd = 0; dd < DUPN(0); ++dd) gemm_phase<EPI_GLU>(p, (const u16*)(ws + E_YG), (const u16*)(ws + OFF_GLU + j * SZ_GLU), 256, 288, 2, 6, ea, smem);
      grid.sync();
    } else {
      for (int dd = 0; dd < DUPN(0); ++dd) gemm_phase<EPI_ODD_IN>(p, ABUF, (const u16*)(ws + OFF_OIN + j * SZ_OIN), 1024, 288, 19, 6, ea, smem);
      grid.sync();
      for (int dd = 0; dd < DUPN(0); ++dd) gemm_phase<EPI_UQ>(p, (const u16*)(ws + O_CQ), (const u16*)(ws + OFF_UQ + j * SZ_UQ), 512, 288, 8, 6, ea, smem);
      for (int dd = 0; dd < DUPN(0); ++dd) gemm_phase<EPI_UKV>(p, (const u16*)(ws + O_CKV), (const u16*)(ws + OFF_UKV + j * SZ_UKV), 256, 288, 8, 6, ea, smem);
      for (int dd = 0; dd < DUPN(1); ++dd) attn_phase<64, true>((const u16*)(ws + O_NQ), (const u16*)(ws + O_NK), (const u16*)(ws + O_NVT), 8, 8, 0.125f, ABUF, 512, need_ctx,
                           p.rpb + (size_t)j * 8 * 465, smem);
      grid.sync();
      for (int dd = 0; dd < DUPN(1); ++dd) attn_phase<96, false>((const u16*)(ws + O_MQ), (const u16*)(ws + O_MK), (const u16*)(ws + O_MVT), 8, 8, 0.10206207261596577f, ABUF, 0,
                            need_ctx, nullptr, smem);
      grid.sync();
    }
    const int mt = need_ctx ? 288 : 256;
    const int band = need_ctx ? 6 : 8;
    gemm_phase<EPI_RESID>(p, ABUF, (const u16*)(ws + ((layer & 1) ? OFF_OOUT : OFF_EOUT) + j * SZ_SQ), 1024, mt, 8, band, ea, smem);
    grid.sync();
    for (int dd = 0; dd < DUPN(3); ++dd) norm_phase(p.out, XC, p.g_norm2 + layer * 1024, modl, 3, 4, need_ctx ? NTOK : NLAT, ABUF);
    grid.sync();
    for (int dd = 0; dd < DUPN(0); ++dd) gemm_phase<EPI_RELU2>(p, ABUF, (const u16*)(ws + OFF_FF1), 1024, mt, 32, band, ea, smem);
    grid.sync();
    ea.gate = modl + 5 * 1024; ea.src_lat = p.out; ea.src_ctx = XC;
    gemm_phase<EPI_RESID>(p, (const u16*)(ws + OFF_H), (const u16*)(ws + OFF_FF2), 4096, mt, 8, band, ea, smem);
    grid.sync();
  }
}

extern "C" void kernel_launch(void* const* d_in, const int* in_sizes, int n_in, void* d_out, int out_size, void* d_ws, size_t ws_size,
                              hipStream_t stream) {
  static int grid_blocks = 0;
  if (!grid_blocks) {
    int dev = 0, cus = 0, per_cu = 0;
    hipGetDevice(&dev);
    hipDeviceGetAttribute(&cus, hipDeviceAttributeMultiprocessorCount, dev);
    hipOccupancyMaxActiveBlocksPerMultiprocessor(&per_cu, fwd_megakernel, NTHR, 0);
    if (per_cu > 2) per_cu = 2;
    if (per_cu < 1) per_cu = 1;
    grid_blocks = cus * per_cu;
    grid_blocks &= ~7;
  }
  P p{};
  const float** f = (const float**)&p;
  for (int i = 0; i < 35; ++i) f[i] = (const float*)d_in[i];
  p.out = (float*)d_out;
  p.ws = (char*)d_ws;
  void* args[] = {&p};
  hipError_t e = hipLaunchCooperativeKernel((void*)fwd_megakernel, dim3(grid_blocks), dim3(NTHR), args, 0, stream);
  if (e != hipSuccess) fprintf(stderr, "cooperative launch failed: %s (grid %d)\n", hipGetErrorString(e), grid_blocks);
}
```

```cpp
#include <hip/hip_runtime.h>
#include <hip/hip_cooperative_groups.h>
#include <cstdio>
namespace cg = cooperative_groups;

typedef unsigned short u16;
using bf16x8 = __attribute__((ext_vector_type(8))) short;
using f32x16 = __attribute__((ext_vector_type(16))) float;
using f32x4 = __attribute__((ext_vector_type(4))) float;
typedef __attribute__((ext_vector_type(2))) __bf16 bf2_t;
using u32x4 = __attribute__((ext_vector_type(4))) unsigned;
#define DI __device__ __forceinline__
#define MFMA32(a, b, c) __builtin_amdgcn_mfma_f32_32x32x16_bf16((a), (b), (c), 0, 0, 0)
#define MFMA16(a, b, c) __builtin_amdgcn_mfma_f32_16x16x32_bf16((a), (b), (c), 0, 0, 0)

#ifndef DUP_MASK
#define DUP_MASK 0
#endif
#define DUPN(bit) (((DUP_MASK) >> (bit)) & 1 ? 2 : 1)
constexpr int NTHR = 256;
constexpr int NLAT = 32768, NTOK = 36864, SP = 2304;
constexpr float EPSF = 1e-6f;
constexpr float LOG2E = 1.4426950408889634f;
constexpr int SMEM_BYTES = 73728;
constexpr int CP = 132;

constexpr size_t SZ_EIN = 1536ull * 1024 * 2, SZ_SQ = 1024ull * 1024 * 2, SZ_OIN = 2432ull * 1024 * 2;
constexpr size_t SZ_UQ = 1024ull * 512 * 2, SZ_UKV = 1024ull * 256 * 2, SZ_GLU = 256ull * 256 * 2;
constexpr size_t OFF_EIN = 0;
constexpr size_t OFF_EOUT = OFF_EIN + 2 * SZ_EIN;
constexpr size_t OFF_OIN = OFF_EOUT + 2 * SZ_SQ;
constexpr size_t OFF_OOUT = OFF_OIN + 2 * SZ_OIN;
constexpr size_t OFF_UQ = OFF_OOUT + 2 * SZ_SQ;
constexpr size_t OFF_UKV = OFF_UQ + 2 * SZ_UQ;
constexpr size_t OFF_GLU = OFF_UKV + 2 * SZ_UKV;
constexpr size_t OFF_FF1 = OFF_GLU + 2 * SZ_GLU;
constexpr size_t OFF_FF2 = OFF_FF1 + 4096ull * 1024 * 2;
constexpr size_t OFF_MODV = OFF_FF2 + 4096ull * 1024 * 2;
constexpr size_t OFF_ROPE = OFF_MODV + 4ull * 17 * 6144 * 4;
constexpr size_t OFF_SA = OFF_ROPE + 16384;
constexpr size_t OFF_SAL = OFF_SA + 4096 * 8;
constexpr size_t OFF_SBB = OFF_SAL + 4096 * 8;
constexpr size_t OFF_BAR = OFF_SBB + 4096ull * 32 * 4;
constexpr size_t OFF_XC = OFF_BAR + 16384;
constexpr size_t OFF_ABUF = OFF_XC + 4096ull * 1024 * 4;
constexpr size_t OFF_R1 = OFF_ABUF + (size_t)NTOK * 1024 * 2;
constexpr size_t E_Q = OFF_R1;
constexpr size_t E_K = E_Q + 16ull * 12 * SP * 64 * 2;
constexpr size_t E_VT = E_K + 16ull * 4 * SP * 64 * 2;
constexpr size_t E_U = E_VT + 16ull * 4 * SP * 64 * 2;
constexpr size_t E_E = E_U + (size_t)NTOK * 256 * 4;
constexpr size_t E_YG = E_E + 16ull * 16 * 2 * 36 * 64 * 8;
constexpr size_t O_CQ = OFF_R1;
constexpr size_t O_CKV = O_CQ + (size_t)NTOK * 512 * 2;
constexpr size_t O_KR = O_CKV + (size_t)NTOK * 256 * 2;
constexpr size_t O_PS = O_KR + (size_t)NTOK * 32 * 4;
constexpr size_t O_NQ = O_PS + (size_t)NTOK * 8 * 4;
constexpr size_t O_NK = O_NQ + 16ull * 8 * SP * 64 * 2;
constexpr size_t O_NVT = O_NK + 16ull * 8 * SP * 64 * 2;
constexpr size_t O_MQ = O_NVT + 16ull * 8 * SP * 64 * 2;
constexpr size_t O_MK = O_MQ + 16ull * 8 * SP * 96 * 2;
constexpr size_t O_MVT = O_MK + 16ull * 8 * SP * 96 * 2;
constexpr size_t O_END = O_MVT + 16ull * 8 * SP * 64 * 2;
constexpr size_t OFF_H = OFF_R1;

struct P {
  const float *x, *c, *ctx, *c_ctx, *w_mod, *b_mod, *g_norm1, *g_norm2, *w_ff1, *w_ff2;
  const float *e_w_in, *e_w_out, *e_g_q, *e_g_k, *lam_re, *lam_im, *log_dt, *b_re, *b_im, *c_re, *c_im, *ssm_d, *w_glu, *b_glu;
  const float *o_w_in, *o_w_out, *g_cq, *g_ckv, *w_uq, *w_ukv, *g_mq, *g_mk, *g_nq, *g_nk, *rpb;
  float* out;
  char* ws;
};

DI unsigned pack2(float a, float b) { bf2_t v; v[0] = (__bf16)a; v[1] = (__bf16)b; return __builtin_bit_cast(unsigned, v); }
DI u16 f2bf(float a) { __bf16 v = (__bf16)a; return __builtin_bit_cast(u16, v); }
DI float bf2f(u16 v) { return __uint_as_float(((unsigned)v) << 16); }
#define GSYNC() do { for (int dd_ = 0; dd_ < DUPN(4); ++dd_) xcd_barrier(xb); } while (0)
DI int otid() { int t = threadIdx.x; asm volatile("" : "+v"(t)); return t; }
DI int tok_row(int b, int pos) { return pos < 256 ? NLAT + b * 256 + pos : b * 2048 + pos - 256; }


#define XB_TMO      128
#define XB_XCNT(j)  (256  + 64 * (j))
#define XB_XSUB(j)  (1280 + 64 * (j))
#define XB_XGEN(j)  (2304 + 64 * (j))
#define XB_TOP      3328
#define XB_TOPGEN   3392
#define XCD_BAR_WORDS 3456
#define XB_SPIN_CAP (1u << 22)
#define LAS __attribute__((address_space(3)))
DI unsigned xb_ld(unsigned* p) { return __hip_atomic_load(p, __ATOMIC_RELAXED, __HIP_MEMORY_SCOPE_AGENT); }
DI unsigned xb_add(unsigned* p, unsigned v) { return __hip_atomic_fetch_add(p, v, __ATOMIC_RELAXED, __HIP_MEMORY_SCOPE_AGENT); }
DI unsigned xb_xcc_id() { return (unsigned)__builtin_amdgcn_s_getreg((3 << 11) | 20) & 0xFu; }
#define XB_SPIN(cond, bar) do { unsigned _sp = 0; while (cond) { __builtin_amdgcn_s_sleep(1); \
    if ((++_sp & 255u) == 0u) { if (xb_ld(&(bar)[XB_TMO])) break; if (_sp > XB_SPIN_CAP) { atomicAdd(&(bar)[XB_TMO], 1u); break; } } } } while (0)
struct XcdBarrier { unsigned* bar; unsigned x; volatile LAS unsigned* st; };
DI XcdBarrier xcd_barrier_post(unsigned* bar, volatile LAS unsigned* st) {
  XcdBarrier b; b.bar = bar; b.x = xb_xcc_id(); b.st = st;
  if (threadIdx.x == 0) (void)xb_add(&bar[XB_XCNT(b.x)], 1u);
  return b;
}
DI void xcd_barrier_complete(unsigned* bar, unsigned x, unsigned& nloc, unsigned& nx) {
  const unsigned G = gridDim.x * gridDim.y * gridDim.z;
  unsigned sum, cnt, mine, sp = 0u;
  for (;;) {
    sum = 0u; cnt = 0u; mine = 0u;
#pragma unroll
    for (unsigned j = 0; j < 16; ++j) { const unsigned c = xb_ld(&bar[XB_XCNT(j)]); sum += c; cnt += (c > 0u) ? 1u : 0u; mine = (j == x) ? c : mine; }
    if (sum == G) break;
    __builtin_amdgcn_s_sleep(1);
    if ((++sp & 255u) == 0u) { if (xb_ld(&bar[XB_TMO])) break; if (sp > XB_SPIN_CAP) { atomicAdd(&bar[XB_TMO], 1u); break; } }
  }
  nloc = mine > 0u ? mine : 1u; nx = cnt > 0u ? cnt : 1u;
}
DI void xcd_barrier(const XcdBarrier& b) {
  asm volatile("s_waitcnt vmcnt(0)" ::: "memory");
  __syncthreads();
  if (threadIdx.x == 0) {
    unsigned* bar = b.bar;
    __builtin_amdgcn_s_waitcnt(0);
    unsigned nloc = b.st[0], nx = b.st[1];
    if (nloc == 0u) { xcd_barrier_complete(bar, b.x, nloc, nx); b.st[0] = nloc; b.st[1] = nx; }
    const unsigned old = xb_add(&bar[XB_XSUB(b.x)], 1u);
    const unsigned gen = old / nloc;
    if (old + 1u == (gen + 1u) * nloc) {
      __builtin_amdgcn_fence(__ATOMIC_RELEASE, "agent");
      asm volatile("s_waitcnt vmcnt(0)" ::: "memory");
      const unsigned og = xb_add(&bar[XB_TOP], 1u);
      const unsigned tg = og / nx;
      if (og + 1u == (tg + 1u) * nx) xb_add(&bar[XB_TOPGEN], 1u);
      else XB_SPIN(xb_ld(&bar[XB_TOPGEN]) == tg, bar);
      __builtin_amdgcn_fence(__ATOMIC_ACQUIRE, "agent");
      xb_add(&bar[XB_XGEN(b.x)], 1u);
      asm volatile("s_waitcnt vmcnt(0)" ::: "memory");
    } else {
      XB_SPIN(xb_ld(&bar[XB_XGEN(b.x)]) == gen, bar);
      __builtin_amdgcn_fence(__ATOMIC_ACQUIRE, "agent");
      asm volatile("s_waitcnt vmcnt(0)" ::: "memory");
    }
  }
  __syncthreads();
}

DI int map_col(int mapk, int n, int N) {
  if (mapk == 0) return n < N ? n : -1;
  if (mapk == 1) { if (n < 768) return n; if (n < 2304) return n + 32; if (n < 2336) return n - 2304 + 768; return -1; }
  int h = n >> 7, jj = n & 127; return jj < 96 ? h * 96 + jj : -1;
}
DI void tr_tile(const float* __restrict__ src, int K, int N, int Npad, int mapk, const float* __restrict__ ks,
                        u16* __restrict__ dst, int tile, char* smem) {
  float* tl = (float*)smem;
  const int tid = otid();
  const int tnn = Npad >> 6;
  const int n0 = (tile % tnn) * 64, k0 = (tile / tnn) * 64;
  const int nn = tid & 63;
  const int sn = map_col(mapk, n0 + nn, N);
#pragma unroll 4
  for (int i = 0; i < 16; ++i) {
    int kk = (tid >> 6) + 4 * i;
    float v = 0.f;
    if (sn >= 0) { v = src[(size_t)(k0 + kk) * N + sn]; if (ks) v *= ks[k0 + kk]; }
    tl[kk * 65 + nn] = v;
  }
  __syncthreads();
#pragma unroll 4
  for (int i = 0; i < 16; ++i) {
    int n2 = (tid >> 6) + 4 * i, kk = tid & 63;
    dst[(size_t)(n0 + n2) * K + k0 + kk] = f2bf(tl[kk * 65 + n2]);
  }
  __syncthreads();
}

DI void ff_convert(const P& p, int layer, char* smem) {
  u16* f1 = (u16*)(p.ws + OFF_FF1);
  u16* f2 = (u16*)(p.ws + OFF_FF2);
  const float* s1 = p.w_ff1 + (size_t)layer * 1024 * 4096;
  const float* s2 = p.w_ff2 + (size_t)layer * 4096 * 1024;
  for (int t = gridDim.x - 1 - blockIdx.x; t < 2048; t += gridDim.x) {
    if (t < 1024) tr_tile(s1, 1024, 4096, 4096, 0, nullptr, f1, t, smem);
    else tr_tile(s2, 4096, 1024, 1024, 0, nullptr, f2, t - 1024, smem);
  }
}

DI void prologue(const P& p, char* smem) {
  const int tid = otid();
  float* modv = (float*)(p.ws + OFF_MODV);
  for (int it = blockIdx.x; it < 384; it += gridDim.x) {
    float* cond = (float*)smem;
    for (int idx = tid; idx < 17 * 1024; idx += NTHR) {
      int bb = idx >> 10, k = idx & 1023;
      float v = bb < 16 ? p.c[bb * 1024 + k] : p.c_ctx[k];
      cond[idx] = v / (1.f + __expf(-v));
    }
    __syncthreads();
    const int l = it / 96, n = (it % 96) * 64 + (tid & 63), kq = tid >> 6;
    float acc[17];
#pragma unroll
    for (int i = 0; i < 17; ++i) acc[i] = 0.f;
    const float* wp = p.w_mod + ((size_t)l * 1024 + kq * 256) * 6144 + n;
    for (int k4 = 0; k4 < 64; ++k4) {
      float w0 = wp[(size_t)(k4 * 4 + 0) * 6144], w1 = wp[(size_t)(k4 * 4 + 1) * 6144];
      float w2 = wp[(size_t)(k4 * 4 + 2) * 6144], w3 = wp[(size_t)(k4 * 4 + 3) * 6144];
#pragma unroll
      for (int bb = 0; bb < 17; ++bb) {
        float4 c4 = *(const float4*)(cond + bb * 1024 + kq * 256 + k4 * 4);
        acc[bb] += c4.x * w0 + c4.y * w1 + c4.z * w2 + c4.w * w3;
      }
    }
    __syncthreads();
    float* red = (float*)smem;
#pragma unroll
    for (int bb = 0; bb < 17; ++bb) red[(kq * 17 + bb) * 64 + (tid & 63)] = acc[bb];
    __syncthreads();
    for (int o = tid; o < 17 * 64; o += NTHR) {
      int bb = o >> 6, nn = o & 63;
      int ncol = (it % 96) * 64 + nn;
      float s = red[(0 * 17 + bb) * 64 + nn] + red[(1 * 17 + bb) * 64 + nn] + red[(2 * 17 + bb) * 64 + nn] + red[(3 * 17 + bb) * 64 + nn];
      modv[((size_t)l * 17 + bb) * 6144 + ncol] = s + p.b_mod[l * 6144 + ncol];
    }
    __syncthreads();
  }
  {
    float* rt = (float*)(p.ws + OFF_ROPE);
    for (int idx = blockIdx.x * NTHR + tid; idx < 1024 + 512; idx += gridDim.x * NTHR) {
      if (idx < 1024) {
        int pos = idx >> 4, i = idx & 15;
        float f = powf(10000.f, -(float)(2 * i) / 32.f);
        float a = (float)pos * f;
        rt[idx] = cosf(a); rt[1024 + idx] = sinf(a);
      } else {
        int q = idx - 1024; int pos = q >> 3, i = q & 7;
        float f = powf(10000.f, -(float)(2 * i) / 16.f);
        float a = (float)pos * f;
        rt[2048 + q] = cosf(a); rt[2560 + q] = sinf(a);
      }
    }
    float2* SA = (float2*)(p.ws + OFF_SA);
    float2* SAL = (float2*)(p.ws + OFF_SAL);
    float* SBB = (float*)(p.ws + OFF_SBB);
    for (int idx = blockIdx.x * NTHR + tid; idx < 4096; idx += gridDim.x * NTHR) {
      float lre = p.lam_re[idx], lim = p.lam_im[idx];
      float dt = expf(p.log_dt[idx >> 6]);
      float mag = expf(lre * dt);
      float are = mag * cosf(lim * dt), aim = mag * sinf(lim * dt);
      float den = lre * lre + lim * lim;
      float fre = ((are - 1.f) * lre + aim * lim) / den;
      float fim = (aim * lre - (are - 1.f) * lim) / den;
      SA[idx] = make_float2(are, aim);
      float pr = are, pi = aim;
#pragma unroll
      for (int q = 0; q < 6; ++q) { float nr = pr * pr - pi * pi, ni = 2.f * pr * pi; pr = nr; pi = ni; }
      SAL[idx] = make_float2(pr, pi);
#pragma unroll
      for (int q = 0; q < 16; ++q) {
        float br = p.b_re[(size_t)idx * 16 + q], bi = p.b_im[(size_t)idx * 16 + q];
        SBB[(size_t)idx * 32 + q] = fre * br - fim * bi;
        SBB[(size_t)idx * 32 + 16 + q] = fre * bi + fim * br;
      }
    }
  }
  for (int t = gridDim.x - 1 - blockIdx.x; t < 3424; t += gridDim.x) {
    int j = t / 1712, r = t % 1712;
    if (r < 384) tr_tile(p.e_w_in + (size_t)j * 1024 * 1536, 1024, 1536, 1536, 0, nullptr, (u16*)(p.ws + OFF_EIN + j * SZ_EIN), r, smem);
    else if (r < 640) tr_tile(p.e_w_out + (size_t)j * 1024 * 1024, 1024, 1024, 1024, 0, nullptr, (u16*)(p.ws + OFF_EOUT + j * SZ_SQ), r - 384, smem);
    else if (r < 1248) tr_tile(p.o_w_in + (size_t)j * 1024 * 2336, 1024, 2336, 2432, 1, nullptr, (u16*)(p.ws + OFF_OIN + j * SZ_OIN), r - 640, smem);
    else if (r < 1504) tr_tile(p.o_w_out + (size_t)j * 1024 * 1024, 1024, 1024, 1024, 0, nullptr, (u16*)(p.ws + OFF_OOUT + j * SZ_SQ), r - 1248, smem);
    else if (r < 1632) tr_tile(p.w_uq + (size_t)j * 512 * 768, 512, 768, 1024, 2, p.g_cq + j * 512, (u16*)(p.ws + OFF_UQ + j * SZ_UQ), r - 1504, smem);
    else if (r < 1696) tr_tile(p.w_ukv + (size_t)j * 256 * 1024, 256, 1024, 1024, 0, p.g_ckv + j * 256, (u16*)(p.ws + OFF_UKV + j * SZ_UKV), r - 1632, smem);
    else tr_tile(p.w_glu + (size_t)j * 256 * 256, 256, 256, 256, 0, nullptr, (u16*)(p.ws + OFF_GLU + j * SZ_GLU), r - 1696, smem);
  }
}

DI void norm_phase(const float* __restrict__ xl, const float* __restrict__ xc, const float* __restrict__ g,
                           const float* __restrict__ modl, int shift_i, int scale_i, int nrows, u16* __restrict__ dst) {
  const int tid_ = otid();
  const int lane = tid_ & 63;
  const int gw = blockIdx.x * 4 + (tid_ >> 6);
  for (int R = gw; R < nrows; R += gridDim.x * 4) {
    const float* src = R < NLAT ? xl + (size_t)R * 1024 : xc + (size_t)(R - NLAT) * 1024;
    const int mrow = R < NLAT ? (R >> 11) : 16;
    float4 v[4];
    float ss = 0.f;
#pragma unroll
    for (int i = 0; i < 4; ++i) {
      v[i] = *(const float4*)(src + lane * 4 + 256 * i);
      ss += v[i].x * v[i].x + v[i].y * v[i].y + v[i].z * v[i].z + v[i].w * v[i].w;
    }
#pragma unroll
    for (int o = 32; o >= 1; o >>= 1) ss += __shfl_xor(ss, o);
    const float rstd = rsqrtf(ss * (1.f / 1024.f) + EPSF);
    const float* sh = modl + (size_t)mrow * 6144 + shift_i * 1024;
    const float* sc = modl + (size_t)mrow * 6144 + scale_i * 1024;
#pragma unroll
    for (int i = 0; i < 4; ++i) {
      int col = lane * 4 + 256 * i;
      float4 gg = *(const float4*)(g + col), s4 = *(const float4*)(sh + col), c4 = *(const float4*)(sc + col);
      float y0 = v[i].x * rstd * gg.x * (1.f + c4.x) + s4.x;
      float y1 = v[i].y * rstd * gg.y * (1.f + c4.y) + s4.y;
      float y2 = v[i].z * rstd * gg.z * (1.f + c4.z) + s4.z;
      float y3 = v[i].w * rstd * gg.w * (1.f + c4.w) + s4.w;
      uint2 o2; o2.x = pack2(y0, y1); o2.y = pack2(y2, y3);
      *(uint2*)(dst + (size_t)R * 1024 + col) = o2;
    }
  }
}

enum { EPI_EVEN_IN = 0, EPI_ODD_IN, EPI_UQ, EPI_UKV, EPI_GLU, EPI_RESID, EPI_RELU2 };

struct EpiArgs {
  int j;
  const float* gate;
  const float* src_lat; const float* src_ctx; float* dst_lat; float* dst_ctx;
};

DI void store16(u16* dst, const float* y) {
  uint4 a, b;
  a.x = pack2(y[0], y[1]); a.y = pack2(y[2], y[3]); a.z = pack2(y[4], y[5]); a.w = pack2(y[6], y[7]);
  b.x = pack2(y[8], y[9]); b.y = pack2(y[10], y[11]); b.z = pack2(y[12], y[13]); b.w = pack2(y[14], y[15]);
  *(uint4*)dst = a; *(uint4*)(dst + 8) = b;
}
DI void load16(const float* s, float* v) {
#pragma unroll
  for (int q = 0; q < 4; ++q) { float4 t = *(const float4*)(s + 4 * q); v[4 * q] = t.x; v[4 * q + 1] = t.y; v[4 * q + 2] = t.z; v[4 * q + 3] = t.w; }
}

DI void epi_head64(const P& p, const float* Cs, int b, int pos0, bool isctx, const float* __restrict__ g, bool rope,
                   u16* __restrict__ dstbase, int H, int head0) {
  const int tid = otid(), sub = tid & 7, hh = sub >> 2, jq = sub & 3;
  const float* rt = (const float*)(p.ws + OFF_ROPE);
#pragma unroll 1
  for (int pass = 0; pass < 4; ++pass) {
    const int row = pass * 32 + (tid >> 3);
    float v[16], pv[16];
    load16(Cs + row * CP + 16 * sub, v);
    float ss = 0.f;
#pragma unroll
    for (int i = 0; i < 16; ++i) ss += v[i] * v[i];
    ss += __shfl_xor(ss, 1); ss += __shfl_xor(ss, 2);
    const float rs = rsqrtf(ss * (1.f / 64.f) + EPSF);
#pragma unroll
    for (int i = 0; i < 16; ++i) v[i] = v[i] * rs * g[16 * jq + i];
    const int pos = pos0 + row;
    if (rope && !isctx) {
      load16(Cs + row * CP + 16 * (sub ^ 1), pv);
      const int lp = pos - 256;
      const int ti = (jq < 2) ? (lp >> 6) : (lp & 63);
      const float sgn = (jq & 1) ? 1.f : -1.f;
#pragma unroll
      for (int i = 0; i < 16; ++i) {
        float pn = pv[i] * rs * g[16 * (jq ^ 1) + i];
        float cs = rt[ti * 16 + i], sn = rt[1024 + ti * 16 + i];
        v[i] = v[i] * cs + sgn * pn * sn;
      }
    }
    store16(dstbase + (((size_t)b * H + head0 + hh) * SP + pos) * 64 + 16 * jq, v);
  }
}

DI void epi_vt(const float* Cs, int b, int pos0, u16* __restrict__ dstbase, int H, int head0, int c0, int ncols, float mul_unused) {
  const int tid = otid();
  const int cl = tid % ncols, tg = tid / ncols, ngrp = NTHR / ncols;
  const int col = c0 + cl;
  const int head = head0 + (cl >> 6), d = cl & 63;
  u16* drow = dstbase + (((size_t)b * H + head) * 64 + d) * SP + pos0;
  for (int tk = tg; tk < 16; tk += ngrp) {
    float y[8];
#pragma unroll
    for (int e = 0; e < 8; ++e) y[e] = Cs[(tk * 8 + e) * CP + col];
    uint4 a; a.x = pack2(y[0], y[1]); a.y = pack2(y[2], y[3]); a.z = pack2(y[4], y[5]); a.w = pack2(y[6], y[7]);
    *(uint4*)(drow + tk * 8) = a;
  }
}

template <int EPI>
DI void epilogue(const P& p, const EpiArgs& ea, float* Cs, int mtile, int ntile) {
  const int tid = otid();
  const int m0 = mtile * 128, n0 = ntile * 128;
  const bool isctx = m0 >= NLAT;
  const int b = isctx ? ((m0 - NLAT) >> 8) : (m0 >> 11);
  const int pos0 = isctx ? ((m0 - NLAT) & 255) : 256 + (m0 & 2047);
  const int mrow = isctx ? 16 : b;
  char* ws = p.ws;
  if (EPI == EPI_RESID || EPI == EPI_RELU2 || EPI == EPI_GLU) {
    const int c4 = (tid & 31) * 4;
    const int n = n0 + c4;
#pragma unroll 2
    for (int pass = 0; pass < 16; ++pass) {
      const int row = pass * 8 + (tid >> 5);
      const int R = m0 + row;
      float4 a = *(const float4*)(Cs + row * CP + c4);
      if (EPI == EPI_RESID) {
        const float* src = isctx ? ea.src_ctx + (size_t)(R - NLAT) * 1024 : ea.src_lat + (size_t)R * 1024;
        float* dst = isctx ? ea.dst_ctx + (size_t)(R - NLAT) * 1024 : ea.dst_lat + (size_t)R * 1024;
        float4 xv = *(const float4*)(src + n);
        float4 gv = *(const float4*)(ea.gate + (size_t)mrow * 6144 + n);
        float4 o; o.x = xv.x + gv.x * a.x; o.y = xv.y + gv.y * a.y; o.z = xv.z + gv.z * a.z; o.w = xv.w + gv.w * a.w;
        *(float4*)(dst + n) = o;
      } else if (EPI == EPI_RELU2) {
        float r0 = fmaxf(a.x, 0.f), r1 = fmaxf(a.y, 0.f), r2 = fmaxf(a.z, 0.f), r3 = fmaxf(a.w, 0.f);
        uint2 o; o.x = pack2(r0 * r0, r1 * r1); o.y = pack2(r2 * r2, r3 * r3);
        *(uint2*)((u16*)(ws + OFF_H) + (size_t)R * 4096 + n) = o;
      } else {
        const u16* yg = (const u16*)(ws + E_YG) + (size_t)R * 256 + n;
        uint2 yv = *(const uint2*)yg;
        float4 bg = *(const float4*)(p.b_glu + ea.j * 256 + n);
        float y0 = __uint_as_float(yv.x << 16), y1 = __uint_as_float(yv.x & 0xffff0000u);
        float y2 = __uint_as_float(yv.y << 16), y3 = __uint_as_float(yv.y & 0xffff0000u);
        float o0 = y0 / (1.f + __expf(-(a.x + bg.x))), o1 = y1 / (1.f + __expf(-(a.y + bg.y)));
        float o2 = y2 / (1.f + __expf(-(a.z + bg.z))), o3 = y3 / (1.f + __expf(-(a.w + bg.w)));
        uint2 o; o.x = pack2(o0, o1); o.y = pack2(o2, o3);
        *(uint2*)((u16*)(ws + OFF_ABUF) + (size_t)R * 1024 + 768 + n) = o;
      }
    }
  } else if (EPI == EPI_EVEN_IN) {
    if (ntile < 6) epi_head64(p, Cs, b, pos0, isctx, p.e_g_q + ea.j * 64, true, (u16*)(ws + E_Q), 12, ntile * 2);
    else if (ntile < 8) epi_head64(p, Cs, b, pos0, isctx, p.e_g_k + ea.j * 64, true, (u16*)(ws + E_K), 4, (ntile - 6) * 2);
    else if (ntile < 10) epi_vt(Cs, b, pos0, (u16*)(ws + E_VT), 4, (ntile - 8) * 2, 0, 128, 1.f);
    else {
      const int c4 = (tid & 31) * 4;
      float* U = (float*)(ws + E_U);
      for (int pass = 0; pass < 16; ++pass) {
        const int row = pass * 8 + (tid >> 5);
        *(float4*)(U + (size_t)(m0 + row) * 256 + (ntile - 10) * 128 + c4) = *(const float4*)(Cs + row * CP + c4);
      }
    }
  } else if (EPI == EPI_ODD_IN) {
    if (ntile < 6) {
      const int c4 = (tid & 31) * 4;
      float* PS = (float*)(ws + O_PS);
      for (int pass = 0; pass < 16; ++pass) {
        const int row = pass * 8 + (tid >> 5);
        const int R = m0 + row;
        float4 a = *(const float4*)(Cs + row * CP + c4);
        float ss = a.x * a.x + a.y * a.y + a.z * a.z + a.w * a.w;
#pragma unroll
        for (int o = 16; o >= 1; o >>= 1) ss += __shfl_xor(ss, o);
        if ((tid & 31) == 0) PS[(size_t)R * 8 + ntile] = ss;
        uint2 o; o.x = pack2(a.x, a.y); o.y = pack2(a.z, a.w);
        if (ntile < 4) *(uint2*)((u16*)(ws + O_CQ) + (size_t)R * 512 + n0 + c4) = o;
        else *(uint2*)((u16*)(ws + O_CKV) + (size_t)R * 256 + (n0 - 512) + c4) = o;
      }
    } else if (ntile < 10) epi_head64(p, Cs, b, pos0, isctx, p.g_nq + ea.j * 64, false, (u16*)(ws + O_NQ), 8, (ntile - 6) * 2);
    else if (ntile < 14) epi_head64(p, Cs, b, pos0, isctx, p.g_nk + ea.j * 64, false, (u16*)(ws + O_NK), 8, (ntile - 10) * 2);
    else if (ntile < 18) epi_vt(Cs, b, pos0, (u16*)(ws + O_NVT), 8, (ntile - 14) * 2, 0, 128, 1.f);
    else {
      float* KR = (float*)(ws + O_KR);
      const int c4 = (tid & 7) * 4;
      for (int pass = 0; pass < 4; ++pass) {
        const int row = pass * 32 + (tid >> 3);
        *(float4*)(KR + (size_t)(m0 + row) * 32 + c4) = *(const float4*)(Cs + row * CP + c4);
      }
    }
  } else if (EPI == EPI_UQ || EPI == EPI_UKV) {
    const int sub = tid & 7;
    const float* PS = (const float*)(ws + O_PS);
    const float* rt = (const float*)(ws + OFF_ROPE);
    const float* gm = (EPI == EPI_UQ ? p.g_mq : p.g_mk) + ea.j * 96;
    u16* dstb = (u16*)(ws + (EPI == EPI_UQ ? O_MQ : O_MK));
    const float* KR = (const float*)(ws + O_KR);
#pragma unroll 1
    for (int pass = 0; pass < 4; ++pass) {
      const int row = pass * 32 + (tid >> 3);
      const int R = m0 + row;
      float rstd;
      if (EPI == EPI_UQ) {
        float4 ps = *(const float4*)(PS + (size_t)R * 8);
        rstd = rsqrtf((ps.x + ps.y + ps.z + ps.w) * (1.f / 512.f) + EPSF);
      } else {
        float2 ps = *(const float2*)(PS + (size_t)R * 8 + 4);
        rstd = rsqrtf((ps.x + ps.y) * (1.f / 256.f) + EPSF);
      }
      float v[16];
      if (EPI == EPI_UQ) {
        load16(Cs + row * CP + 16 * sub, v);
#pragma unroll
        for (int i = 0; i < 16; ++i) v[i] *= rstd;
      } else {
        if (sub < 4) {
          load16(Cs + row * CP + 16 * sub, v);
#pragma unroll
          for (int i = 0; i < 16; ++i) v[i] *= rstd;
        } else if (sub < 6) {
          load16(KR + (size_t)R * 32 + 16 * (sub - 4), v);
        } else {
#pragma unroll
          for (int i = 0; i < 16; ++i) v[i] = 0.f;
        }
      }
      float ss = 0.f;
#pragma unroll
      for (int i = 0; i < 16; ++i) ss += v[i] * v[i];
      ss += __shfl_xor(ss, 1); ss += __shfl_xor(ss, 2); ss += __shfl_xor(ss, 4);
      const float rs = rsqrtf(ss * (1.f / 96.f) + EPSF);
      if (sub < 6) {
#pragma unroll
        for (int i = 0; i < 16; ++i) v[i] = v[i] * rs * gm[16 * sub + i];
        const int pos = pos0 + row;
        if (sub >= 4 && !isctx) {
          const int lp = pos - 256;
          const int ti = (sub == 4) ? (lp >> 6) : (lp & 63);
#pragma unroll
          for (int i = 0; i < 8; ++i) {
            float cs = rt[2048 + ti * 8 + i], sn = rt[2560 + ti * 8 + i];
            float x1 = v[i], x2 = v[i + 8];
            v[i] = x1 * cs - x2 * sn;
            v[i + 8] = x2 * cs + x1 * sn;
          }
        }
        store16(dstb + (((size_t)b * 8 + ntile) * SP + pos) * 96 + 16 * sub, v);
      }
    }
    if (EPI == EPI_UKV) {
      const int cl = tid & 63, tg = tid >> 6;
      u16* drow = (u16*)(ws + O_MVT) + (((size_t)b * 8 + ntile) * 64 + cl) * SP + pos0;
      for (int tk = tg; tk < 16; tk += 4) {
        float y[8];
#pragma unroll
        for (int e = 0; e < 8; ++e) {
          const int R = m0 + tk * 8 + e;
          float2 ps = *(const float2*)(PS + (size_t)R * 8 + 4);
          float rstd = rsqrtf((ps.x + ps.y) * (1.f / 256.f) + EPSF);
          y[e] = Cs[(tk * 8 + e) * CP + 64 + cl] * rstd;
        }
        uint4 a; a.x = pack2(y[0], y[1]); a.y = pack2(y[2], y[3]); a.z = pack2(y[4], y[5]); a.w = pack2(y[6], y[7]);
        *(uint4*)(drow + tk * 8) = a;
      }
    }
  }
}

template <int EPI>
DI void gemm_phase(const P& p, const u16* __restrict__ A, const u16* __restrict__ Bt, int K, int mt, int ntn, int band,
                           const EpiArgs& ea, char* smem) {
  const int tid = otid(), lane = tid & 63, w = tid >> 6, wm = w >> 1, wn = w & 1, r = lane & 31, h = lane >> 5;
  u16* As = (u16*)smem;
  u16* Bs = As + 2 * 9216;
  float* Cs = (float*)smem;
  const int total = mt * ntn;
  const int mper = mt >> 3;
  const int nk = K >> 6;
  const int lrow = tid >> 3, lkc = (tid & 7) * 8;
  for (int t = blockIdx.x; t < total; t += gridDim.x) {
    const int xcd = t & 7, L = t >> 3;
    const int bandsz = band * ntn;
    const int bi = L / bandsz, rr = L - bi * bandsz;
    const int full = (ntn >> 3) * (band * 8);
    int mi_, ni_;
    if (rr < full) { int ch = rr / (band * 8); int wv = rr - ch * (band * 8); mi_ = wv % band; ni_ = ch * 8 + wv / band; }
    else { int r2 = rr - full; mi_ = r2 % band; ni_ = (ntn >> 3) * 8 + r2 / band; }
    const int mtile = xcd * mper + bi * band + mi_;
    const int ntile = ni_;
    const u16* Ag = A + (size_t)(mtile * 128 + lrow) * K + lkc;
    const u16* Bg = Bt + (size_t)(ntile * 128 + lrow) * K + lkc;
    f32x16 acc[2][2];
#pragma unroll
    for (int a = 0; a < 2; ++a)
#pragma unroll
      for (int c = 0; c < 2; ++c)
#pragma unroll
        for (int i = 0; i < 16; ++i) acc[a][c][i] = 0.f;
    uint4 ra0_0, ra0_1, ra0_2, ra0_3, rb0_0, rb0_1, rb0_2, rb0_3, ra1_0, ra1_1, ra1_2, ra1_3, rb1_0, rb1_1, rb1_2, rb1_3;
#define G_LD1(S, i, kt_) ra##S##_##i = *(const uint4*)(Ag + (size_t)(32 * i) * K + (kt_) * 64); rb##S##_##i = *(const uint4*)(Bg + (size_t)(32 * i) * K + (kt_) * 64);
#define G_LOAD(S, kt_) { G_LD1(S, 0, kt_) G_LD1(S, 1, kt_) G_LD1(S, 2, kt_) G_LD1(S, 3, kt_) }
#define L_ST1(S, i, buf_) *(uint4*)(As + (buf_) * 9216 + (lrow + 32 * i) * 72 + lkc) = ra##S##_##i; *(uint4*)(Bs + (buf_) * 9216 + (lrow + 32 * i) * 72 + lkc) = rb##S##_##i;
#define L_STORE(S, buf_) { L_ST1(S, 0, buf_) L_ST1(S, 1, buf_) L_ST1(S, 2, buf_) L_ST1(S, 3, buf_) }
#define G_COMPUTE(buf_) { \
      const u16* as = As + (buf_) * 9216 + (wm * 64 + r) * 72 + h * 8; \
      const u16* bs = Bs + (buf_) * 9216 + (wn * 64 + r) * 72 + h * 8; \
      _Pragma("unroll") for (int kk = 0; kk < 4; ++kk) { \
        bf16x8 a0 = *(const bf16x8*)(as + kk * 16), a1 = *(const bf16x8*)(as + 32 * 72 + kk * 16); \
        bf16x8 b0 = *(const bf16x8*)(bs + kk * 16), b1 = *(const bf16x8*)(bs + 32 * 72 + kk * 16); \
        acc[0][0] = MFMA32(a0, b0, acc[0][0]); acc[0][1] = MFMA32(a0, b1, acc[0][1]); \
        acc[1][0] = MFMA32(a1, b0, acc[1][0]); acc[1][1] = MFMA32(a1, b1, acc[1][1]); } }
    G_LOAD(0, 0);
    G_LOAD(1, 1);
    L_STORE(0, 0);
    __syncthreads();
    for (int kt = 0; kt < nk; kt += 2) {
      if (kt + 2 < nk) { G_LOAD(0, kt + 2); }
      G_COMPUTE(0);
      L_STORE(1, 1);
      __syncthreads();
      if (kt + 3 < nk) { G_LOAD(1, kt + 3); }
      G_COMPUTE(1);
      if (kt + 2 < nk) { L_STORE(0, 0); }
      __syncthreads();
    }
#pragma unroll
    for (int a = 0; a < 2; ++a)
#pragma unroll
      for (int c = 0; c < 2; ++c)
#pragma unroll
        for (int i = 0; i < 16; ++i)
          Cs[(wm * 64 + a * 32 + (i & 3) + 8 * (i >> 2) + 4 * h) * CP + wn * 64 + c * 32 + r] = acc[a][c][i];
    __syncthreads();
    epilogue<EPI>(p, ea, Cs, mtile, ntile);
    __syncthreads();
  }
}

template <int DQK, bool NA>
DI void attn_phase(const u16* __restrict__ Q, const u16* __restrict__ Kb, const u16* __restrict__ Vt, int HQ, int HK,
                           float scale, u16* __restrict__ mix, int coloff, bool do_ctx, const float* __restrict__ rpb, char* smem) {
  constexpr int KP = DQK + 8;
  constexpr int NKK = DQK / 16;
  constexpr int KCH = DQK / 32;
  const int tid = otid(), lane = tid & 63, w = tid >> 6, r = lane & 31, h = lane >> 5;
  u16* Ks = (u16*)smem;
  u16* Vs = (u16*)(smem + 13312);
  float* rpbs = (float*)(smem + 22528);
  const int grp_heads = HQ / HK;
  const int nqb = 16 + (do_ctx ? 2 : 0);
  const int upg = grp_heads * nqb;
  const int total = 16 * HK * upg;
  const float sl2 = scale * LOG2E;
  for (int u = blockIdx.x; u < total; u += gridDim.x) {
    const int xcd = u & 7, L = u >> 3;
    const int grp = (L / upg) * 8 + xcd, wi = L % upg;
    const int b = grp / HK, hk = grp % HK;
    const int hq = hk * grp_heads + wi / nqb, qb = wi % nqb;
    const bool lat = qb < 16;
    const int qpos0 = lat ? 256 + 128 * qb : 128 * (qb - 16);
    int ntiles = lat ? 36 : 4;
    int rs0 = 0, rw = 0, rsw = 0;
    if (NA && lat) {
      int r0 = 2 * qb;
      rs0 = min(max(r0 - 4, 0), 24);
      int rs1 = min(max(r0 + 1 - 4, 0), 24);
      ntiles = 4 + (rs1 + 8 - rs0);
      rw = r0 + (w >> 1);
      rsw = min(max(rw - 4, 0), 24);
    }
    const int qpos = qpos0 + w * 32 + r;
    bf16x8 qf[NKK];
    {
      const u16* qp = Q + (((size_t)b * HQ + hq) * SP + qpos) * DQK + 8 * h;
#pragma unroll
      for (int kk = 0; kk < NKK; ++kk) qf[kk] = *(const bf16x8*)(qp + 16 * kk);
    }
    f32x16 o0, o1;
#pragma unroll
    for (int i = 0; i < 16; ++i) { o0[i] = 0.f; o1[i] = 0.f; }
    float m = -1e30f, l = 0.f;
    const u16* kbase = Kb + ((size_t)b * HK + hk) * SP * DQK;
    const u16* vbase = Vt + ((size_t)b * HK + hk) * 64 * SP;
    uint4 rk0, rk1, rk2 = make_uint4(0, 0, 0, 0), rv0, rv1;
#define KPOS_OF(i) ((NA && lat && (i) >= 4) ? 256 + 64 * (rs0 + (i) - 4) : 64 * (i))
#define ATT_GLOAD(kp) do { \
      rk0 = *(const uint4*)(kbase + (size_t)(kp) * DQK + tid * 8); \
      rk1 = *(const uint4*)(kbase + (size_t)(kp) * DQK + (tid + 256) * 8); \
      if (KCH > 2) rk2 = *(const uint4*)(kbase + (size_t)(kp) * DQK + (tid + 512) * 8); \
      rv0 = *(const uint4*)(vbase + (size_t)(tid >> 3) * SP + (kp) + (tid & 7) * 8); \
      rv1 = *(const uint4*)(vbase + (size_t)((tid >> 3) + 32) * SP + (kp) + (tid & 7) * 8); } while (0)
    { const int kp0 = KPOS_OF(0); ATT_GLOAD(kp0); }
    for (int ti = 0; ti < ntiles; ++ti) {
      __syncthreads();
      { int c = tid; *(uint4*)(Ks + (c / (DQK / 8)) * KP + (c % (DQK / 8)) * 8) = rk0; }
      { int c = tid + 256; *(uint4*)(Ks + (c / (DQK / 8)) * KP + (c % (DQK / 8)) * 8) = rk1; }
      if (KCH > 2) { int c = tid + 512; *(uint4*)(Ks + (c / (DQK / 8)) * KP + (c % (DQK / 8)) * 8) = rk2; }
      *(uint4*)(Vs + (tid >> 3) * 72 + (tid & 7) * 8) = rv0;
      *(uint4*)(Vs + ((tid >> 3) + 32) * 72 + (tid & 7) * 8) = rv1;
      if (NA && ti == 0) { for (int q = tid; q < 465; q += NTHR) rpbs[q] = rpb[hq * 465 + q]; }
      __syncthreads();
      if (ti + 1 < ntiles) { const int kp1 = KPOS_OF(ti + 1); ATT_GLOAD(kp1); }
      bool active = true;
      int jrow = 0;
      if (NA && lat && ti >= 4) { jrow = rs0 + ti - 4; active = (jrow >= rsw) && (jrow < rsw + 8); }
      if (active) {
        f32x16 s0, s1;
#pragma unroll
        for (int i = 0; i < 16; ++i) { s0[i] = 0.f; s1[i] = 0.f; }
#pragma unroll
        for (int kk = 0; kk < NKK; ++kk) {
          bf16x8 k0 = *(const bf16x8*)(Ks + r * KP + 16 * kk + 8 * h);
          bf16x8 k1 = *(const bf16x8*)(Ks + (32 + r) * KP + 16 * kk + 8 * h);
          s0 = MFMA32(k0, qf[kk], s0);
          s1 = MFMA32(k1, qf[kk], s1);
        }
        if (NA && lat && ti >= 4) {
          const int qc = (w & 1) * 32 + r;
          const int cs = min(max(qc - 8, 0), 48);
          const float* brow = rpbs + (jrow - rw + 7) * 31 + (15 - qc);
#pragma unroll
          for (int i = 0; i < 16; ++i) {
            int kc0 = (i & 3) + 8 * (i >> 2) + 4 * h, kc1 = kc0 + 32;
            bool v0 = (kc0 >= cs) && (kc0 < cs + 16), v1 = (kc1 >= cs) && (kc1 < cs + 16);
            float b0 = v0 ? brow[kc0] : 0.f, b1 = v1 ? brow[kc1] : 0.f;
            s0[i] = v0 ? (s0[i] * sl2 + b0 * LOG2E) : -1e30f;
            s1[i] = v1 ? (s1[i] * sl2 + b1 * LOG2E) : -1e30f;
          }
        } else {
#pragma unroll
          for (int i = 0; i < 16; ++i) { s0[i] *= sl2; s1[i] *= sl2; }
        }
        float tm = s0[0];
#pragma unroll
        for (int i = 1; i < 16; ++i) tm = fmaxf(tm, s0[i]);
#pragma unroll
        for (int i = 0; i < 16; ++i) tm = fmaxf(tm, s1[i]);
        tm = fmaxf(tm, __shfl_xor(tm, 32));
        const float mn = fmaxf(m, tm);
        const float alpha = __builtin_amdgcn_exp2f(m - mn);
        m = mn;
        float ps = 0.f;
#pragma unroll
        for (int i = 0; i < 16; ++i) { s0[i] = __builtin_amdgcn_exp2f(s0[i] - mn); ps += s0[i]; s1[i] = __builtin_amdgcn_exp2f(s1[i] - mn); ps += s1[i]; }
        l = l * alpha + ps;
#pragma unroll
        for (int i = 0; i < 16; ++i) { o0[i] *= alpha; o1[i] *= alpha; }
#pragma unroll
        for (int kt = 0; kt < 2; ++kt) {
#pragma unroll
          for (int sp = 0; sp < 2; ++sp) {
            u32x4 pu;
            pu[0] = pack2(kt ? s1[8 * sp + 0] : s0[8 * sp + 0], kt ? s1[8 * sp + 1] : s0[8 * sp + 1]);
            pu[1] = pack2(kt ? s1[8 * sp + 2] : s0[8 * sp + 2], kt ? s1[8 * sp + 3] : s0[8 * sp + 3]);
            pu[2] = pack2(kt ? s1[8 * sp + 4] : s0[8 * sp + 4], kt ? s1[8 * sp + 5] : s0[8 * sp + 5]);
            pu[3] = pack2(kt ? s1[8 * sp + 6] : s0[8 * sp + 6], kt ? s1[8 * sp + 7] : s0[8 * sp + 7]);
            const bf16x8 pfv = __builtin_bit_cast(bf16x8, pu);
            const int ko = 32 * kt + 16 * sp + 4 * h;
            const uint2 a0 = *(const uint2*)(Vs + r * 72 + ko), a1 = *(const uint2*)(Vs + r * 72 + ko + 8);
            const uint2 c0 = *(const uint2*)(Vs + (32 + r) * 72 + ko), c1 = *(const uint2*)(Vs + (32 + r) * 72 + ko + 8);
            u32x4 vau, vbu;
            vau[0] = a0.x; vau[1] = a0.y; vau[2] = a1.x; vau[3] = a1.y;
            vbu[0] = c0.x; vbu[1] = c0.y; vbu[2] = c1.x; vbu[3] = c1.y;
            const bf16x8 vav = __builtin_bit_cast(bf16x8, vau), vbv = __builtin_bit_cast(bf16x8, vbu);
            o0 = MFMA32(vav, pfv, o0);
            o1 = MFMA32(vbv, pfv, o1);
          }
        }
      }
    }
    l += __shfl_xor(l, 32);
    const float inv = 1.f / l;
    const int R = tok_row(b, qpos);
    u16* op = mix + (size_t)R * 1024 + coloff + hq * 64 + 4 * h;
#pragma unroll
    for (int g4 = 0; g4 < 4; ++g4) {
      uint2 a, c;
      a.x = pack2(o0[4 * g4] * inv, o0[4 * g4 + 1] * inv); a.y = pack2(o0[4 * g4 + 2] * inv, o0[4 * g4 + 3] * inv);
      c.x = pack2(o1[4 * g4] * inv, o1[4 * g4 + 1] * inv); c.y = pack2(o1[4 * g4 + 2] * inv, o1[4 * g4 + 3] * inv);
      *(uint2*)(op + 8 * g4) = a;
      *(uint2*)(op + 32 + 8 * g4) = c;
    }
  }
  __syncthreads();
}

DI void s5_pass1(const P& p, int j, char* smem) {
  const int tid = otid(), lane = tid & 63, w = tid >> 6;
  const float* U = (const float*)(p.ws + E_U);
  float2* E = (float2*)(p.ws + E_E);
  const float2* SA = (const float2*)(p.ws + OFF_SA);
  const float* SBB = (const float*)(p.ws + OFF_SBB);
  float* us = (float*)smem + w * 1024;
  for (int item = blockIdx.x; item < 4608; item += gridDim.x) {
    const int unit = item * 4 + w;
    const int c = unit % 36; const int t1 = unit / 36; const int dir = t1 & 1; const int t2 = t1 >> 1; const int g = t2 & 15; const int b = t2 >> 4;
#pragma unroll
    for (int i = 0; i < 4; ++i) {
      int idx = lane + 64 * i; int step = idx >> 2, quad = idx & 3;
      int tau = 64 * c + step;
      int pos = dir ? (tau < 256 ? 255 - tau : 2559 - tau) : tau;
      int row = tok_row(b, pos);
      *(float4*)(us + step * 16 + quad * 4) = *(const float4*)(U + (size_t)row * 256 + 16 * g + 4 * quad);
    }
    const int tidx = ((j * 2 + dir) * 16 + g) * 64 + lane;
    const float2 a = SA[tidx];
    float bbr[16], bbi[16];
#pragma unroll
    for (int q = 0; q < 4; ++q) {
      float4 t = *(const float4*)(SBB + (size_t)tidx * 32 + 4 * q); bbr[4 * q] = t.x; bbr[4 * q + 1] = t.y; bbr[4 * q + 2] = t.z; bbr[4 * q + 3] = t.w;
      float4 t2_ = *(const float4*)(SBB + (size_t)tidx * 32 + 16 + 4 * q); bbi[4 * q] = t2_.x; bbi[4 * q + 1] = t2_.y; bbi[4 * q + 2] = t2_.z; bbi[4 * q + 3] = t2_.w;
    }
    __builtin_amdgcn_wave_barrier();
    float hr = 0.f, hi = 0.f;
#pragma unroll 4
    for (int step = 0; step < 64; ++step) {
      float bur = 0.f, bui = 0.f;
#pragma unroll
      for (int q = 0; q < 4; ++q) {
        float4 uv = *(const float4*)(us + step * 16 + 4 * q);
        bur += bbr[4 * q] * uv.x + bbr[4 * q + 1] * uv.y + bbr[4 * q + 2] * uv.z + bbr[4 * q + 3] * uv.w;
        bui += bbi[4 * q] * uv.x + bbi[4 * q + 1] * uv.y + bbi[4 * q + 2] * uv.z + bbi[4 * q + 3] * uv.w;
      }
      float nr = a.x * hr - a.y * hi + bur;
      float ni = a.x * hi + a.y * hr + bui;
      hr = nr; hi = ni;
    }
    E[((((size_t)b * 16 + g) * 2 + dir) * 36 + c) * 64 + lane] = make_float2(hr, hi);
    __syncthreads();
  }
}

DI void s5_pass2(const P& p, int j, char* smem) {
  const int tid = otid(), lane = tid & 63, w = tid >> 6;
  const float* U = (const float*)(p.ws + E_U);
  const float2* E = (const float2*)(p.ws + E_E);
  const float2* SA = (const float2*)(p.ws + OFF_SA);
  const float2* SAL = (const float2*)(p.ws + OFF_SAL);
  const float* SBB = (const float*)(p.ws + OFF_SBB);
  u16* YG = (u16*)(p.ws + E_YG);
  char* wb = smem + w * 12544;
  float* us = (float*)wb; u16* Hs = (u16*)(wb + 4096); float* ys = (float*)(wb + 4096 + 4352);
  const int pcol = lane & 15, fq = lane >> 4;
  for (int item = blockIdx.x; item < 4608; item += gridDim.x) {
    const int Pc = item % 36; const int t1 = item / 36; const int gp = t1 & 7; const int b = t1 >> 3;
    const int g = gp * 2 + (w >> 1), dir = w & 1;
#pragma unroll
    for (int i = 0; i < 4; ++i) {
      int idx = lane + 64 * i; int k = idx >> 2, quad = idx & 3;
      int lt = dir ? 63 - k : k;
      int row = tok_row(b, 64 * Pc + lt);
      *(float4*)(us + k * 16 + quad * 4) = *(const float4*)(U + (size_t)row * 256 + 16 * g + 4 * quad);
    }
    const int tidx = ((j * 2 + dir) * 16 + g) * 64 + lane;
    const float2 a = SA[tidx], aL = SAL[tidx];
    float bbr[16], bbi[16];
#pragma unroll
    for (int q = 0; q < 4; ++q) {
      float4 t = *(const float4*)(SBB + (size_t)tidx * 32 + 4 * q); bbr[4 * q] = t.x; bbr[4 * q + 1] = t.y; bbr[4 * q + 2] = t.z; bbr[4 * q + 3] = t.w;
      float4 t2_ = *(const float4*)(SBB + (size_t)tidx * 32 + 16 + 4 * q); bbi[4 * q] = t2_.x; bbi[4 * q + 1] = t2_.y; bbi[4 * q + 2] = t2_.z; bbi[4 * q + 3] = t2_.w;
    }
    const int c = dir ? (Pc < 4 ? 3 - Pc : 39 - Pc) : Pc;
    float hr = 0.f, hi = 0.f;
    {
      const float2* Eb = E + ((((size_t)b * 16 + g) * 2 + dir) * 36) * 64 + lane;
      for (int cc = 0; cc < c; ++cc) {
        float2 e = Eb[(size_t)cc * 64];
        float nr = aL.x * hr - aL.y * hi + e.x;
        float ni = aL.x * hi + aL.y * hr + e.y;
        hr = nr; hi = ni;
      }
    }
    bf16x8 cf[4];
    {
      const size_t cbase = ((size_t)((j * 2 + dir) * 16 + g) * 16 + pcol) * 64;
#pragma unroll
      for (int ks = 0; ks < 4; ++ks) {
        const float* src = (ks < 2 ? p.c_re : p.c_im) + cbase + 32 * (ks & 1) + 8 * fq;
        float4 t0 = *(const float4*)src, t1_ = *(const float4*)(src + 4);
        const float sg = ks < 2 ? 1.f : -1.f;
        u32x4 cu;
        cu[0] = pack2(sg * t0.x, sg * t0.y); cu[1] = pack2(sg * t0.z, sg * t0.w);
        cu[2] = pack2(sg * t1_.x, sg * t1_.y); cu[3] = pack2(sg * t1_.z, sg * t1_.w);
        cf[ks] = __builtin_bit_cast(bf16x8, cu);
      }
    }
    __builtin_amdgcn_wave_barrier();
#pragma unroll 1
    for (int sub = 0; sub < 4; ++sub) {
#pragma unroll 4
      for (int k16 = 0; k16 < 16; ++k16) {
        const int k = sub * 16 + k16;
        float bur = 0.f, bui = 0.f;
#pragma unroll
        for (int q = 0; q < 4; ++q) {
          float4 uv = *(const float4*)(us + k * 16 + 4 * q);
          bur += bbr[4 * q] * uv.x + bbr[4 * q + 1] * uv.y + bbr[4 * q + 2] * uv.z + bbr[4 * q + 3] * uv.w;
          bui += bbi[4 * q] * uv.x + bbi[4 * q + 1] * uv.y + bbi[4 * q + 2] * uv.z + bbi[4 * q + 3] * uv.w;
        }
        float nr = a.x * hr - a.y * hi + bur;
        float ni = a.x * hi + a.y * hr + bui;
        hr = nr; hi = ni;
        Hs[k16 * 136 + lane] = f2bf(hr);
        Hs[k16 * 136 + 64 + lane] = f2bf(hi);
      }
      __builtin_amdgcn_wave_barrier();
      f32x4 acc = {0.f, 0.f, 0.f, 0.f};
#pragma unroll
      for (int ks = 0; ks < 4; ++ks) {
        bf16x8 af = *(const bf16x8*)(Hs + pcol * 136 + 32 * ks + 8 * fq);
        acc = MFMA16(af, cf[ks], acc);
      }
#pragma unroll
      for (int jj = 0; jj < 4; ++jj) {
        int k = sub * 16 + 4 * fq + jj;
        int lt = dir ? 63 - k : k;
        ys[lt * 16 + pcol] = acc[jj];
      }
      __builtin_amdgcn_wave_barrier();
    }
    __syncthreads();
#pragma unroll
    for (int i = 0; i < 8; ++i) {
      int idx = tid + 256 * i; int gi = idx >> 10, lt = (idx >> 4) & 63, pp = idx & 15;
      const char* w0 = smem + (2 * gi) * 12544; const char* w1 = smem + (2 * gi + 1) * 12544;
      const int gg = gp * 2 + gi;
      float y = ((const float*)(w0 + 8448))[lt * 16 + pp] + ((const float*)(w1 + 8448))[lt * 16 + pp]
              + p.ssm_d[j * 256 + 16 * gg + pp] * ((const float*)w0)[lt * 16 + pp];
      float t = 0.7978845608028654f * (y + 0.044715f * y * y * y);
      float ge = 0.5f * y * (1.f + tanhf(t));
      int row = tok_row(b, 64 * Pc + lt);
      YG[(size_t)row * 256 + 16 * gg + pp] = f2bf(ge);
    }
    __syncthreads();
  }
}

__global__ void __launch_bounds__(NTHR, 2) fwd_megakernel(P p) {
  __shared__ __attribute__((aligned(16))) char smem[SMEM_BYTES];
  cg::grid_group grid = cg::this_grid();
  char* ws = p.ws;
  float* XC = (float*)(ws + OFF_XC);
  u16* ABUF = (u16*)(ws + OFF_ABUF);
  const float* modv = (const float*)(ws + OFF_MODV);

  __shared__ uint4 xb_words;
  unsigned* barw = (unsigned*)(ws + OFF_BAR);
  if (threadIdx.x == 0) xb_words = make_uint4(0u, 0u, 0u, 0u);
  if (blockIdx.x == 0) { for (int i = threadIdx.x; i < XCD_BAR_WORDS; i += NTHR) barw[i] = 0u; }
  for (int dd = 0; dd < DUPN(3); ++dd) prologue(p, smem);
  grid.sync();
  XcdBarrier xb = xcd_barrier_post(barw, (volatile LAS unsigned*)&xb_words);

  for (int layer = 0; layer < 4; ++layer) {
    const int j = layer >> 1;
    const bool need_ctx = layer < 3;
    const float* xs_lat = layer == 0 ? p.x : p.out;
    const float* xs_ctx = layer == 0 ? p.ctx : XC;
    const float* modl = modv + (size_t)layer * 17 * 6144;
    EpiArgs ea;
    ea.j = j; ea.gate = modl + 2 * 1024; ea.src_lat = xs_lat; ea.src_ctx = xs_ctx; ea.dst_lat = p.out; ea.dst_ctx = XC;

    for (int dd = 0; dd < DUPN(3); ++dd) norm_phase(xs_lat, xs_ctx, p.g_norm1 + layer * 1024, modl, 0, 1, NTOK, ABUF);
    for (int dd = 0; dd < DUPN(3); ++dd) ff_convert(p, layer, smem);
    GSYNC();

    if ((layer & 1) == 0) {
      for (int dd = 0; dd < DUPN(0); ++dd) gemm_phase<EPI_EVEN_IN>(p, ABUF, (const u16*)(ws + OFF_EIN + j * SZ_EIN), 1024, 288, 12, 6, ea, smem);
      GSYNC();
      for (int dd = 0; dd < DUPN(2); ++dd) s5_pass1(p, j, smem);
      for (int dd = 0; dd < DUPN(1); ++dd) attn_phase<64, false>((const u16*)(ws + E_Q), (const u16*)(ws + E_K), (const u16*)(ws + E_VT), 12, 4, 0.125f, ABUF, 0, need_ctx, nullptr, smem);
      GSYNC();
      for (int dd = 0; dd < DUPN(2); ++dd) s5_pass2(p, j, smem);
      GSYNC();
      for (int dd = 0; dd < DUPN(0); ++dd) gemm_phase<EPI_GLU>(p, (const u16*)(ws + E_YG), (const u16*)(ws + OFF_GLU + j * SZ_GLU), 256, 288, 2, 6, ea, smem);
      GSYNC();
    } else {
      for (int dd = 0; dd < DUPN(0); ++dd) gemm_phase<EPI_ODD_IN>(p, ABUF, (const u16*)(ws + OFF_OIN + j * SZ_OIN), 1024, 288, 19, 6, ea, smem);
      GSYNC();
      for (int dd = 0; dd < DUPN(0); ++dd) gemm_phase<EPI_UQ>(p, (const u16*)(ws + O_CQ), (const u16*)(ws + OFF_UQ + j * SZ_UQ), 512, 288, 8, 6, ea, smem);
      for (int dd = 0; dd < DUPN(0); ++dd) gemm_phase<EPI_UKV>(p, (const u16*)(ws + O_CKV), (const u16*)(ws + OFF_UKV + j * SZ_UKV), 256, 288, 8, 6, ea, smem);
      for (int dd = 0; dd < DUPN(1); ++dd) attn_phase<64, true>((const u16*)(ws + O_NQ), (const u16*)(ws + O_NK), (const u16*)(ws + O_NVT), 8, 8, 0.125f, ABUF, 512, need_ctx,
                           p.rpb + (size_t)j * 8 * 465, smem);
      GSYNC();
      for (int dd = 0; dd < DUPN(1); ++dd) attn_phase<96, false>((const u16*)(ws + O_MQ), (const u16*)(ws + O_MK), (const u16*)(ws + O_MVT), 8, 8, 0.10206207261596577f, ABUF, 0,
                            need_ctx, nullptr, smem);
      GSYNC();
    }
    const int mt = need_ctx ? 288 : 256;
    const int band = need_ctx ? 6 : 8;
    gemm_phase<EPI_RESID>(p, ABUF, (const u16*)(ws + ((layer & 1) ? OFF_OOUT : OFF_EOUT) + j * SZ_SQ), 1024, mt, 8, band, ea, smem);
    GSYNC();
    for (int dd = 0; dd < DUPN(3); ++dd) norm_phase(p.out, XC, p.g_norm2 + layer * 1024, modl, 3, 4, need_ctx ? NTOK : NLAT, ABUF);
    GSYNC();
    for (int dd = 0; dd < DUPN(0); ++dd) gemm_phase<EPI_RELU2>(p, ABUF, (const u16*)(ws + OFF_FF1), 1024, mt, 32, band, ea, smem);
    GSYNC();
    ea.gate = modl + 5 * 1024; ea.src_lat = p.out; ea.src_ctx = XC;
    gemm_phase<EPI_RESID>(p, (const u16*)(ws + OFF_H), (const u16*)(ws + OFF_FF2), 4096, mt, 8, band, ea, smem);
    GSYNC();
  }
}

extern "C" void kernel_launch(void* const* d_in, const int* in_sizes, int n_in, void* d_out, int out_size, void* d_ws, size_t ws_size,
                              hipStream_t stream) {
  static int grid_blocks = 0;
  if (!grid_blocks) {
    int dev = 0, cus = 0, per_cu = 0;
    hipGetDevice(&dev);
    hipDeviceGetAttribute(&cus, hipDeviceAttributeMultiprocessorCount, dev);
    hipOccupancyMaxActiveBlocksPerMultiprocessor(&per_cu, fwd_megakernel, NTHR, 0);
    if (per_cu > 2) per_cu = 2;
    if (per_cu < 1) per_cu = 1;
    grid_blocks = cus * per_cu;
    grid_blocks &= ~7;
  }
  P p{};
  const float** f = (const float**)&p;
  for (int i = 0; i < 35; ++i) f[i] = (const float*)d_in[i];
  p.out = (float*)d_out;
  p.ws = (char*)d_ws;
  void* args[] = {&p};
  hipError_t e = hipLaunchCooperativeKernel((void*)fwd_megakernel, dim3(grid_blocks), dim3(NTHR), args, 0, stream);
  if (e != hipSuccess) fprintf(stderr, "cooperative launch failed: %s (grid %d)\n", hipGetErrorString(e), grid_blocks);
}
```

```cpp
#include <hip/hip_runtime.h>
#include <hip/hip_cooperative_groups.h>
#include <cstdio>
namespace cg = cooperative_groups;

typedef unsigned short u16;
using bf16x8 = __attribute__((ext_vector_type(8))) short;
using f32x16 = __attribute__((ext_vector_type(16))) float;
using f32x4 = __attribute__((ext_vector_type(4))) float;
typedef __attribute__((ext_vector_type(2))) __bf16 bf2_t;
using u32x4 = __attribute__((ext_vector_type(4))) unsigned;
#define DI __device__ __forceinline__
#define MFMA32(a, b, c) __builtin_amdgcn_mfma_f32_32x32x16_bf16((a), (b), (c), 0, 0, 0)
#define MFMA16(a, b, c) __builtin_amdgcn_mfma_f32_16x16x32_bf16((a), (b), (c), 0, 0, 0)

#ifndef GPROBE
#define GPROBE -1
#endif
#ifndef DUP_MASK
#define DUP_MASK 0
#endif
#define DUPN(bit) (((DUP_MASK) >> (bit)) & 1 ? 2 : 1)
constexpr int NTHR = 256;
constexpr int NLAT = 32768, NTOK = 36864, SP = 2304;
constexpr float EPSF = 1e-6f;
constexpr float LOG2E = 1.4426950408889634f;
constexpr int SMEM_BYTES = 73728;
constexpr int CP = 132;

constexpr size_t SZ_EIN = 1536ull * 1024 * 2, SZ_SQ = 1024ull * 1024 * 2, SZ_OIN = 2432ull * 1024 * 2;
constexpr size_t SZ_UQ = 1024ull * 512 * 2, SZ_UKV = 1024ull * 256 * 2, SZ_GLU = 256ull * 256 * 2;
constexpr size_t OFF_EIN = 0;
constexpr size_t OFF_EOUT = OFF_EIN + 2 * SZ_EIN;
constexpr size_t OFF_OIN = OFF_EOUT + 2 * SZ_SQ;
constexpr size_t OFF_OOUT = OFF_OIN + 2 * SZ_OIN;
constexpr size_t OFF_UQ = OFF_OOUT + 2 * SZ_SQ;
constexpr size_t OFF_UKV = OFF_UQ + 2 * SZ_UQ;
constexpr size_t OFF_GLU = OFF_UKV + 2 * SZ_UKV;
constexpr size_t OFF_FF1 = OFF_GLU + 2 * SZ_GLU;
constexpr size_t OFF_FF2 = OFF_FF1 + 4096ull * 1024 * 2;
constexpr size_t OFF_MODV = OFF_FF2 + 4096ull * 1024 * 2;
constexpr size_t OFF_ROPE = OFF_MODV + 4ull * 17 * 6144 * 4;
constexpr size_t OFF_SA = OFF_ROPE + 16384;
constexpr size_t OFF_SAL = OFF_SA + 4096 * 8;
constexpr size_t OFF_SBB = OFF_SAL + 4096 * 8;
constexpr size_t OFF_BAR = OFF_SBB + 4096ull * 32 * 4;
constexpr size_t OFF_XC = OFF_BAR + 16384;
constexpr size_t OFF_ABUF = OFF_XC + 4096ull * 1024 * 4;
constexpr size_t OFF_R1 = OFF_ABUF + (size_t)NTOK * 1024 * 2;
constexpr size_t E_Q = OFF_R1;
constexpr size_t E_K = E_Q + 16ull * 12 * SP * 64 * 2;
constexpr size_t E_VT = E_K + 16ull * 4 * SP * 64 * 2;
constexpr size_t E_U = E_VT + 16ull * 4 * SP * 64 * 2;
constexpr size_t E_E = E_U + (size_t)NTOK * 256 * 4;
constexpr size_t E_YG = E_E + 16ull * 16 * 2 * 36 * 64 * 8;
constexpr size_t O_CQ = OFF_R1;
constexpr size_t O_CKV = O_CQ + (size_t)NTOK * 512 * 2;
constexpr size_t O_KR = O_CKV + (size_t)NTOK * 256 * 2;
constexpr size_t O_PS = O_KR + (size_t)NTOK * 32 * 4;
constexpr size_t O_NQ = O_PS + (size_t)NTOK * 8 * 4;
constexpr size_t O_NK = O_NQ + 16ull * 8 * SP * 64 * 2;
constexpr size_t O_NVT = O_NK + 16ull * 8 * SP * 64 * 2;
constexpr size_t O_MQ = O_NVT + 16ull * 8 * SP * 64 * 2;
constexpr size_t O_MK = O_MQ + 16ull * 8 * SP * 96 * 2;
constexpr size_t O_MVT = O_MK + 16ull * 8 * SP * 96 * 2;
constexpr size_t O_END = O_MVT + 16ull * 8 * SP * 64 * 2;
constexpr size_t OFF_H = OFF_R1;

struct P {
  const float *x, *c, *ctx, *c_ctx, *w_mod, *b_mod, *g_norm1, *g_norm2, *w_ff1, *w_ff2;
  const float *e_w_in, *e_w_out, *e_g_q, *e_g_k, *lam_re, *lam_im, *log_dt, *b_re, *b_im, *c_re, *c_im, *ssm_d, *w_glu, *b_glu;
  const float *o_w_in, *o_w_out, *g_cq, *g_ckv, *w_uq, *w_ukv, *g_mq, *g_mk, *g_nq, *g_nk, *rpb;
  float* out;
  char* ws;
};

DI unsigned pack2(float a, float b) { bf2_t v; v[0] = (__bf16)a; v[1] = (__bf16)b; return __builtin_bit_cast(unsigned, v); }
DI u16 f2bf(float a) { __bf16 v = (__bf16)a; return __builtin_bit_cast(u16, v); }
DI float bf2f(u16 v) { return __uint_as_float(((unsigned)v) << 16); }
#define GSYNC() do { for (int dd_ = 0; dd_ < DUPN(4); ++dd_) xcd_barrier(xb); } while (0)
DI int otid() { int t = threadIdx.x; asm volatile("" : "+v"(t)); return t; }
DI int tok_row(int b, int pos) { return pos < 256 ? NLAT + b * 256 + pos : b * 2048 + pos - 256; }


#define XB_TMO      128
#define XB_XCNT(j)  (256  + 64 * (j))
#define XB_XSUB(j)  (1280 + 64 * (j))
#define XB_XGEN(j)  (2304 + 64 * (j))
#define XB_TOP      3328
#define XB_TOPGEN   3392
#define XCD_BAR_WORDS 3456
#define XB_SPIN_CAP (1u << 22)
#define LAS __attribute__((address_space(3)))
DI unsigned xb_ld(unsigned* p) { return __hip_atomic_load(p, __ATOMIC_RELAXED, __HIP_MEMORY_SCOPE_AGENT); }
DI unsigned xb_add(unsigned* p, unsigned v) { return __hip_atomic_fetch_add(p, v, __ATOMIC_RELAXED, __HIP_MEMORY_SCOPE_AGENT); }
DI unsigned xb_xcc_id() { return (unsigned)__builtin_amdgcn_s_getreg((3 << 11) | 20) & 0xFu; }
#define XB_SPIN(cond, bar) do { unsigned _sp = 0; while (cond) { __builtin_amdgcn_s_sleep(1); \
    if ((++_sp & 255u) == 0u) { if (xb_ld(&(bar)[XB_TMO])) break; if (_sp > XB_SPIN_CAP) { atomicAdd(&(bar)[XB_TMO], 1u); break; } } } } while (0)
struct XcdBarrier { unsigned* bar; unsigned x; volatile LAS unsigned* st; };
DI XcdBarrier xcd_barrier_post(unsigned* bar, volatile LAS unsigned* st) {
  XcdBarrier b; b.bar = bar; b.x = xb_xcc_id(); b.st = st;
  if (threadIdx.x == 0) (void)xb_add(&bar[XB_XCNT(b.x)], 1u);
  return b;
}
DI void xcd_barrier_complete(unsigned* bar, unsigned x, unsigned& nloc, unsigned& nx) {
  const unsigned G = gridDim.x * gridDim.y * gridDim.z;
  unsigned sum, cnt, mine, sp = 0u;
  for (;;) {
    sum = 0u; cnt = 0u; mine = 0u;
#pragma unroll
    for (unsigned j = 0; j < 16; ++j) { const unsigned c = xb_ld(&bar[XB_XCNT(j)]); sum += c; cnt += (c > 0u) ? 1u : 0u; mine = (j == x) ? c : mine; }
    if (sum == G) break;
    __builtin_amdgcn_s_sleep(1);
    if ((++sp & 255u) == 0u) { if (xb_ld(&bar[XB_TMO])) break; if (sp > XB_SPIN_CAP) { atomicAdd(&bar[XB_TMO], 1u); break; } }
  }
  nloc = mine > 0u ? mine : 1u; nx = cnt > 0u ? cnt : 1u;
}
DI void xcd_barrier(const XcdBarrier& b) {
  asm volatile("s_waitcnt vmcnt(0)" ::: "memory");
  __syncthreads();
  if (threadIdx.x == 0) {
    unsigned* bar = b.bar;
    __builtin_amdgcn_s_waitcnt(0);
    unsigned nloc = b.st[0], nx = b.st[1];
    if (nloc == 0u) { xcd_barrier_complete(bar, b.x, nloc, nx); b.st[0] = nloc; b.st[1] = nx; }
    const unsigned old = xb_add(&bar[XB_XSUB(b.x)], 1u);
    const unsigned gen = old / nloc;
    if (old + 1u == (gen + 1u) * nloc) {
      __builtin_amdgcn_fence(__ATOMIC_RELEASE, "agent");
      asm volatile("s_waitcnt vmcnt(0)" ::: "memory");
      const unsigned og = xb_add(&bar[XB_TOP], 1u);
      const unsigned tg = og / nx;
      if (og + 1u == (tg + 1u) * nx) xb_add(&bar[XB_TOPGEN], 1u);
      else XB_SPIN(xb_ld(&bar[XB_TOPGEN]) == tg, bar);
      __builtin_amdgcn_fence(__ATOMIC_ACQUIRE, "agent");
      xb_add(&bar[XB_XGEN(b.x)], 1u);
      asm volatile("s_waitcnt vmcnt(0)" ::: "memory");
    } else {
      XB_SPIN(xb_ld(&bar[XB_XGEN(b.x)]) == gen, bar);
      __builtin_amdgcn_fence(__ATOMIC_ACQUIRE, "agent");
      asm volatile("s_waitcnt vmcnt(0)" ::: "memory");
    }
  }
  __syncthreads();
}

DI int map_col(int mapk, int n, int N) {
  if (mapk == 0) return n < N ? n : -1;
  if (mapk == 1) { if (n < 768) return n; if (n < 2304) return n + 32; if (n < 2336) return n - 2304 + 768; return -1; }
  int h = n >> 7, jj = n & 127; return jj < 96 ? h * 96 + jj : -1;
}
DI void tr_tile(const float* __restrict__ src, int K, int N, int Npad, int mapk, const float* __restrict__ ks,
                        u16* __restrict__ dst, int tile, char* smem) {
  float* tl = (float*)smem;
  const int tid = otid();
  const int tnn = Npad >> 6;
  const int n0 = (tile % tnn) * 64, k0 = (tile / tnn) * 64;
  const int nn = tid & 63;
  const int sn = map_col(mapk, n0 + nn, N);
#pragma unroll 4
  for (int i = 0; i < 16; ++i) {
    int kk = (tid >> 6) + 4 * i;
    float v = 0.f;
    if (sn >= 0) { v = src[(size_t)(k0 + kk) * N + sn]; if (ks) v *= ks[k0 + kk]; }
    tl[kk * 65 + nn] = v;
  }
  __syncthreads();
#pragma unroll 4
  for (int i = 0; i < 16; ++i) {
    int n2 = (tid >> 6) + 4 * i, kk = tid & 63;
    dst[(size_t)(n0 + n2) * K + k0 + kk] = f2bf(tl[kk * 65 + n2]);
  }
  __syncthreads();
}

DI void ff_convert(const P& p, int layer, char* smem) {
  u16* f1 = (u16*)(p.ws + OFF_FF1);
  u16* f2 = (u16*)(p.ws + OFF_FF2);
  const float* s1 = p.w_ff1 + (size_t)layer * 1024 * 4096;
  const float* s2 = p.w_ff2 + (size_t)layer * 4096 * 1024;
  for (int t = gridDim.x - 1 - blockIdx.x; t < 2048; t += gridDim.x) {
    if (t < 1024) tr_tile(s1, 1024, 4096, 4096, 0, nullptr, f1, t, smem);
    else tr_tile(s2, 4096, 1024, 1024, 0, nullptr, f2, t - 1024, smem);
  }
}

DI void prologue(const P& p, char* smem) {
  const int tid = otid();
  float* modv = (float*)(p.ws + OFF_MODV);
  for (int it = blockIdx.x; it < 384; it += gridDim.x) {
    float* cond = (float*)smem;
    for (int idx = tid; idx < 17 * 1024; idx += NTHR) {
      int bb = idx >> 10, k = idx & 1023;
      float v = bb < 16 ? p.c[bb * 1024 + k] : p.c_ctx[k];
      cond[idx] = v / (1.f + __expf(-v));
    }
    __syncthreads();
    const int l = it / 96, n = (it % 96) * 64 + (tid & 63), kq = tid >> 6;
    float acc[17];
#pragma unroll
    for (int i = 0; i < 17; ++i) acc[i] = 0.f;
    const float* wp = p.w_mod + ((size_t)l * 1024 + kq * 256) * 6144 + n;
    for (int k4 = 0; k4 < 64; ++k4) {
      float w0 = wp[(size_t)(k4 * 4 + 0) * 6144], w1 = wp[(size_t)(k4 * 4 + 1) * 6144];
      float w2 = wp[(size_t)(k4 * 4 + 2) * 6144], w3 = wp[(size_t)(k4 * 4 + 3) * 6144];
#pragma unroll
      for (int bb = 0; bb < 17; ++bb) {
        float4 c4 = *(const float4*)(cond + bb * 1024 + kq * 256 + k4 * 4);
        acc[bb] += c4.x * w0 + c4.y * w1 + c4.z * w2 + c4.w * w3;
      }
    }
    __syncthreads();
    float* red = (float*)smem;
#pragma unroll
    for (int bb = 0; bb < 17; ++bb) red[(kq * 17 + bb) * 64 + (tid & 63)] = acc[bb];
    __syncthreads();
    for (int o = tid; o < 17 * 64; o += NTHR) {
      int bb = o >> 6, nn = o & 63;
      int ncol = (it % 96) * 64 + nn;
      float s = red[(0 * 17 + bb) * 64 + nn] + red[(1 * 17 + bb) * 64 + nn] + red[(2 * 17 + bb) * 64 + nn] + red[(3 * 17 + bb) * 64 + nn];
      modv[((size_t)l * 17 + bb) * 6144 + ncol] = s + p.b_mod[l * 6144 + ncol];
    }
    __syncthreads();
  }
  {
    float* rt = (float*)(p.ws + OFF_ROPE);
    for (int idx = blockIdx.x * NTHR + tid; idx < 1024 + 512; idx += gridDim.x * NTHR) {
      if (idx < 1024) {
        int pos = idx >> 4, i = idx & 15;
        float f = powf(10000.f, -(float)(2 * i) / 32.f);
        float a = (float)pos * f;
        rt[idx] = cosf(a); rt[1024 + idx] = sinf(a);
      } else {
        int q = idx - 1024; int pos = q >> 3, i = q & 7;
        float f = powf(10000.f, -(float)(2 * i) / 16.f);
        float a = (float)pos * f;
        rt[2048 + q] = cosf(a); rt[2560 + q] = sinf(a);
      }
    }
    float2* SA = (float2*)(p.ws + OFF_SA);
    float2* SAL = (float2*)(p.ws + OFF_SAL);
    float* SBB = (float*)(p.ws + OFF_SBB);
    for (int idx = blockIdx.x * NTHR + tid; idx < 4096; idx += gridDim.x * NTHR) {
      float lre = p.lam_re[idx], lim = p.lam_im[idx];
      float dt = expf(p.log_dt[idx >> 6]);
      float mag = expf(lre * dt);
      float are = mag * cosf(lim * dt), aim = mag * sinf(lim * dt);
      float den = lre * lre + lim * lim;
      float fre = ((are - 1.f) * lre + aim * lim) / den;
      float fim = (aim * lre - (are - 1.f) * lim) / den;
      SA[idx] = make_float2(are, aim);
      float pr = are, pi = aim;
#pragma unroll
      for (int q = 0; q < 6; ++q) { float nr = pr * pr - pi * pi, ni = 2.f * pr * pi; pr = nr; pi = ni; }
      SAL[idx] = make_float2(pr, pi);
#pragma unroll
      for (int q = 0; q < 16; ++q) {
        float br = p.b_re[(size_t)idx * 16 + q], bi = p.b_im[(size_t)idx * 16 + q];
        SBB[(size_t)idx * 32 + q] = fre * br - fim * bi;
        SBB[(size_t)idx * 32 + 16 + q] = fre * bi + fim * br;
      }
    }
  }
  for (int t = gridDim.x - 1 - blockIdx.x; t < 3424; t += gridDim.x) {
    int j = t / 1712, r = t % 1712;
    if (r < 384) tr_tile(p.e_w_in + (size_t)j * 1024 * 1536, 1024, 1536, 1536, 0, nullptr, (u16*)(p.ws + OFF_EIN + j * SZ_EIN), r, smem);
    else if (r < 640) tr_tile(p.e_w_out + (size_t)j * 1024 * 1024, 1024, 1024, 1024, 0, nullptr, (u16*)(p.ws + OFF_EOUT + j * SZ_SQ), r - 384, smem);
    else if (r < 1248) tr_tile(p.o_w_in + (size_t)j * 1024 * 2336, 1024, 2336, 2432, 1, nullptr, (u16*)(p.ws + OFF_OIN + j * SZ_OIN), r - 640, smem);
    else if (r < 1504) tr_tile(p.o_w_out + (size_t)j * 1024 * 1024, 1024, 1024, 1024, 0, nullptr, (u16*)(p.ws + OFF_OOUT + j * SZ_SQ), r - 1248, smem);
    else if (r < 1632) tr_tile(p.w_uq + (size_t)j * 512 * 768, 512, 768, 1024, 2, p.g_cq + j * 512, (u16*)(p.ws + OFF_UQ + j * SZ_UQ), r - 1504, smem);
    else if (r < 1696) tr_tile(p.w_ukv + (size_t)j * 256 * 1024, 256, 1024, 1024, 0, p.g_ckv + j * 256, (u16*)(p.ws + OFF_UKV + j * SZ_UKV), r - 1632, smem);
    else tr_tile(p.w_glu + (size_t)j * 256 * 256, 256, 256, 256, 0, nullptr, (u16*)(p.ws + OFF_GLU + j * SZ_GLU), r - 1696, smem);
  }
}

DI void norm_phase(const float* __restrict__ xl, const float* __restrict__ xc, const float* __restrict__ g,
                           const float* __restrict__ modl, int shift_i, int scale_i, int nrows, u16* __restrict__ dst) {
  const int tid_ = otid();
  const int lane = tid_ & 63;
  const int gw = blockIdx.x * 4 + (tid_ >> 6);
  for (int R = gw; R < nrows; R += gridDim.x * 4) {
    const float* src = R < NLAT ? xl + (size_t)R * 1024 : xc + (size_t)(R - NLAT) * 1024;
    const int mrow = R < NLAT ? (R >> 11) : 16;
    float4 v[4];
    float ss = 0.f;
#pragma unroll
    for (int i = 0; i < 4; ++i) {
      v[i] = *(const float4*)(src + lane * 4 + 256 * i);
      ss += v[i].x * v[i].x + v[i].y * v[i].y + v[i].z * v[i].z + v[i].w * v[i].w;
    }
#pragma unroll
    for (int o = 32; o >= 1; o >>= 1) ss += __shfl_xor(ss, o);
    const float rstd = rsqrtf(ss * (1.f / 1024.f) + EPSF);
    const float* sh = modl + (size_t)mrow * 6144 + shift_i * 1024;
    const float* sc = modl + (size_t)mrow * 6144 + scale_i * 1024;
#pragma unroll
    for (int i = 0; i < 4; ++i) {
      int col = lane * 4 + 256 * i;
      float4 gg = *(const float4*)(g + col), s4 = *(const float4*)(sh + col), c4 = *(const float4*)(sc + col);
      float y0 = v[i].x * rstd * gg.x * (1.f + c4.x) + s4.x;
      float y1 = v[i].y * rstd * gg.y * (1.f + c4.y) + s4.y;
      float y2 = v[i].z * rstd * gg.z * (1.f + c4.z) + s4.z;
      float y3 = v[i].w * rstd * gg.w * (1.f + c4.w) + s4.w;
      uint2 o2; o2.x = pack2(y0, y1); o2.y = pack2(y2, y3);
      *(uint2*)(dst + (size_t)R * 1024 + col) = o2;
    }
  }
}

enum { EPI_EVEN_IN = 0, EPI_ODD_IN, EPI_UQ, EPI_UKV, EPI_GLU, EPI_RESID, EPI_RELU2 };

struct EpiArgs {
  int j;
  const float* gate;
  const float* src_lat; const float* src_ctx; float* dst_lat; float* dst_ctx;
};

DI void store16(u16* dst, const float* y) {
  uint4 a, b;
  a.x = pack2(y[0], y[1]); a.y = pack2(y[2], y[3]); a.z = pack2(y[4], y[5]); a.w = pack2(y[6], y[7]);
  b.x = pack2(y[8], y[9]); b.y = pack2(y[10], y[11]); b.z = pack2(y[12], y[13]); b.w = pack2(y[14], y[15]);
  *(uint4*)dst = a; *(uint4*)(dst + 8) = b;
}
DI void load16(const float* s, float* v) {
#pragma unroll
  for (int q = 0; q < 4; ++q) { float4 t = *(const float4*)(s + 4 * q); v[4 * q] = t.x; v[4 * q + 1] = t.y; v[4 * q + 2] = t.z; v[4 * q + 3] = t.w; }
}

DI void epi_head64(const P& p, const float* Cs, int b, int pos0, bool isctx, const float* __restrict__ g, bool rope,
                   u16* __restrict__ dstbase, int H, int head0) {
  const int tid = otid(), sub = tid & 7, hh = sub >> 2, jq = sub & 3;
  const float* rt = (const float*)(p.ws + OFF_ROPE);
#pragma unroll 1
  for (int pass = 0; pass < 4; ++pass) {
    const int row = pass * 32 + (tid >> 3);
    float v[16], pv[16];
    load16(Cs + row * CP + 16 * sub, v);
    float ss = 0.f;
#pragma unroll
    for (int i = 0; i < 16; ++i) ss += v[i] * v[i];
    ss += __shfl_xor(ss, 1); ss += __shfl_xor(ss, 2);
    const float rs = rsqrtf(ss * (1.f / 64.f) + EPSF);
#pragma unroll
    for (int i = 0; i < 16; ++i) v[i] = v[i] * rs * g[16 * jq + i];
    const int pos = pos0 + row;
    if (rope && !isctx) {
      load16(Cs + row * CP + 16 * (sub ^ 1), pv);
      const int lp = pos - 256;
      const int ti = (jq < 2) ? (lp >> 6) : (lp & 63);
      const float sgn = (jq & 1) ? 1.f : -1.f;
#pragma unroll
      for (int i = 0; i < 16; ++i) {
        float pn = pv[i] * rs * g[16 * (jq ^ 1) + i];
        float cs = rt[ti * 16 + i], sn = rt[1024 + ti * 16 + i];
        v[i] = v[i] * cs + sgn * pn * sn;
      }
    }
    store16(dstbase + (((size_t)b * H + head0 + hh) * SP + pos) * 64 + 16 * jq, v);
  }
}

DI void epi_vt(const float* Cs, int b, int pos0, u16* __restrict__ dstbase, int H, int head0, int c0, int ncols, float mul_unused) {
  const int tid = otid();
  const int cl = tid % ncols, tg = tid / ncols, ngrp = NTHR / ncols;
  const int col = c0 + cl;
  const int head = head0 + (cl >> 6), d = cl & 63;
  u16* drow = dstbase + (((size_t)b * H + head) * 64 + d) * SP + pos0;
  for (int tk = tg; tk < 16; tk += ngrp) {
    float y[8];
#pragma unroll
    for (int e = 0; e < 8; ++e) y[e] = Cs[(tk * 8 + e) * CP + col];
    uint4 a; a.x = pack2(y[0], y[1]); a.y = pack2(y[2], y[3]); a.z = pack2(y[4], y[5]); a.w = pack2(y[6], y[7]);
    *(uint4*)(drow + tk * 8) = a;
  }
}

template <int EPI>
DI void epilogue(const P& p, const EpiArgs& ea, float* Cs, int mtile, int ntile) {
  const int tid = otid();
  const int m0 = mtile * 128, n0 = ntile * 128;
  const bool isctx = m0 >= NLAT;
  const int b = isctx ? ((m0 - NLAT) >> 8) : (m0 >> 11);
  const int pos0 = isctx ? ((m0 - NLAT) & 255) : 256 + (m0 & 2047);
  const int mrow = isctx ? 16 : b;
  char* ws = p.ws;
  if (EPI == EPI_RESID) {
    const int c4 = (tid & 31) * 4;
    const int n = n0 + c4;
    const int R0 = m0 + (tid >> 5);
    const float* src = (isctx ? ea.src_ctx + (size_t)(R0 - NLAT) * 1024 : ea.src_lat + (size_t)R0 * 1024) + n;
    float* dst = (isctx ? ea.dst_ctx + (size_t)(R0 - NLAT) * 1024 : ea.dst_lat + (size_t)R0 * 1024) + n;
    const float4 gv = *(const float4*)(ea.gate + (size_t)mrow * 6144 + n);
    float4 xv[16];
#pragma unroll
    for (int pass = 0; pass < 16; ++pass) xv[pass] = *(const float4*)(src + (size_t)pass * 8 * 1024);
#pragma unroll
    for (int pass = 0; pass < 16; ++pass) {
      const int row = pass * 8 + (tid >> 5);
      float4 a = *(const float4*)(Cs + row * CP + c4);
      float4 o; o.x = xv[pass].x + gv.x * a.x; o.y = xv[pass].y + gv.y * a.y; o.z = xv[pass].z + gv.z * a.z; o.w = xv[pass].w + gv.w * a.w;
      *(float4*)(dst + (size_t)pass * 8 * 1024) = o;
    }
  } else if (EPI == EPI_RELU2 || EPI == EPI_GLU) {
    const int c4 = (tid & 31) * 4;
    const int n = n0 + c4;
#pragma unroll 4
    for (int pass = 0; pass < 16; ++pass) {
      const int row = pass * 8 + (tid >> 5);
      const int R = m0 + row;
      float4 a = *(const float4*)(Cs + row * CP + c4);
      if (EPI == EPI_RELU2) {
        float r0 = fmaxf(a.x, 0.f), r1 = fmaxf(a.y, 0.f), r2 = fmaxf(a.z, 0.f), r3 = fmaxf(a.w, 0.f);
        uint2 o; o.x = pack2(r0 * r0, r1 * r1); o.y = pack2(r2 * r2, r3 * r3);
        *(uint2*)((u16*)(ws + OFF_H) + (size_t)R * 4096 + n) = o;
      } else {
        const u16* yg = (const u16*)(ws + E_YG) + (size_t)R * 256 + n;
        uint2 yv = *(const uint2*)yg;
        float4 bg = *(const float4*)(p.b_glu + ea.j * 256 + n);
        float y0 = __uint_as_float(yv.x << 16), y1 = __uint_as_float(yv.x & 0xffff0000u);
        float y2 = __uint_as_float(yv.y << 16), y3 = __uint_as_float(yv.y & 0xffff0000u);
        float o0 = y0 / (1.f + __expf(-(a.x + bg.x))), o1 = y1 / (1.f + __expf(-(a.y + bg.y)));
        float o2 = y2 / (1.f + __expf(-(a.z + bg.z))), o3 = y3 / (1.f + __expf(-(a.w + bg.w)));
        uint2 o; o.x = pack2(o0, o1); o.y = pack2(o2, o3);
        *(uint2*)((u16*)(ws + OFF_ABUF) + (size_t)R * 1024 + 768 + n) = o;
      }
    }
  } else if (EPI == EPI_EVEN_IN) {
    if (ntile < 6) epi_head64(p, Cs, b, pos0, isctx, p.e_g_q + ea.j * 64, true, (u16*)(ws + E_Q), 12, ntile * 2);
    else if (ntile < 8) epi_head64(p, Cs, b, pos0, isctx, p.e_g_k + ea.j * 64, true, (u16*)(ws + E_K), 4, (ntile - 6) * 2);
    else if (ntile < 10) epi_vt(Cs, b, pos0, (u16*)(ws + E_VT), 4, (ntile - 8) * 2, 0, 128, 1.f);
    else {
      const int c4 = (tid & 31) * 4;
      float* U = (float*)(ws + E_U);
      for (int pass = 0; pass < 16; ++pass) {
        const int row = pass * 8 + (tid >> 5);
        *(float4*)(U + (size_t)(m0 + row) * 256 + (ntile - 10) * 128 + c4) = *(const float4*)(Cs + row * CP + c4);
      }
    }
  } else if (EPI == EPI_ODD_IN) {
    if (ntile < 6) {
      const int c4 = (tid & 31) * 4;
      float* PS = (float*)(ws + O_PS);
      for (int pass = 0; pass < 16; ++pass) {
        const int row = pass * 8 + (tid >> 5);
        const int R = m0 + row;
        float4 a = *(const float4*)(Cs + row * CP + c4);
        float ss = a.x * a.x + a.y * a.y + a.z * a.z + a.w * a.w;
#pragma unroll
        for (int o = 16; o >= 1; o >>= 1) ss += __shfl_xor(ss, o);
        if ((tid & 31) == 0) PS[(size_t)R * 8 + ntile] = ss;
        uint2 o; o.x = pack2(a.x, a.y); o.y = pack2(a.z, a.w);
        if (ntile < 4) *(uint2*)((u16*)(ws + O_CQ) + (size_t)R * 512 + n0 + c4) = o;
        else *(uint2*)((u16*)(ws + O_CKV) + (size_t)R * 256 + (n0 - 512) + c4) = o;
      }
    } else if (ntile < 10) epi_head64(p, Cs, b, pos0, isctx, p.g_nq + ea.j * 64, false, (u16*)(ws + O_NQ), 8, (ntile - 6) * 2);
    else if (ntile < 14) epi_head64(p, Cs, b, pos0, isctx, p.g_nk + ea.j * 64, false, (u16*)(ws + O_NK), 8, (ntile - 10) * 2);
    else if (ntile < 18) epi_vt(Cs, b, pos0, (u16*)(ws + O_NVT), 8, (ntile - 14) * 2, 0, 128, 1.f);
    else {
      float* KR = (float*)(ws + O_KR);
      const int c4 = (tid & 7) * 4;
      for (int pass = 0; pass < 4; ++pass) {
        const int row = pass * 32 + (tid >> 3);
        *(float4*)(KR + (size_t)(m0 + row) * 32 + c4) = *(const float4*)(Cs + row * CP + c4);
      }
    }
  } else if (EPI == EPI_UQ || EPI == EPI_UKV) {
    const int sub = tid & 7;
    const float* PS = (const float*)(ws + O_PS);
    const float* rt = (const float*)(ws + OFF_ROPE);
    const float* gm = (EPI == EPI_UQ ? p.g_mq : p.g_mk) + ea.j * 96;
    u16* dstb = (u16*)(ws + (EPI == EPI_UQ ? O_MQ : O_MK));
    const float* KR = (const float*)(ws + O_KR);
#pragma unroll 1
    for (int pass = 0; pass < 4; ++pass) {
      const int row = pass * 32 + (tid >> 3);
      const int R = m0 + row;
      float rstd;
      if (EPI == EPI_UQ) {
        float4 ps = *(const float4*)(PS + (size_t)R * 8);
        rstd = rsqrtf((ps.x + ps.y + ps.z + ps.w) * (1.f / 512.f) + EPSF);
      } else {
        float2 ps = *(const float2*)(PS + (size_t)R * 8 + 4);
        rstd = rsqrtf((ps.x + ps.y) * (1.f / 256.f) + EPSF);
      }
      float v[16];
      if (EPI == EPI_UQ) {
        load16(Cs + row * CP + 16 * sub, v);
#pragma unroll
        for (int i = 0; i < 16; ++i) v[i] *= rstd;
      } else {
        if (sub < 4) {
          load16(Cs + row * CP + 16 * sub, v);
#pragma unroll
          for (int i = 0; i < 16; ++i) v[i] *= rstd;
        } else if (sub < 6) {
          load16(KR + (size_t)R * 32 + 16 * (sub - 4), v);
        } else {
#pragma unroll
          for (int i = 0; i < 16; ++i) v[i] = 0.f;
        }
      }
      float ss = 0.f;
#pragma unroll
      for (int i = 0; i < 16; ++i) ss += v[i] * v[i];
      ss += __shfl_xor(ss, 1); ss += __shfl_xor(ss, 2); ss += __shfl_xor(ss, 4);
      const float rs = rsqrtf(ss * (1.f / 96.f) + EPSF);
      if (sub < 6) {
#pragma unroll
        for (int i = 0; i < 16; ++i) v[i] = v[i] * rs * gm[16 * sub + i];
        const int pos = pos0 + row;
        if (sub >= 4 && !isctx) {
          const int lp = pos - 256;
          const int ti = (sub == 4) ? (lp >> 6) : (lp & 63);
#pragma unroll
          for (int i = 0; i < 8; ++i) {
            float cs = rt[2048 + ti * 8 + i], sn = rt[2560 + ti * 8 + i];
            float x1 = v[i], x2 = v[i + 8];
            v[i] = x1 * cs - x2 * sn;
            v[i + 8] = x2 * cs + x1 * sn;
          }
        }
        store16(dstb + (((size_t)b * 8 + ntile) * SP + pos) * 96 + 16 * sub, v);
      }
    }
    if (EPI == EPI_UKV) {
      const int cl = tid & 63, tg = tid >> 6;
      u16* drow = (u16*)(ws + O_MVT) + (((size_t)b * 8 + ntile) * 64 + cl) * SP + pos0;
      for (int tk = tg; tk < 16; tk += 4) {
        float y[8];
#pragma unroll
        for (int e = 0; e < 8; ++e) {
          const int R = m0 + tk * 8 + e;
          float2 ps = *(const float2*)(PS + (size_t)R * 8 + 4);
          float rstd = rsqrtf((ps.x + ps.y) * (1.f / 256.f) + EPSF);
          y[e] = Cs[(tk * 8 + e) * CP + 64 + cl] * rstd;
        }
        uint4 a; a.x = pack2(y[0], y[1]); a.y = pack2(y[2], y[3]); a.z = pack2(y[4], y[5]); a.w = pack2(y[6], y[7]);
        *(uint4*)(drow + tk * 8) = a;
      }
    }
  }
}

template <int EPI, int PROBE = 0>
DI void gemm_phase(const P& p, const u16* __restrict__ A, const u16* __restrict__ Bt, int K, int mt, int ntn, int band,
                           const EpiArgs& ea, char* smem) {
  const int tid = otid(), lane = tid & 63, w = tid >> 6, wm = w >> 1, wn = w & 1, r = lane & 31, h = lane >> 5;
  u16* As = (u16*)smem;
  u16* Bs = As + 2 * 9216;
  float* Cs = (float*)smem;
  const int total = mt * ntn;
  const int mper = mt >> 3;
  const int nk = K >> 6;
  const int lrow = tid >> 3, lkc = (tid & 7) * 8;
  for (int t = blockIdx.x; t < total; t += gridDim.x) {
    const int xcd = t & 7, L = t >> 3;
    const int bandsz = band * ntn;
    const int bi = L / bandsz, rr = L - bi * bandsz;
    const int full = (ntn >> 3) * (band * 8);
    int mi_, ni_;
    if (rr < full) { int ch = rr / (band * 8); int wv = rr - ch * (band * 8); mi_ = wv % band; ni_ = ch * 8 + wv / band; }
    else { int r2 = rr - full; mi_ = r2 % band; ni_ = (ntn >> 3) * 8 + r2 / band; }
    const int mtile = xcd * mper + bi * band + mi_;
    const int ntile = ni_;
    const u16* Ag = A + (size_t)(mtile * 128 + lrow) * K + lkc;
    const u16* Bg = Bt + (size_t)(ntile * 128 + lrow) * K + lkc;
    f32x16 acc[2][2];
#pragma unroll
    for (int a = 0; a < 2; ++a)
#pragma unroll
      for (int c = 0; c < 2; ++c)
#pragma unroll
        for (int i = 0; i < 16; ++i) acc[a][c][i] = 0.f;
    uint4 ra0_0, ra0_1, ra0_2, ra0_3, rb0_0, rb0_1, rb0_2, rb0_3, ra1_0, ra1_1, ra1_2, ra1_3, rb1_0, rb1_1, rb1_2, rb1_3;
    uint4 ra2_0, ra2_1, ra2_2, ra2_3, rb2_0, rb2_1, rb2_2, rb2_3;
#define G_LD1(S, i, kt_) ra##S##_##i = *(const uint4*)(Ag + (size_t)(32 * i) * K + (kt_) * 64); rb##S##_##i = *(const uint4*)(Bg + (size_t)(32 * i) * K + (kt_) * 64);
#define G_LOAD(S, kt_) { G_LD1(S, 0, kt_) G_LD1(S, 1, kt_) G_LD1(S, 2, kt_) G_LD1(S, 3, kt_) }
#define L_ST1(S, i, buf_) *(uint4*)(As + (buf_) * 9216 + (lrow + 32 * i) * 72 + lkc) = ra##S##_##i; *(uint4*)(Bs + (buf_) * 9216 + (lrow + 32 * i) * 72 + lkc) = rb##S##_##i;
#define L_STORE(S, buf_) { L_ST1(S, 0, buf_) L_ST1(S, 1, buf_) L_ST1(S, 2, buf_) L_ST1(S, 3, buf_) }
#define G_COMPUTE(buf_) { \
      const u16* as = As + (buf_) * 9216 + (wm * 64 + r) * 72 + h * 8; \
      const u16* bs = Bs + (buf_) * 9216 + (wn * 64 + r) * 72 + h * 8; \
      _Pragma("unroll") for (int kk = 0; kk < 4; ++kk) { \
        bf16x8 a0 = *(const bf16x8*)(as + kk * 16), a1 = *(const bf16x8*)(as + 32 * 72 + kk * 16); \
        bf16x8 b0 = *(const bf16x8*)(bs + kk * 16), b1 = *(const bf16x8*)(bs + 32 * 72 + kk * 16); \
        acc[0][0] = MFMA32(a0, b0, acc[0][0]); acc[0][1] = MFMA32(a0, b1, acc[0][1]); \
        acc[1][0] = MFMA32(a1, b0, acc[1][0]); acc[1][1] = MFMA32(a1, b1, acc[1][1]); } }
#define LDFRAG(P_, kk) P_##a0 = *(const bf16x8*)(as_ + (kk) * 16); P_##a1 = *(const bf16x8*)(as_ + 32 * 72 + (kk) * 16); \
                       P_##b0 = *(const bf16x8*)(bs_ + (kk) * 16); P_##b1 = *(const bf16x8*)(bs_ + 32 * 72 + (kk) * 16);
#define MFMA4(P_) acc[0][0] = MFMA32(P_##a0, P_##b0, acc[0][0]); acc[0][1] = MFMA32(P_##a0, P_##b1, acc[0][1]); \
                  acc[1][0] = MFMA32(P_##a1, P_##b0, acc[1][0]); acc[1][1] = MFMA32(P_##a1, P_##b1, acc[1][1]);
#define G_PIPE(buf_, SNEXT, nbuf_, dost_) { \
      const u16* as_ = As + (buf_) * 9216 + (wm * 64 + r) * 72 + h * 8; \
      const u16* bs_ = Bs + (buf_) * 9216 + (wn * 64 + r) * 72 + h * 8; \
      bf16x8 f_a0, f_a1, f_b0, f_b1, g_a0, g_a1, g_b0, g_b1; \
      LDFRAG(f_, 0) \
      LDFRAG(g_, 1) \
      __builtin_amdgcn_sched_barrier(0); \
      MFMA4(f_) if (dost_) { L_ST1(SNEXT, 0, nbuf_) } \
      __builtin_amdgcn_sched_barrier(0); \
      LDFRAG(f_, 2) \
      MFMA4(g_) if (dost_) { L_ST1(SNEXT, 1, nbuf_) } \
      __builtin_amdgcn_sched_barrier(0); \
      LDFRAG(g_, 3) \
      MFMA4(f_) if (dost_) { L_ST1(SNEXT, 2, nbuf_) } \
      __builtin_amdgcn_sched_barrier(0); \
      MFMA4(g_) if (dost_) { L_ST1(SNEXT, 3, nbuf_) } }
#define G_COMPUTE_NOLDS() { \
      _Pragma("unroll") for (int kk = 0; kk < 4; ++kk) { \
        acc[0][0] = MFMA32(pa0, pb0, acc[0][0]); acc[0][1] = MFMA32(pa0, pb1, acc[0][1]); \
        acc[1][0] = MFMA32(pa1, pb0, acc[1][0]); acc[1][1] = MFMA32(pa1, pb1, acc[1][1]); } }
    bf16x8 pa0 = *(const bf16x8*)(As + r * 72 + h * 8), pa1 = *(const bf16x8*)(As + (32 + r) * 72 + h * 8);
    bf16x8 pb0 = *(const bf16x8*)(Bs + r * 72 + h * 8), pb1 = *(const bf16x8*)(Bs + (32 + r) * 72 + h * 8);
    (void)pa0; (void)pa1; (void)pb0; (void)pb1;
    G_LOAD(0, 0);
    G_LOAD(1, 1);
    if (nk > 2) { G_LOAD(2, 2); }
    L_STORE(0, 0);
    __syncthreads();
#define G_STEP(SCUR, SNEXT, kt_) { \
      const int kq_ = (kt_); \
      if (PROBE < 1 && kq_ + 3 < nk) { G_LOAD(SCUR, kq_ + 3); } \
      if (PROBE == 0) { const bool st_ = kq_ + 1 < nk; G_PIPE(kq_ & 1, SNEXT, (kq_ + 1) & 1, st_) } \
      else { if (PROBE < 3) { G_COMPUTE(kq_ & 1); } else { G_COMPUTE_NOLDS(); } \
      if (PROBE < 2 && kq_ + 1 < nk) { L_STORE(SNEXT, (kq_ + 1) & 1); } } \
      __syncthreads(); }
    for (int kt = 0; kt < nk; kt += 3) {
      G_STEP(0, 1, kt);
      if (kt + 1 < nk) G_STEP(1, 2, kt + 1);
      if (kt + 2 < nk) G_STEP(2, 0, kt + 2);
    }
#pragma unroll
    for (int a = 0; a < 2; ++a)
#pragma unroll
      for (int c = 0; c < 2; ++c)
#pragma unroll
        for (int i = 0; i < 16; ++i)
          Cs[(wm * 64 + a * 32 + (i & 3) + 8 * (i >> 2) + 4 * h) * CP + wn * 64 + c * 32 + r] = acc[a][c][i];
    __syncthreads();
    epilogue<EPI>(p, ea, Cs, mtile, ntile);
    __syncthreads();
  }
}

template <int DQK, bool NA>
DI void attn_phase(const u16* __restrict__ Q, const u16* __restrict__ Kb, const u16* __restrict__ Vt, int HQ, int HK,
                           float scale, u16* __restrict__ mix, int coloff, bool do_ctx, const float* __restrict__ rpb, char* smem) {
  constexpr int KP = DQK + 8;
  constexpr int NKK = DQK / 16;
  constexpr int KCH = DQK / 32;
  const int tid = otid(), lane = tid & 63, w = tid >> 6, r = lane & 31, h = lane >> 5;
  u16* Ks = (u16*)smem;
  u16* Vs = (u16*)(smem + 13312);
  float* rpbs = (float*)(smem + 22528);
  const int grp_heads = HQ / HK;
  const int nqb = 16 + (do_ctx ? 2 : 0);
  const int upg = grp_heads * nqb;
  const int total = 16 * HK * upg;
  const float sl2 = scale * LOG2E;
  for (int u = blockIdx.x; u < total; u += gridDim.x) {
    const int xcd = u & 7, L = u >> 3;
    const int grp = (L / upg) * 8 + xcd, wi = L % upg;
    const int b = grp / HK, hk = grp % HK;
    const int hq = hk * grp_heads + wi / nqb, qb = wi % nqb;
    const bool lat = qb < 16;
    const int qpos0 = lat ? 256 + 128 * qb : 128 * (qb - 16);
    int ntiles = lat ? 36 : 4;
    int rs0 = 0, rw = 0, rsw = 0;
    if (NA && lat) {
      int r0 = 2 * qb;
      rs0 = min(max(r0 - 4, 0), 24);
      int rs1 = min(max(r0 + 1 - 4, 0), 24);
      ntiles = 4 + (rs1 + 8 - rs0);
      rw = r0 + (w >> 1);
      rsw = min(max(rw - 4, 0), 24);
    }
    const int qpos = qpos0 + w * 32 + r;
    bf16x8 qf[NKK];
    {
      const u16* qp = Q + (((size_t)b * HQ + hq) * SP + qpos) * DQK + 8 * h;
#pragma unroll
      for (int kk = 0; kk < NKK; ++kk) qf[kk] = *(const bf16x8*)(qp + 16 * kk);
    }
    f32x16 o0, o1;
#pragma unroll
    for (int i = 0; i < 16; ++i) { o0[i] = 0.f; o1[i] = 0.f; }
    float m = -1e30f, l = 0.f;
    const u16* kbase = Kb + ((size_t)b * HK + hk) * SP * DQK;
    const u16* vbase = Vt + ((size_t)b * HK + hk) * 64 * SP;
    uint4 rk0, rk1, rk2 = make_uint4(0, 0, 0, 0), rv0, rv1;
#define KPOS_OF(i) ((NA && lat && (i) >= 4) ? 256 + 64 * (rs0 + (i) - 4) : 64 * (i))
#define ATT_GLOAD(kp) do { \
      rk0 = *(const uint4*)(kbase + (size_t)(kp) * DQK + tid * 8); \
      rk1 = *(const uint4*)(kbase + (size_t)(kp) * DQK + (tid + 256) * 8); \
      if (KCH > 2) rk2 = *(const uint4*)(kbase + (size_t)(kp) * DQK + (tid + 512) * 8); \
      rv0 = *(const uint4*)(vbase + (size_t)(tid >> 3) * SP + (kp) + (tid & 7) * 8); \
      rv1 = *(const uint4*)(vbase + (size_t)((tid >> 3) + 32) * SP + (kp) + (tid & 7) * 8); } while (0)
    { const int kp0 = KPOS_OF(0); ATT_GLOAD(kp0); }
    for (int ti = 0; ti < ntiles; ++ti) {
      __syncthreads();
      { int c = tid; *(uint4*)(Ks + (c / (DQK / 8)) * KP + (c % (DQK / 8)) * 8) = rk0; }
      { int c = tid + 256; *(uint4*)(Ks + (c / (DQK / 8)) * KP + (c % (DQK / 8)) * 8) = rk1; }
      if (KCH > 2) { int c = tid + 512; *(uint4*)(Ks + (c / (DQK / 8)) * KP + (c % (DQK / 8)) * 8) = rk2; }
      *(uint4*)(Vs + (tid >> 3) * 72 + (tid & 7) * 8) = rv0;
      *(uint4*)(Vs + ((tid >> 3) + 32) * 72 + (tid & 7) * 8) = rv1;
      if (NA && ti == 0) { for (int q = tid; q < 465; q += NTHR) rpbs[q] = rpb[hq * 465 + q]; }
      __syncthreads();
      if (ti + 1 < ntiles) { const int kp1 = KPOS_OF(ti + 1); ATT_GLOAD(kp1); }
      bool active = true;
      int jrow = 0;
      if (NA && lat && ti >= 4) { jrow = rs0 + ti - 4; active = (jrow >= rsw) && (jrow < rsw + 8); }
      if (active) {
        f32x16 s0, s1;
#pragma unroll
        for (int i = 0; i < 16; ++i) { s0[i] = 0.f; s1[i] = 0.f; }
#pragma unroll
        for (int kk = 0; kk < NKK; ++kk) {
          bf16x8 k0 = *(const bf16x8*)(Ks + r * KP + 16 * kk + 8 * h);
          bf16x8 k1 = *(const bf16x8*)(Ks + (32 + r) * KP + 16 * kk + 8 * h);
          s0 = MFMA32(k0, qf[kk], s0);
          s1 = MFMA32(k1, qf[kk], s1);
        }
        if (NA && lat && ti >= 4) {
          const int qc = (w & 1) * 32 + r;
          const int cs = min(max(qc - 8, 0), 48);
          const float* brow = rpbs + (jrow - rw + 7) * 31 + (15 - qc);
#pragma unroll
          for (int i = 0; i < 16; ++i) {
            int kc0 = (i & 3) + 8 * (i >> 2) + 4 * h, kc1 = kc0 + 32;
            bool v0 = (kc0 >= cs) && (kc0 < cs + 16), v1 = (kc1 >= cs) && (kc1 < cs + 16);
            float b0 = v0 ? brow[kc0] : 0.f, b1 = v1 ? brow[kc1] : 0.f;
            s0[i] = v0 ? (s0[i] * sl2 + b0 * LOG2E) : -1e30f;
            s1[i] = v1 ? (s1[i] * sl2 + b1 * LOG2E) : -1e30f;
          }
        } else {
#pragma unroll
          for (int i = 0; i < 16; ++i) { s0[i] *= sl2; s1[i] *= sl2; }
        }
        float tm = s0[0];
#pragma unroll
        for (int i = 1; i < 16; ++i) tm = fmaxf(tm, s0[i]);
#pragma unroll
        for (int i = 0; i < 16; ++i) tm = fmaxf(tm, s1[i]);
        tm = fmaxf(tm, __shfl_xor(tm, 32));
        const float mn = fmaxf(m, tm);
        const float alpha = __builtin_amdgcn_exp2f(m - mn);
        m = mn;
        float ps = 0.f;
#pragma unroll
        for (int i = 0; i < 16; ++i) { s0[i] = __builtin_amdgcn_exp2f(s0[i] - mn); ps += s0[i]; s1[i] = __builtin_amdgcn_exp2f(s1[i] - mn); ps += s1[i]; }
        l = l * alpha + ps;
#pragma unroll
        for (int i = 0; i < 16; ++i) { o0[i] *= alpha; o1[i] *= alpha; }
#pragma unroll
        for (int kt = 0; kt < 2; ++kt) {
#pragma unroll
          for (int sp = 0; sp < 2; ++sp) {
            u32x4 pu;
            pu[0] = pack2(kt ? s1[8 * sp + 0] : s0[8 * sp + 0], kt ? s1[8 * sp + 1] : s0[8 * sp + 1]);
            pu[1] = pack2(kt ? s1[8 * sp + 2] : s0[8 * sp + 2], kt ? s1[8 * sp + 3] : s0[8 * sp + 3]);
            pu[2] = pack2(kt ? s1[8 * sp + 4] : s0[8 * sp + 4], kt ? s1[8 * sp + 5] : s0[8 * sp + 5]);
            pu[3] = pack2(kt ? s1[8 * sp + 6] : s0[8 * sp + 6], kt ? s1[8 * sp + 7] : s0[8 * sp + 7]);
            const bf16x8 pfv = __builtin_bit_cast(bf16x8, pu);
            const int ko = 32 * kt + 16 * sp + 4 * h;
            const uint2 a0 = *(const uint2*)(Vs + r * 72 + ko), a1 = *(const uint2*)(Vs + r * 72 + ko + 8);
            const uint2 c0 = *(const uint2*)(Vs + (32 + r) * 72 + ko), c1 = *(const uint2*)(Vs + (32 + r) * 72 + ko + 8);
            u32x4 vau, vbu;
            vau[0] = a0.x; vau[1] = a0.y; vau[2] = a1.x; vau[3] = a1.y;
            vbu[0] = c0.x; vbu[1] = c0.y; vbu[2] = c1.x; vbu[3] = c1.y;
            const bf16x8 vav = __builtin_bit_cast(bf16x8, vau), vbv = __builtin_bit_cast(bf16x8, vbu);
            o0 = MFMA32(vav, pfv, o0);
            o1 = MFMA32(vbv, pfv, o1);
          }
        }
      }
    }
    l += __shfl_xor(l, 32);
    const float inv = 1.f / l;
    const int R = tok_row(b, qpos);
    u16* op = mix + (size_t)R * 1024 + coloff + hq * 64 + 4 * h;
#pragma unroll
    for (int g4 = 0; g4 < 4; ++g4) {
      uint2 a, c;
      a.x = pack2(o0[4 * g4] * inv, o0[4 * g4 + 1] * inv); a.y = pack2(o0[4 * g4 + 2] * inv, o0[4 * g4 + 3] * inv);
      c.x = pack2(o1[4 * g4] * inv, o1[4 * g4 + 1] * inv); c.y = pack2(o1[4 * g4 + 2] * inv, o1[4 * g4 + 3] * inv);
      *(uint2*)(op + 8 * g4) = a;
      *(uint2*)(op + 32 + 8 * g4) = c;
    }
  }
  __syncthreads();
}

DI void s5_pass1(const P& p, int j, char* smem) {
  const int tid = otid(), lane = tid & 63, w = tid >> 6;
  const float* U = (const float*)(p.ws + E_U);
  float2* E = (float2*)(p.ws + E_E);
  const float2* SA = (const float2*)(p.ws + OFF_SA);
  const float* SBB = (const float*)(p.ws + OFF_SBB);
  float* us = (float*)smem + w * 1024;
  for (int item = blockIdx.x; item < 4608; item += gridDim.x) {
    const int unit = item * 4 + w;
    const int c = unit % 36; const int t1 = unit / 36; const int dir = t1 & 1; const int t2 = t1 >> 1; const int g = t2 & 15; const int b = t2 >> 4;
#pragma unroll
    for (int i = 0; i < 4; ++i) {
      int idx = lane + 64 * i; int step = idx >> 2, quad = idx & 3;
      int tau = 64 * c + step;
      int pos = dir ? (tau < 256 ? 255 - tau : 2559 - tau) : tau;
      int row = tok_row(b, pos);
      *(float4*)(us + step * 16 + quad * 4) = *(const float4*)(U + (size_t)row * 256 + 16 * g + 4 * quad);
    }
    const int tidx = ((j * 2 + dir) * 16 + g) * 64 + lane;
    const float2 a = SA[tidx];
    float bbr[16], bbi[16];
#pragma unroll
    for (int q = 0; q < 4; ++q) {
      float4 t = *(const float4*)(SBB + (size_t)tidx * 32 + 4 * q); bbr[4 * q] = t.x; bbr[4 * q + 1] = t.y; bbr[4 * q + 2] = t.z; bbr[4 * q + 3] = t.w;
      float4 t2_ = *(const float4*)(SBB + (size_t)tidx * 32 + 16 + 4 * q); bbi[4 * q] = t2_.x; bbi[4 * q + 1] = t2_.y; bbi[4 * q + 2] = t2_.z; bbi[4 * q + 3] = t2_.w;
    }
    __builtin_amdgcn_wave_barrier();
    float hr = 0.f, hi = 0.f;
#pragma unroll 4
    for (int step = 0; step < 64; ++step) {
      float bur = 0.f, bui = 0.f;
#pragma unroll
      for (int q = 0; q < 4; ++q) {
        float4 uv = *(const float4*)(us + step * 16 + 4 * q);
        bur += bbr[4 * q] * uv.x + bbr[4 * q + 1] * uv.y + bbr[4 * q + 2] * uv.z + bbr[4 * q + 3] * uv.w;
        bui += bbi[4 * q] * uv.x + bbi[4 * q + 1] * uv.y + bbi[4 * q + 2] * uv.z + bbi[4 * q + 3] * uv.w;
      }
      float nr = a.x * hr - a.y * hi + bur;
      float ni = a.x * hi + a.y * hr + bui;
      hr = nr; hi = ni;
    }
    E[((((size_t)b * 16 + g) * 2 + dir) * 36 + c) * 64 + lane] = make_float2(hr, hi);
    __syncthreads();
  }
}

DI void s5_pass2(const P& p, int j, char* smem) {
  const int tid = otid(), lane = tid & 63, w = tid >> 6;
  const float* U = (const float*)(p.ws + E_U);
  const float2* E = (const float2*)(p.ws + E_E);
  const float2* SA = (const float2*)(p.ws + OFF_SA);
  const float2* SAL = (const float2*)(p.ws + OFF_SAL);
  const float* SBB = (const float*)(p.ws + OFF_SBB);
  u16* YG = (u16*)(p.ws + E_YG);
  char* wb = smem + w * 12544;
  float* us = (float*)wb; u16* Hs = (u16*)(wb + 4096); float* ys = (float*)(wb + 4096 + 4352);
  const int pcol = lane & 15, fq = lane >> 4;
  for (int item = blockIdx.x; item < 4608; item += gridDim.x) {
    const int Pc = item % 36; const int t1 = item / 36; const int gp = t1 & 7; const int b = t1 >> 3;
    const int g = gp * 2 + (w >> 1), dir = w & 1;
#pragma unroll
    for (int i = 0; i < 4; ++i) {
      int idx = lane + 64 * i; int k = idx >> 2, quad = idx & 3;
      int lt = dir ? 63 - k : k;
      int row = tok_row(b, 64 * Pc + lt);
      *(float4*)(us + k * 16 + quad * 4) = *(const float4*)(U + (size_t)row * 256 + 16 * g + 4 * quad);
    }
    const int tidx = ((j * 2 + dir) * 16 + g) * 64 + lane;
    const float2 a = SA[tidx], aL = SAL[tidx];
    float bbr[16], bbi[16];
#pragma unroll
    for (int q = 0; q < 4; ++q) {
      float4 t = *(const float4*)(SBB + (size_t)tidx * 32 + 4 * q); bbr[4 * q] = t.x; bbr[4 * q + 1] = t.y; bbr[4 * q + 2] = t.z; bbr[4 * q + 3] = t.w;
      float4 t2_ = *(const float4*)(SBB + (size_t)tidx * 32 + 16 + 4 * q); bbi[4 * q] = t2_.x; bbi[4 * q + 1] = t2_.y; bbi[4 * q + 2] = t2_.z; bbi[4 * q + 3] = t2_.w;
    }
    const int c = dir ? (Pc < 4 ? 3 - Pc : 39 - Pc) : Pc;
    float hr = 0.f, hi = 0.f;
    {
      const float2* Eb = E + ((((size_t)b * 16 + g) * 2 + dir) * 36) * 64 + lane;
      for (int cc = 0; cc < c; ++cc) {
        float2 e = Eb[(size_t)cc * 64];
        float nr = aL.x * hr - aL.y * hi + e.x;
        float ni = aL.x * hi + aL.y * hr + e.y;
        hr = nr; hi = ni;
      }
    }
    bf16x8 cf[4];
    {
      const size_t cbase = ((size_t)((j * 2 + dir) * 16 + g) * 16 + pcol) * 64;
#pragma unroll
      for (int ks = 0; ks < 4; ++ks) {
        const float* src = (ks < 2 ? p.c_re : p.c_im) + cbase + 32 * (ks & 1) + 8 * fq;
        float4 t0 = *(const float4*)src, t1_ = *(const float4*)(src + 4);
        const float sg = ks < 2 ? 1.f : -1.f;
        u32x4 cu;
        cu[0] = pack2(sg * t0.x, sg * t0.y); cu[1] = pack2(sg * t0.z, sg * t0.w);
        cu[2] = pack2(sg * t1_.x, sg * t1_.y); cu[3] = pack2(sg * t1_.z, sg * t1_.w);
        cf[ks] = __builtin_bit_cast(bf16x8, cu);
      }
    }
    __builtin_amdgcn_wave_barrier();
#pragma unroll 1
    for (int sub = 0; sub < 4; ++sub) {
#pragma unroll 4
      for (int k16 = 0; k16 < 16; ++k16) {
        const int k = sub * 16 + k16;
        float bur = 0.f, bui = 0.f;
#pragma unroll
        for (int q = 0; q < 4; ++q) {
          float4 uv = *(const float4*)(us + k * 16 + 4 * q);
          bur += bbr[4 * q] * uv.x + bbr[4 * q + 1] * uv.y + bbr[4 * q + 2] * uv.z + bbr[4 * q + 3] * uv.w;
          bui += bbi[4 * q] * uv.x + bbi[4 * q + 1] * uv.y + bbi[4 * q + 2] * uv.z + bbi[4 * q + 3] * uv.w;
        }
        float nr = a.x * hr - a.y * hi + bur;
        float ni = a.x * hi + a.y * hr + bui;
        hr = nr; hi = ni;
        Hs[k16 * 136 + lane] = f2bf(hr);
        Hs[k16 * 136 + 64 + lane] = f2bf(hi);
      }
      __builtin_amdgcn_wave_barrier();
      f32x4 acc = {0.f, 0.f, 0.f, 0.f};
#pragma unroll
      for (int ks = 0; ks < 4; ++ks) {
        bf16x8 af = *(const bf16x8*)(Hs + pcol * 136 + 32 * ks + 8 * fq);
        acc = MFMA16(af, cf[ks], acc);
      }
#pragma unroll
      for (int jj = 0; jj < 4; ++jj) {
        int k = sub * 16 + 4 * fq + jj;
        int lt = dir ? 63 - k : k;
        ys[lt * 16 + pcol] = acc[jj];
      }
      __builtin_amdgcn_wave_barrier();
    }
    __syncthreads();
#pragma unroll
    for (int i = 0; i < 8; ++i) {
      int idx = tid + 256 * i; int gi = idx >> 10, lt = (idx >> 4) & 63, pp = idx & 15;
      const char* w0 = smem + (2 * gi) * 12544; const char* w1 = smem + (2 * gi + 1) * 12544;
      const int gg = gp * 2 + gi;
      float y = ((const float*)(w0 + 8448))[lt * 16 + pp] + ((const float*)(w1 + 8448))[lt * 16 + pp]
              + p.ssm_d[j * 256 + 16 * gg + pp] * ((const float*)w0)[lt * 16 + pp];
      float t = 0.7978845608028654f * (y + 0.044715f * y * y * y);
      float ge = 0.5f * y * (1.f + tanhf(t));
      int row = tok_row(b, 64 * Pc + lt);
      YG[(size_t)row * 256 + 16 * gg + pp] = f2bf(ge);
    }
    __syncthreads();
  }
}

__global__ void __launch_bounds__(NTHR, 2) fwd_megakernel(P p) {
  __shared__ __attribute__((aligned(16))) char smem[SMEM_BYTES];
  cg::grid_group grid = cg::this_grid();
  char* ws = p.ws;
  float* XC = (float*)(ws + OFF_XC);
  u16* ABUF = (u16*)(ws + OFF_ABUF);
  const float* modv = (const float*)(ws + OFF_MODV);

  __shared__ uint4 xb_words;
  unsigned* barw = (unsigned*)(ws + OFF_BAR);
  if (threadIdx.x == 0) xb_words = make_uint4(0u, 0u, 0u, 0u);
  if (blockIdx.x == 0) { for (int i = threadIdx.x; i < XCD_BAR_WORDS; i += NTHR) barw[i] = 0u; }
  for (int dd = 0; dd < DUPN(3); ++dd) prologue(p, smem);
  grid.sync();
  XcdBarrier xb = xcd_barrier_post(barw, (volatile LAS unsigned*)&xb_words);

  for (int layer = 0; layer < 4; ++layer) {
    const int j = layer >> 1;
    const bool need_ctx = layer < 3;
    const float* xs_lat = layer == 0 ? p.x : p.out;
    const float* xs_ctx = layer == 0 ? p.ctx : XC;
    const float* modl = modv + (size_t)layer * 17 * 6144;
    EpiArgs ea;
    ea.j = j; ea.gate = modl + 2 * 1024; ea.src_lat = xs_lat; ea.src_ctx = xs_ctx; ea.dst_lat = p.out; ea.dst_ctx = XC;

    for (int dd = 0; dd < DUPN(3); ++dd) norm_phase(xs_lat, xs_ctx, p.g_norm1 + layer * 1024, modl, 0, 1, NTOK, ABUF);
    for (int dd = 0; dd < DUPN(3); ++dd) ff_convert(p, layer, smem);
    GSYNC();

    if ((layer & 1) == 0) {
      for (int dd = 0; dd < DUPN(0); ++dd) gemm_phase<EPI_EVEN_IN>(p, ABUF, (const u16*)(ws + OFF_EIN + j * SZ_EIN), 1024, 288, 12, 6, ea, smem);
      GSYNC();
      for (int dd = 0; dd < DUPN(2); ++dd) s5_pass1(p, j, smem);
      for (int dd = 0; dd < DUPN(1); ++dd) attn_phase<64, false>((const u16*)(ws + E_Q), (const u16*)(ws + E_K), (const u16*)(ws + E_VT), 12, 4, 0.125f, ABUF, 0, need_ctx, nullptr, smem);
      GSYNC();
      for (int dd = 0; dd < DUPN(2); ++dd) s5_pass2(p, j, smem);
      GSYNC();
      for (int dd = 0; dd < DUPN(0); ++dd) gemm_phase<EPI_GLU>(p, (const u16*)(ws + E_YG), (const u16*)(ws + OFF_GLU + j * SZ_GLU), 256, 288, 2, 6, ea, smem);
      GSYNC();
    } else {
      for (int dd = 0; dd < DUPN(0); ++dd) gemm_phase<EPI_ODD_IN>(p, ABUF, (const u16*)(ws + OFF_OIN + j * SZ_OIN), 1024, 288, 19, 6, ea, smem);
      GSYNC();
      for (int dd = 0; dd < DUPN(0); ++dd) gemm_phase<EPI_UQ>(p, (const u16*)(ws + O_CQ), (const u16*)(ws + OFF_UQ + j * SZ_UQ), 512, 288, 8, 6, ea, smem);
      for (int dd = 0; dd < DUPN(0); ++dd) gemm_phase<EPI_UKV>(p, (const u16*)(ws + O_CKV), (const u16*)(ws + OFF_UKV + j * SZ_UKV), 256, 288, 8, 6, ea, smem);
      for (int dd = 0; dd < DUPN(1); ++dd) attn_phase<64, true>((const u16*)(ws + O_NQ), (const u16*)(ws + O_NK), (const u16*)(ws + O_NVT), 8, 8, 0.125f, ABUF, 512, need_ctx,
                           p.rpb + (size_t)j * 8 * 465, smem);
      GSYNC();
      for (int dd = 0; dd < DUPN(1); ++dd) attn_phase<96, false>((const u16*)(ws + O_MQ), (const u16*)(ws + O_MK), (const u16*)(ws + O_MVT), 8, 8, 0.10206207261596577f, ABUF, 0,
                            need_ctx, nullptr, smem);
      GSYNC();
    }
    const int mt = need_ctx ? 288 : 256;
    const int band = need_ctx ? 6 : 8;
    gemm_phase<EPI_RESID>(p, ABUF, (const u16*)(ws + ((layer & 1) ? OFF_OOUT : OFF_EOUT) + j * SZ_SQ), 1024, mt, 8, band, ea, smem);
    GSYNC();
    for (int dd = 0; dd < DUPN(3); ++dd) norm_phase(p.out, XC, p.g_norm2 + layer * 1024, modl, 3, 4, need_ctx ? NTOK : NLAT, ABUF);
    GSYNC();
    for (int dd = 0; dd < DUPN(0); ++dd) gemm_phase<EPI_RELU2>(p, ABUF, (const u16*)(ws + OFF_FF1), 1024, mt, 32, band, ea, smem);
    GSYNC();
    ea.gate = modl + 5 * 1024; ea.src_lat = p.out; ea.src_ctx = XC;
    gemm_phase<EPI_RESID>(p, (const u16*)(ws + OFF_H), (const u16*)(ws + OFF_FF2), 4096, mt, 8, band, ea, smem);
    GSYNC();
  }
  if (GPROBE >= 0) {
    EpiArgs ed{}; ed.j = 0;
    gemm_phase<EPI_RELU2, (GPROBE < 0 ? 0 : GPROBE)>(p, (const u16*)(ws + OFF_ABUF), (const u16*)(ws + OFF_FF1), 1024, 288, 32, 6, ed, smem);
  }
}

extern "C" void kernel_launch(void* const* d_in, const int* in_sizes, int n_in, void* d_out, int out_size, void* d_ws, size_t ws_size,
                              hipStream_t stream) {
  static int grid_blocks = 0;
  if (!grid_blocks) {
    int dev = 0, cus = 0, per_cu = 0;
    hipGetDevice(&dev);
    hipDeviceGetAttribute(&cus, hipDeviceAttributeMultiprocessorCount, dev);
    hipOccupancyMaxActiveBlocksPerMultiprocessor(&per_cu, fwd_megakernel, NTHR, 0);
    if (per_cu > 2) per_cu = 2;
    if (per_cu < 1) per_cu = 1;
    grid_blocks = cus * per_cu;
    grid_blocks &= ~7;
  }
  P p{};
  const float** f = (const float**)&p;
  for (int i = 0; i < 35; ++i) f[i] = (const float*)d_in[i];
  p.out = (float*)d_out;
  p.ws = (char*)d_ws;
  void* args[] = {&p};
  hipError_t e = hipLaunchCooperativeKernel((void*)fwd_megakernel, dim3(grid_blocks), dim3(NTHR), args, 0, stream);
  if (e != hipSuccess) fprintf(stderr, "cooperative launch failed: %s (grid %d)\n", hipGetErrorString(e), grid_blocks);
}
```

```cpp
#include <hip/hip_runtime.h>
#include <hip/hip_cooperative_groups.h>
#include <cstdio>
namespace cg = cooperative_groups;

typedef unsigned short u16;
using bf16x8 = __attribute__((ext_vector_type(8))) short;
using f32x16 = __attribute__((ext_vector_type(16))) float;
using f32x4 = __attribute__((ext_vector_type(4))) float;
typedef __attribute__((ext_vector_type(2))) __bf16 bf2_t;
using u32x4 = __attribute__((ext_vector_type(4))) unsigned;
#define DI __device__ __forceinline__
#define MFMA32(a, b, c) __builtin_amdgcn_mfma_f32_32x32x16_bf16((a), (b), (c), 0, 0, 0)
#define MFMA16(a, b, c) __builtin_amdgcn_mfma_f32_16x16x32_bf16((a), (b), (c), 0, 0, 0)

#ifndef GPROBE
#define GPROBE -1
#endif
#ifndef DUP_MASK
#define DUP_MASK 0
#endif
#define DUPN(bit) (((DUP_MASK) >> (bit)) & 1 ? 2 : 1)
constexpr int NTHR = 256;
constexpr int NLAT = 32768, NTOK = 36864, SP = 2304;
constexpr float EPSF = 1e-6f;
constexpr float LOG2E = 1.4426950408889634f;
constexpr int SMEM_BYTES = 73728 + 512;
constexpr int CP = 132;

constexpr size_t SZ_EIN = 1536ull * 1024 * 2, SZ_SQ = 1024ull * 1024 * 2, SZ_OIN = 2432ull * 1024 * 2;
constexpr size_t SZ_UQ = 1024ull * 512 * 2, SZ_UKV = 1024ull * 256 * 2, SZ_GLU = 256ull * 256 * 2;
constexpr size_t OFF_EIN = 0;
constexpr size_t OFF_EOUT = OFF_EIN + 2 * SZ_EIN;
constexpr size_t OFF_OIN = OFF_EOUT + 2 * SZ_SQ;
constexpr size_t OFF_OOUT = OFF_OIN + 2 * SZ_OIN;
constexpr size_t OFF_UQ = OFF_OOUT + 2 * SZ_SQ;
constexpr size_t OFF_UKV = OFF_UQ + 2 * SZ_UQ;
constexpr size_t OFF_GLU = OFF_UKV + 2 * SZ_UKV;
constexpr size_t OFF_FF1 = OFF_GLU + 2 * SZ_GLU;
constexpr size_t OFF_FF2 = OFF_FF1 + 4096ull * 1024 * 2;
constexpr size_t OFF_MODV = OFF_FF2 + 4096ull * 1024 * 2;
constexpr size_t OFF_ROPE = OFF_MODV + 4ull * 17 * 6144 * 4;
constexpr size_t OFF_SA = OFF_ROPE + 16384;
constexpr size_t OFF_SAL = OFF_SA + 4096 * 8;
constexpr size_t OFF_SBB = OFF_SAL + 4096 * 8;
constexpr size_t OFF_BAR = OFF_SBB + 4096ull * 32 * 4;
constexpr size_t OFF_PSN = OFF_BAR + 16384;
constexpr size_t OFF_SW1 = OFF_PSN + 36864ull * 8 * 4;
constexpr size_t OFF_SW2 = OFF_SW1 + 4ull * 17 * 2560 * 4;
constexpr size_t OFF_XC = OFF_SW2 + 4ull * 17 * 4096 * 4;
constexpr size_t OFF_ABUF = OFF_XC + 4096ull * 1024 * 4;
constexpr size_t OFF_R1 = OFF_ABUF + (size_t)NTOK * 1024 * 2;
constexpr size_t E_Q = OFF_R1;
constexpr size_t E_K = E_Q + 16ull * 12 * SP * 64 * 2;
constexpr size_t E_VT = E_K + 16ull * 4 * SP * 64 * 2;
constexpr size_t E_U = E_VT + 16ull * 4 * SP * 64 * 2;
constexpr size_t E_E = E_U + (size_t)NTOK * 256 * 4;
constexpr size_t E_YG = E_E + 16ull * 16 * 2 * 36 * 64 * 8;
constexpr size_t O_CQ = OFF_R1;
constexpr size_t O_CKV = O_CQ + (size_t)NTOK * 512 * 2;
constexpr size_t O_KR = O_CKV + (size_t)NTOK * 256 * 2;
constexpr size_t O_PS = O_KR + (size_t)NTOK * 32 * 4;
constexpr size_t O_NQ = O_PS + (size_t)NTOK * 8 * 4;
constexpr size_t O_NK = O_NQ + 16ull * 8 * SP * 64 * 2;
constexpr size_t O_NVT = O_NK + 16ull * 8 * SP * 64 * 2;
constexpr size_t O_MQ = O_NVT + 16ull * 8 * SP * 64 * 2;
constexpr size_t O_MK = O_MQ + 16ull * 8 * SP * 96 * 2;
constexpr size_t O_MVT = O_MK + 16ull * 8 * SP * 96 * 2;
constexpr size_t O_END = O_MVT + 16ull * 8 * SP * 64 * 2;
constexpr size_t OFF_H = OFF_R1;
constexpr size_t OFF_XG2 = OFF_H + (size_t)NTOK * 4096 * 2;
constexpr size_t WS_END = OFF_XG2 + (size_t)NTOK * 1024 * 2;
static_assert(WS_END <= 536870912ull, "workspace map exceeds 512 MiB");

struct P {
  const float *x, *c, *ctx, *c_ctx, *w_mod, *b_mod, *g_norm1, *g_norm2, *w_ff1, *w_ff2;
  const float *e_w_in, *e_w_out, *e_g_q, *e_g_k, *lam_re, *lam_im, *log_dt, *b_re, *b_im, *c_re, *c_im, *ssm_d, *w_glu, *b_glu;
  const float *o_w_in, *o_w_out, *g_cq, *g_ckv, *w_uq, *w_ukv, *g_mq, *g_mk, *g_nq, *g_nk, *rpb;
  float* out;
  char* ws;
};

DI unsigned pack2(float a, float b) { bf2_t v; v[0] = (__bf16)a; v[1] = (__bf16)b; return __builtin_bit_cast(unsigned, v); }
DI u16 f2bf(float a) { __bf16 v = (__bf16)a; return __builtin_bit_cast(u16, v); }
DI float bf2f(u16 v) { return __uint_as_float(((unsigned)v) << 16); }
#define GSYNC() do { for (int dd_ = 0; dd_ < DUPN(4); ++dd_) xcd_barrier(xb); } while (0)
DI int otid() { int t = threadIdx.x; asm volatile("" : "+v"(t)); return t; }
DI int tok_row(int b, int pos) { return pos < 256 ? NLAT + b * 256 + pos : b * 2048 + pos - 256; }


#define XB_TMO      128
#define XB_XCNT(j)  (256  + 64 * (j))
#define XB_XSUB(j)  (1280 + 64 * (j))
#define XB_XGEN(j)  (2304 + 64 * (j))
#define XB_TOP      3328
#define XB_TOPGEN   3392
#define XCD_BAR_WORDS 3456
#define XB_SPIN_CAP (1u << 22)
#define LAS __attribute__((address_space(3)))
DI unsigned xb_ld(unsigned* p) { return __hip_atomic_load(p, __ATOMIC_RELAXED, __HIP_MEMORY_SCOPE_AGENT); }
DI unsigned xb_add(unsigned* p, unsigned v) { return __hip_atomic_fetch_add(p, v, __ATOMIC_RELAXED, __HIP_MEMORY_SCOPE_AGENT); }
DI unsigned xb_xcc_id() { return (unsigned)__builtin_amdgcn_s_getreg((3 << 11) | 20) & 0xFu; }
#define XB_SPIN(cond, bar) do { unsigned _sp = 0; while (cond) { __builtin_amdgcn_s_sleep(1); \
    if ((++_sp & 255u) == 0u) { if (xb_ld(&(bar)[XB_TMO])) break; if (_sp > XB_SPIN_CAP) { atomicAdd(&(bar)[XB_TMO], 1u); break; } } } } while (0)
struct XcdBarrier { unsigned* bar; unsigned x; volatile LAS unsigned* st; };
DI XcdBarrier xcd_barrier_post(unsigned* bar, volatile LAS unsigned* st) {
  XcdBarrier b; b.bar = bar; b.x = xb_xcc_id(); b.st = st;
  if (threadIdx.x == 0) (void)xb_add(&bar[XB_XCNT(b.x)], 1u);
  return b;
}
DI void xcd_barrier_complete(unsigned* bar, unsigned x, unsigned& nloc, unsigned& nx) {
  const unsigned G = gridDim.x * gridDim.y * gridDim.z;
  unsigned sum, cnt, mine, sp = 0u;
  for (;;) {
    sum = 0u; cnt = 0u; mine = 0u;
#pragma unroll
    for (unsigned j = 0; j < 16; ++j) { const unsigned c = xb_ld(&bar[XB_XCNT(j)]); sum += c; cnt += (c > 0u) ? 1u : 0u; mine = (j == x) ? c : mine; }
    if (sum == G) break;
    __builtin_amdgcn_s_sleep(1);
    if ((++sp & 255u) == 0u) { if (xb_ld(&bar[XB_TMO])) break; if (sp > XB_SPIN_CAP) { atomicAdd(&bar[XB_TMO], 1u); break; } }
  }
  nloc = mine > 0u ? mine : 1u; nx = cnt > 0u ? cnt : 1u;
}
DI void xcd_barrier(const XcdBarrier& b) {
  asm volatile("s_waitcnt vmcnt(0)" ::: "memory");
  __syncthreads();
  if (threadIdx.x == 0) {
    unsigned* bar = b.bar;
    __builtin_amdgcn_s_waitcnt(0);
    unsigned nloc = b.st[0], nx = b.st[1];
    if (nloc == 0u) { xcd_barrier_complete(bar, b.x, nloc, nx); b.st[0] = nloc; b.st[1] = nx; }
    const unsigned old = xb_add(&bar[XB_XSUB(b.x)], 1u);
    const unsigned gen = old / nloc;
    if (old + 1u == (gen + 1u) * nloc) {
      __builtin_amdgcn_fence(__ATOMIC_RELEASE, "agent");
      asm volatile("s_waitcnt vmcnt(0)" ::: "memory");
      const unsigned og = xb_add(&bar[XB_TOP], 1u);
      const unsigned tg = og / nx;
      if (og + 1u == (tg + 1u) * nx) xb_add(&bar[XB_TOPGEN], 1u);
      else XB_SPIN(xb_ld(&bar[XB_TOPGEN]) == tg, bar);
      __builtin_amdgcn_fence(__ATOMIC_ACQUIRE, "agent");
      xb_add(&bar[XB_XGEN(b.x)], 1u);
      asm volatile("s_waitcnt vmcnt(0)" ::: "memory");
    } else {
      XB_SPIN(xb_ld(&bar[XB_XGEN(b.x)]) == gen, bar);
      __builtin_amdgcn_fence(__ATOMIC_ACQUIRE, "agent");
      asm volatile("s_waitcnt vmcnt(0)" ::: "memory");
    }
  }
  __syncthreads();
}

DI int map_col(int mapk, int n, int N) {
  if (mapk == 0) return n < N ? n : -1;
  if (mapk == 1) { if (n < 768) return n; if (n < 2304) return n + 32; if (n < 2336) return n - 2304 + 768; return -1; }
  int h = n >> 7, jj = n & 127; return jj < 96 ? h * 96 + jj : -1;
}
DI void tr_tile(const float* __restrict__ src, int K, int N, int Npad, int mapk, const float* __restrict__ ks,
                        u16* __restrict__ dst, int tile, char* smem) {
  float* tl = (float*)smem;
  const int tid = otid();
  const int tnn = Npad >> 6;
  const int n0 = (tile % tnn) * 64, k0 = (tile / tnn) * 64;
  const int nn = tid & 63;
  const int sn = map_col(mapk, n0 + nn, N);
#pragma unroll 4
  for (int i = 0; i < 16; ++i) {
    int kk = (tid >> 6) + 4 * i;
    float v = 0.f;
    if (sn >= 0) { v = src[(size_t)(k0 + kk) * N + sn]; if (ks) v *= ks[k0 + kk]; }
    tl[kk * 65 + nn] = v;
  }
  __syncthreads();
#pragma unroll 4
  for (int i = 0; i < 16; ++i) {
    int n2 = (tid >> 6) + 4 * i, kk = tid & 63;
    dst[(size_t)(n0 + n2) * K + k0 + kk] = f2bf(tl[kk * 65 + n2]);
  }
  __syncthreads();
}

DI void ff_convert(const P& p, int layer, char* smem) {
  u16* f1 = (u16*)(p.ws + OFF_FF1);
  u16* f2 = (u16*)(p.ws + OFF_FF2);
  const float* s1 = p.w_ff1 + (size_t)layer * 1024 * 4096;
  const float* s2 = p.w_ff2 + (size_t)layer * 4096 * 1024;
  for (int t = gridDim.x - 1 - blockIdx.x; t < 2048; t += gridDim.x) {
    if (t < 1024) tr_tile(s1, 1024, 4096, 4096, 0, nullptr, f1, t, smem);
    else tr_tile(s2, 4096, 1024, 1024, 0, nullptr, f2, t - 1024, smem);
  }
}

DI void prologue(const P& p, char* smem) {
  const int tid = otid();
  float* modv = (float*)(p.ws + OFF_MODV);
  for (int it = blockIdx.x; it < 384; it += gridDim.x) {
    float* cond = (float*)smem;
    for (int idx = tid; idx < 17 * 1024; idx += NTHR) {
      int bb = idx >> 10, k = idx & 1023;
      float v = bb < 16 ? p.c[bb * 1024 + k] : p.c_ctx[k];
      cond[idx] = v / (1.f + __expf(-v));
    }
    __syncthreads();
    const int l = it / 96, n = (it % 96) * 64 + (tid & 63), kq = tid >> 6;
    float acc[17];
#pragma unroll
    for (int i = 0; i < 17; ++i) acc[i] = 0.f;
    const float* wp = p.w_mod + ((size_t)l * 1024 + kq * 256) * 6144 + n;
    for (int k4 = 0; k4 < 64; ++k4) {
      float w0 = wp[(size_t)(k4 * 4 + 0) * 6144], w1 = wp[(size_t)(k4 * 4 + 1) * 6144];
      float w2 = wp[(size_t)(k4 * 4 + 2) * 6144], w3 = wp[(size_t)(k4 * 4 + 3) * 6144];
#pragma unroll
      for (int bb = 0; bb < 17; ++bb) {
        float4 c4 = *(const float4*)(cond + bb * 1024 + kq * 256 + k4 * 4);
        acc[bb] += c4.x * w0 + c4.y * w1 + c4.z * w2 + c4.w * w3;
      }
    }
    __syncthreads();
    float* red = (float*)smem;
#pragma unroll
    for (int bb = 0; bb < 17; ++bb) red[(kq * 17 + bb) * 64 + (tid & 63)] = acc[bb];
    __syncthreads();
    for (int o = tid; o < 17 * 64; o += NTHR) {
      int bb = o >> 6, nn = o & 63;
      int ncol = (it % 96) * 64 + nn;
      float s = red[(0 * 17 + bb) * 64 + nn] + red[(1 * 17 + bb) * 64 + nn] + red[(2 * 17 + bb) * 64 + nn] + red[(3 * 17 + bb) * 64 + nn];
      modv[((size_t)l * 17 + bb) * 6144 + ncol] = s + p.b_mod[l * 6144 + ncol];
    }
    __syncthreads();
  }
  {
    float* rt = (float*)(p.ws + OFF_ROPE);
    for (int idx = blockIdx.x * NTHR + tid; idx < 1024 + 512; idx += gridDim.x * NTHR) {
      if (idx < 1024) {
        int pos = idx >> 4, i = idx & 15;
        float f = powf(10000.f, -(float)(2 * i) / 32.f);
        float a = (float)pos * f;
        rt[idx] = cosf(a); rt[1024 + idx] = sinf(a);
      } else {
        int q = idx - 1024; int pos = q >> 3, i = q & 7;
        float f = powf(10000.f, -(float)(2 * i) / 16.f);
        float a = (float)pos * f;
        rt[2048 + q] = cosf(a); rt[2560 + q] = sinf(a);
      }
    }
    float2* SA = (float2*)(p.ws + OFF_SA);
    float2* SAL = (float2*)(p.ws + OFF_SAL);
    float* SBB = (float*)(p.ws + OFF_SBB);
    for (int idx = blockIdx.x * NTHR + tid; idx < 4096; idx += gridDim.x * NTHR) {
      float lre = p.lam_re[idx], lim = p.lam_im[idx];
      float dt = expf(p.log_dt[idx >> 6]);
      float mag = expf(lre * dt);
      float are = mag * cosf(lim * dt), aim = mag * sinf(lim * dt);
      float den = lre * lre + lim * lim;
      float fre = ((are - 1.f) * lre + aim * lim) / den;
      float fim = (aim * lre - (are - 1.f) * lim) / den;
      SA[idx] = make_float2(are, aim);
      float pr = are, pi = aim;
#pragma unroll
      for (int q = 0; q < 6; ++q) { float nr = pr * pr - pi * pi, ni = 2.f * pr * pi; pr = nr; pi = ni; }
      SAL[idx] = make_float2(pr, pi);
#pragma unroll
      for (int q = 0; q < 16; ++q) {
        float br = p.b_re[(size_t)idx * 16 + q], bi = p.b_im[(size_t)idx * 16 + q];
        SBB[(size_t)idx * 32 + q] = fre * br - fim * bi;
        SBB[(size_t)idx * 32 + 16 + q] = fre * bi + fim * br;
      }
    }
  }
  for (int t = gridDim.x - 1 - blockIdx.x; t < 3424; t += gridDim.x) {
    int j = t / 1712, r = t % 1712;
    if (r < 384) tr_tile(p.e_w_in + (size_t)j * 1024 * 1536, 1024, 1536, 1536, 0, nullptr, (u16*)(p.ws + OFF_EIN + j * SZ_EIN), r, smem);
    else if (r < 640) tr_tile(p.e_w_out + (size_t)j * 1024 * 1024, 1024, 1024, 1024, 0, nullptr, (u16*)(p.ws + OFF_EOUT + j * SZ_SQ), r - 384, smem);
    else if (r < 1248) tr_tile(p.o_w_in + (size_t)j * 1024 * 2336, 1024, 2336, 2432, 1, nullptr, (u16*)(p.ws + OFF_OIN + j * SZ_OIN), r - 640, smem);
    else if (r < 1504) tr_tile(p.o_w_out + (size_t)j * 1024 * 1024, 1024, 1024, 1024, 0, nullptr, (u16*)(p.ws + OFF_OOUT + j * SZ_SQ), r - 1248, smem);
    else if (r < 1632) tr_tile(p.w_uq + (size_t)j * 512 * 768, 512, 768, 1024, 2, p.g_cq + j * 512, (u16*)(p.ws + OFF_UQ + j * SZ_UQ), r - 1504, smem);
    else if (r < 1696) tr_tile(p.w_ukv + (size_t)j * 256 * 1024, 256, 1024, 1024, 0, p.g_ckv + j * 256, (u16*)(p.ws + OFF_UKV + j * SZ_UKV), r - 1632, smem);
    else tr_tile(p.w_glu + (size_t)j * 256 * 256, 256, 256, 256, 0, nullptr, (u16*)(p.ws + OFF_GLU + j * SZ_GLU), r - 1696, smem);
  }
}

DI void norm_phase(const float* __restrict__ xl, const float* __restrict__ xc, const float* __restrict__ g,
                           const float* __restrict__ modl, int shift_i, int scale_i, int nrows, u16* __restrict__ dst, float* __restrict__ psn) {
  const int tid_ = otid();
  const int lane = tid_ & 63;
  const int gw = blockIdx.x * 4 + (tid_ >> 6);
  for (int R = gw; R < nrows; R += gridDim.x * 4) {
    const float* src = R < NLAT ? xl + (size_t)R * 1024 : xc + (size_t)(R - NLAT) * 1024;
    const int mrow = R < NLAT ? (R >> 11) : 16;
    float4 v[4];
    float ss = 0.f;
#pragma unroll
    for (int i = 0; i < 4; ++i) {
      v[i] = *(const float4*)(src + lane * 4 + 256 * i);
      ss += v[i].x * v[i].x + v[i].y * v[i].y + v[i].z * v[i].z + v[i].w * v[i].w;
    }
#pragma unroll
    for (int o = 32; o >= 1; o >>= 1) ss += __shfl_xor(ss, o);
    if (lane < 8) psn[(size_t)R * 8 + lane] = lane == 0 ? ss : 0.f;
    const float* sc = modl + (size_t)mrow * 6144 + scale_i * 1024;
#pragma unroll
    for (int i = 0; i < 4; ++i) {
      int col = lane * 4 + 256 * i;
      float4 gg = *(const float4*)(g + col), c4 = *(const float4*)(sc + col);
      float y0 = v[i].x * gg.x * (1.f + c4.x);
      float y1 = v[i].y * gg.y * (1.f + c4.y);
      float y2 = v[i].z * gg.z * (1.f + c4.z);
      float y3 = v[i].w * gg.w * (1.f + c4.w);
      uint2 o2; o2.x = pack2(y0, y1); o2.y = pack2(y2, y3);
      *(uint2*)(dst + (size_t)R * 1024 + col) = o2;
    }
  }
}

DI void sw_items(const float* __restrict__ shift, const u16* __restrict__ Wt, int N, float* __restrict__ out, int ostride) {
  const int tid_ = otid();
  const int lane = tid_ & 63;
  const int gw = blockIdx.x * 4 + (tid_ >> 6);
  for (int n = gw; n < N; n += gridDim.x * 4) {
    const uint4 w0 = *(const uint4*)(Wt + (size_t)n * 1024 + lane * 16);
    const uint4 w1 = *(const uint4*)(Wt + (size_t)n * 1024 + lane * 16 + 8);
    float wf[16];
    wf[0] = __uint_as_float(w0.x << 16); wf[1] = __uint_as_float(w0.x & 0xffff0000u);
    wf[2] = __uint_as_float(w0.y << 16); wf[3] = __uint_as_float(w0.y & 0xffff0000u);
    wf[4] = __uint_as_float(w0.z << 16); wf[5] = __uint_as_float(w0.z & 0xffff0000u);
    wf[6] = __uint_as_float(w0.w << 16); wf[7] = __uint_as_float(w0.w & 0xffff0000u);
    wf[8] = __uint_as_float(w1.x << 16); wf[9] = __uint_as_float(w1.x & 0xffff0000u);
    wf[10] = __uint_as_float(w1.y << 16); wf[11] = __uint_as_float(w1.y & 0xffff0000u);
    wf[12] = __uint_as_float(w1.z << 16); wf[13] = __uint_as_float(w1.z & 0xffff0000u);
    wf[14] = __uint_as_float(w1.w << 16); wf[15] = __uint_as_float(w1.w & 0xffff0000u);
#pragma unroll 1
    for (int bb = 0; bb < 17; ++bb) {
      const float* sp = shift + (size_t)bb * 6144 + lane * 16;
      float acc = 0.f;
#pragma unroll
      for (int q = 0; q < 4; ++q) {
        float4 t = *(const float4*)(sp + 4 * q);
        acc += t.x * wf[4 * q] + t.y * wf[4 * q + 1] + t.z * wf[4 * q + 2] + t.w * wf[4 * q + 3];
      }
#pragma unroll
      for (int o = 32; o >= 1; o >>= 1) acc += __shfl_xor(acc, o);
      if (lane == 0) out[(size_t)bb * ostride + n] = acc;
    }
  }
}

enum { EPI_EVEN_IN = 0, EPI_ODD_IN, EPI_UQ, EPI_UKV, EPI_GLU, EPI_RESID, EPI_RELU2 };

struct EpiArgs {
  int j;
  const float* gate;
  const float* src_lat; const float* src_ctx; float* dst_lat; float* dst_ctx;
  const float* sw; int sw_stride;
  u16* xg_dst;
  const float* ng; const float* nscale;
};

DI void store16(u16* dst, const float* y) {
  uint4 a, b;
  a.x = pack2(y[0], y[1]); a.y = pack2(y[2], y[3]); a.z = pack2(y[4], y[5]); a.w = pack2(y[6], y[7]);
  b.x = pack2(y[8], y[9]); b.y = pack2(y[10], y[11]); b.z = pack2(y[12], y[13]); b.w = pack2(y[14], y[15]);
  *(uint4*)dst = a; *(uint4*)(dst + 8) = b;
}
DI void load16(const float* s, float* v) {
#pragma unroll
  for (int q = 0; q < 4; ++q) { float4 t = *(const float4*)(s + 4 * q); v[4 * q] = t.x; v[4 * q + 1] = t.y; v[4 * q + 2] = t.z; v[4 * q + 3] = t.w; }
}

DI void epi_head64(const P& p, const float* Cs, int b, int pos0, bool isctx, const float* __restrict__ g, bool rope,
                   u16* __restrict__ dstbase, int H, int head0) {
  const int tid = otid(), sub = tid & 7, hh = sub >> 2, jq = sub & 3;
  const float* rt = (const float*)(p.ws + OFF_ROPE);
#pragma unroll 1
  for (int pass = 0; pass < 4; ++pass) {
    const int row = pass * 32 + (tid >> 3);
    float v[16], pv[16];
    load16(Cs + row * CP + 16 * sub, v);
    float ss = 0.f;
#pragma unroll
    for (int i = 0; i < 16; ++i) ss += v[i] * v[i];
    ss += __shfl_xor(ss, 1); ss += __shfl_xor(ss, 2);
    const float rs = rsqrtf(ss * (1.f / 64.f) + EPSF);
#pragma unroll
    for (int i = 0; i < 16; ++i) v[i] = v[i] * rs * g[16 * jq + i];
    const int pos = pos0 + row;
    if (rope && !isctx) {
      load16(Cs + row * CP + 16 * (sub ^ 1), pv);
      const int lp = pos - 256;
      const int ti = (jq < 2) ? (lp >> 6) : (lp & 63);
      const float sgn = (jq & 1) ? 1.f : -1.f;
#pragma unroll
      for (int i = 0; i < 16; ++i) {
        float pn = pv[i] * rs * g[16 * (jq ^ 1) + i];
        float cs = rt[ti * 16 + i], sn = rt[1024 + ti * 16 + i];
        v[i] = v[i] * cs + sgn * pn * sn;
      }
    }
    store16(dstbase + (((size_t)b * H + head0 + hh) * SP + pos) * 64 + 16 * jq, v);
  }
}

DI void epi_vt(const float* Cs, int b, int pos0, u16* __restrict__ dstbase, int H, int head0, int c0, int ncols, float mul_unused) {
  const int tid = otid();
  const int cl = tid % ncols, tg = tid / ncols, ngrp = NTHR / ncols;
  const int col = c0 + cl;
  const int head = head0 + (cl >> 6), d = cl & 63;
  u16* drow = dstbase + (((size_t)b * H + head) * 64 + d) * SP + pos0;
  for (int tk = tg; tk < 16; tk += ngrp) {
    float y[8];
#pragma unroll
    for (int e = 0; e < 8; ++e) y[e] = Cs[(tk * 8 + e) * CP + col];
    uint4 a; a.x = pack2(y[0], y[1]); a.y = pack2(y[2], y[3]); a.z = pack2(y[4], y[5]); a.w = pack2(y[6], y[7]);
    *(uint4*)(drow + tk * 8) = a;
  }
}

template <int EPI>
DI void epilogue(const P& p, const EpiArgs& ea, float* Cs, int mtile, int ntile) {
  const int tid = otid();
  const int m0 = mtile * 128, n0 = ntile * 128;
  const bool isctx = m0 >= NLAT;
  const int b = isctx ? ((m0 - NLAT) >> 8) : (m0 >> 11);
  const int pos0 = isctx ? ((m0 - NLAT) & 255) : 256 + (m0 & 2047);
  const int mrow = isctx ? 16 : b;
  char* ws = p.ws;
  if (EPI == EPI_RESID) {
    const int c4 = (tid & 31) * 4;
    const int n = n0 + c4;
    const int R0 = m0 + (tid >> 5);
    const float* src = (isctx ? ea.src_ctx + (size_t)(R0 - NLAT) * 1024 : ea.src_lat + (size_t)R0 * 1024) + n;
    float* dst = (isctx ? ea.dst_ctx + (size_t)(R0 - NLAT) * 1024 : ea.dst_lat + (size_t)R0 * 1024) + n;
    const float4 gv = *(const float4*)(ea.gate + (size_t)mrow * 6144 + n);
    float4 gmv = make_float4(0.f, 0.f, 0.f, 0.f);
    if (ea.ng) {
      float4 g4 = *(const float4*)(ea.ng + n), s4 = *(const float4*)(ea.nscale + (size_t)mrow * 6144 + n);
      gmv.x = g4.x * (1.f + s4.x); gmv.y = g4.y * (1.f + s4.y); gmv.z = g4.z * (1.f + s4.z); gmv.w = g4.w * (1.f + s4.w);
    }
    float4 xv[16];
#pragma unroll
    for (int pass = 0; pass < 16; ++pass) xv[pass] = *(const float4*)(src + (size_t)pass * 8 * 1024);
#pragma unroll
    for (int pass = 0; pass < 16; ++pass) {
      const int row = pass * 8 + (tid >> 5);
      float4 a = *(const float4*)(Cs + row * CP + c4);
      float4 o; o.x = xv[pass].x + gv.x * a.x; o.y = xv[pass].y + gv.y * a.y; o.z = xv[pass].z + gv.z * a.z; o.w = xv[pass].w + gv.w * a.w;
      *(float4*)(dst + (size_t)pass * 8 * 1024) = o;
      if (ea.ng) {
        float ss = o.x * o.x + o.y * o.y + o.z * o.z + o.w * o.w;
#pragma unroll
        for (int q = 16; q >= 1; q >>= 1) ss += __shfl_xor(ss, q);
        const int R = m0 + row;
        if ((tid & 31) == 0) ((float*)(ws + OFF_PSN))[(size_t)R * 8 + ntile] = ss;
        uint2 xo; xo.x = pack2(o.x * gmv.x, o.y * gmv.y); xo.y = pack2(o.z * gmv.z, o.w * gmv.w);
        *(uint2*)(ea.xg_dst + (size_t)R * 1024 + n) = xo;
      }
    }
  } else if (EPI == EPI_RELU2 || EPI == EPI_GLU) {
    const int c4 = (tid & 31) * 4;
    const int n = n0 + c4;
#pragma unroll 4
    for (int pass = 0; pass < 16; ++pass) {
      const int row = pass * 8 + (tid >> 5);
      const int R = m0 + row;
      float4 a = *(const float4*)(Cs + row * CP + c4);
      if (EPI == EPI_RELU2) {
        float r0 = fmaxf(a.x, 0.f), r1 = fmaxf(a.y, 0.f), r2 = fmaxf(a.z, 0.f), r3 = fmaxf(a.w, 0.f);
        uint2 o; o.x = pack2(r0 * r0, r1 * r1); o.y = pack2(r2 * r2, r3 * r3);
        *(uint2*)((u16*)(ws + OFF_H) + (size_t)R * 4096 + n) = o;
      } else {
        const u16* yg = (const u16*)(ws + E_YG) + (size_t)R * 256 + n;
        uint2 yv = *(const uint2*)yg;
        float4 bg = *(const float4*)(p.b_glu + ea.j * 256 + n);
        float y0 = __uint_as_float(yv.x << 16), y1 = __uint_as_float(yv.x & 0xffff0000u);
        float y2 = __uint_as_float(yv.y << 16), y3 = __uint_as_float(yv.y & 0xffff0000u);
        float o0 = y0 / (1.f + __expf(-(a.x + bg.x))), o1 = y1 / (1.f + __expf(-(a.y + bg.y)));
        float o2 = y2 / (1.f + __expf(-(a.z + bg.z))), o3 = y3 / (1.f + __expf(-(a.w + bg.w)));
        uint2 o; o.x = pack2(o0, o1); o.y = pack2(o2, o3);
        *(uint2*)((u16*)(ws + OFF_ABUF) + (size_t)R * 1024 + 768 + n) = o;
      }
    }
  } else if (EPI == EPI_EVEN_IN) {
    if (ntile < 6) epi_head64(p, Cs, b, pos0, isctx, p.e_g_q + ea.j * 64, true, (u16*)(ws + E_Q), 12, ntile * 2);
    else if (ntile < 8) epi_head64(p, Cs, b, pos0, isctx, p.e_g_k + ea.j * 64, true, (u16*)(ws + E_K), 4, (ntile - 6) * 2);
    else if (ntile < 10) epi_vt(Cs, b, pos0, (u16*)(ws + E_VT), 4, (ntile - 8) * 2, 0, 128, 1.f);
    else {
      const int c4 = (tid & 31) * 4;
      float* U = (float*)(ws + E_U);
      for (int pass = 0; pass < 16; ++pass) {
        const int row = pass * 8 + (tid >> 5);
        *(float4*)(U + (size_t)(m0 + row) * 256 + (ntile - 10) * 128 + c4) = *(const float4*)(Cs + row * CP + c4);
      }
    }
  } else if (EPI == EPI_ODD_IN) {
    if (ntile < 6) {
      const int c4 = (tid & 31) * 4;
      float* PS = (float*)(ws + O_PS);
      for (int pass = 0; pass < 16; ++pass) {
        const int row = pass * 8 + (tid >> 5);
        const int R = m0 + row;
        float4 a = *(const float4*)(Cs + row * CP + c4);
        float ss = a.x * a.x + a.y * a.y + a.z * a.z + a.w * a.w;
#pragma unroll
        for (int o = 16; o >= 1; o >>= 1) ss += __shfl_xor(ss, o);
        if ((tid & 31) == 0) PS[(size_t)R * 8 + ntile] = ss;
        uint2 o; o.x = pack2(a.x, a.y); o.y = pack2(a.z, a.w);
        if (ntile < 4) *(uint2*)((u16*)(ws + O_CQ) + (size_t)R * 512 + n0 + c4) = o;
        else *(uint2*)((u16*)(ws + O_CKV) + (size_t)R * 256 + (n0 - 512) + c4) = o;
      }
    } else if (ntile < 10) epi_head64(p, Cs, b, pos0, isctx, p.g_nq + ea.j * 64, false, (u16*)(ws + O_NQ), 8, (ntile - 6) * 2);
    else if (ntile < 14) epi_head64(p, Cs, b, pos0, isctx, p.g_nk + ea.j * 64, false, (u16*)(ws + O_NK), 8, (ntile - 10) * 2);
    else if (ntile < 18) epi_vt(Cs, b, pos0, (u16*)(ws + O_NVT), 8, (ntile - 14) * 2, 0, 128, 1.f);
    else {
      float* KR = (float*)(ws + O_KR);
      const int c4 = (tid & 7) * 4;
      for (int pass = 0; pass < 4; ++pass) {
        const int row = pass * 32 + (tid >> 3);
        *(float4*)(KR + (size_t)(m0 + row) * 32 + c4) = *(const float4*)(Cs + row * CP + c4);
      }
    }
  } else if (EPI == EPI_UQ || EPI == EPI_UKV) {
    const int sub = tid & 7;
    const float* PS = (const float*)(ws + O_PS);
    const float* rt = (const float*)(ws + OFF_ROPE);
    const float* gm = (EPI == EPI_UQ ? p.g_mq : p.g_mk) + ea.j * 96;
    u16* dstb = (u16*)(ws + (EPI == EPI_UQ ? O_MQ : O_MK));
    const float* KR = (const float*)(ws + O_KR);
#pragma unroll 1
    for (int pass = 0; pass < 4; ++pass) {
      const int row = pass * 32 + (tid >> 3);
      const int R = m0 + row;
      float rstd;
      if (EPI == EPI_UQ) {
        float4 ps = *(const float4*)(PS + (size_t)R * 8);
        rstd = rsqrtf((ps.x + ps.y + ps.z + ps.w) * (1.f / 512.f) + EPSF);
      } else {
        float2 ps = *(const float2*)(PS + (size_t)R * 8 + 4);
        rstd = rsqrtf((ps.x + ps.y) * (1.f / 256.f) + EPSF);
      }
      float v[16];
      if (EPI == EPI_UQ) {
        load16(Cs + row * CP + 16 * sub, v);
#pragma unroll
        for (int i = 0; i < 16; ++i) v[i] *= rstd;
      } else {
        if (sub < 4) {
          load16(Cs + row * CP + 16 * sub, v);
#pragma unroll
          for (int i = 0; i < 16; ++i) v[i] *= rstd;
        } else if (sub < 6) {
          load16(KR + (size_t)R * 32 + 16 * (sub - 4), v);
        } else {
#pragma unroll
          for (int i = 0; i < 16; ++i) v[i] = 0.f;
        }
      }
      float ss = 0.f;
#pragma unroll
      for (int i = 0; i < 16; ++i) ss += v[i] * v[i];
      ss += __shfl_xor(ss, 1); ss += __shfl_xor(ss, 2); ss += __shfl_xor(ss, 4);
      const float rs = rsqrtf(ss * (1.f / 96.f) + EPSF);
      if (sub < 6) {
#pragma unroll
        for (int i = 0; i < 16; ++i) v[i] = v[i] * rs * gm[16 * sub + i];
        const int pos = pos0 + row;
        if (sub >= 4 && !isctx) {
          const int lp = pos - 256;
          const int ti = (sub == 4) ? (lp >> 6) : (lp & 63);
#pragma unroll
          for (int i = 0; i < 8; ++i) {
            float cs = rt[2048 + ti * 8 + i], sn = rt[2560 + ti * 8 + i];
            float x1 = v[i], x2 = v[i + 8];
            v[i] = x1 * cs - x2 * sn;
            v[i + 8] = x2 * cs + x1 * sn;
          }
        }
        store16(dstb + (((size_t)b * 8 + ntile) * SP + pos) * 96 + 16 * sub, v);
      }
    }
    if (EPI == EPI_UKV) {
      const int cl = tid & 63, tg = tid >> 6;
      u16* drow = (u16*)(ws + O_MVT) + (((size_t)b * 8 + ntile) * 64 + cl) * SP + pos0;
      for (int tk = tg; tk < 16; tk += 4) {
        float y[8];
#pragma unroll
        for (int e = 0; e < 8; ++e) {
          const int R = m0 + tk * 8 + e;
          float2 ps = *(const float2*)(PS + (size_t)R * 8 + 4);
          float rstd = rsqrtf((ps.x + ps.y) * (1.f / 256.f) + EPSF);
          y[e] = Cs[(tk * 8 + e) * CP + 64 + cl] * rstd;
        }
        uint4 a; a.x = pack2(y[0], y[1]); a.y = pack2(y[2], y[3]); a.z = pack2(y[4], y[5]); a.w = pack2(y[6], y[7]);
        *(uint4*)(drow + tk * 8) = a;
      }
    }
  }
}

template <int EPI, int PROBE = 0>
DI void gemm_phase(const P& p, const u16* __restrict__ A, const u16* __restrict__ Bt, int K, int mt, int ntn, int band,
                           const EpiArgs& ea, char* smem) {
  const int tid = otid(), lane = tid & 63, w = tid >> 6, wm = w >> 1, wn = w & 1, r = lane & 31, h = lane >> 5;
  u16* As = (u16*)smem;
  u16* Bs = As + 2 * 9216;
  float* Cs = (float*)smem;
  const int total = mt * ntn;
  const int mper = mt >> 3;
  const int nk = K >> 6;
  const int lrow = tid >> 3, lkc = (tid & 7) * 8;
  for (int t = blockIdx.x; t < total; t += gridDim.x) {
    const int xcd = t & 7, L = t >> 3;
    const int bandsz = band * ntn;
    const int bi = L / bandsz, rr = L - bi * bandsz;
    const int full = (ntn >> 3) * (band * 8);
    int mi_, ni_;
    if (rr < full) { int ch = rr / (band * 8); int wv = rr - ch * (band * 8); mi_ = wv % band; ni_ = ch * 8 + wv / band; }
    else { int r2 = rr - full; mi_ = r2 % band; ni_ = (ntn >> 3) * 8 + r2 / band; }
    const int mtile = xcd * mper + bi * band + mi_;
    const int ntile = ni_;
    constexpr bool AFF = (EPI == EPI_EVEN_IN || EPI == EPI_ODD_IN || EPI == EPI_RELU2);
    float* rsb = (float*)(smem + 73728);
    if (AFF && tid < 128) {
      const float* ps = (const float*)(p.ws + OFF_PSN) + (size_t)(mtile * 128 + tid) * 8;
      float4 p0 = *(const float4*)ps, p1 = *(const float4*)(ps + 4);
      rsb[tid] = rsqrtf((p0.x + p0.y + p0.z + p0.w + p1.x + p1.y + p1.z + p1.w) * (1.f / 1024.f) + EPSF);
    }
    const u16* Ag = A + (size_t)(mtile * 128 + lrow) * K + lkc;
    const u16* Bg = Bt + (size_t)(ntile * 128 + lrow) * K + lkc;
    f32x16 acc[2][2];
#pragma unroll
    for (int a = 0; a < 2; ++a)
#pragma unroll
      for (int c = 0; c < 2; ++c)
#pragma unroll
        for (int i = 0; i < 16; ++i) acc[a][c][i] = 0.f;
    uint4 ra0_0, ra0_1, ra0_2, ra0_3, rb0_0, rb0_1, rb0_2, rb0_3, ra1_0, ra1_1, ra1_2, ra1_3, rb1_0, rb1_1, rb1_2, rb1_3;
#define G_LD1(S, i, kt_) ra##S##_##i = *(const uint4*)(Ag + (size_t)(32 * i) * K + (kt_) * 64); rb##S##_##i = *(const uint4*)(Bg + (size_t)(32 * i) * K + (kt_) * 64);
#define G_LOAD(S, kt_) { G_LD1(S, 0, kt_) G_LD1(S, 1, kt_) G_LD1(S, 2, kt_) G_LD1(S, 3, kt_) }
#define L_ST1(S, i, buf_) *(uint4*)(As + (buf_) * 9216 + (lrow + 32 * i) * 72 + lkc) = ra##S##_##i; *(uint4*)(Bs + (buf_) * 9216 + (lrow + 32 * i) * 72 + lkc) = rb##S##_##i;
#define L_STORE(S, buf_) { L_ST1(S, 0, buf_) L_ST1(S, 1, buf_) L_ST1(S, 2, buf_) L_ST1(S, 3, buf_) }
#define G_COMPUTE(buf_) { \
      const u16* as = As + (buf_) * 9216 + (wm * 64 + r) * 72 + h * 8; \
      const u16* bs = Bs + (buf_) * 9216 + (wn * 64 + r) * 72 + h * 8; \
      _Pragma("unroll") for (int kk = 0; kk < 4; ++kk) { \
        bf16x8 a0 = *(const bf16x8*)(as + kk * 16), a1 = *(const bf16x8*)(as + 32 * 72 + kk * 16); \
        bf16x8 b0 = *(const bf16x8*)(bs + kk * 16), b1 = *(const bf16x8*)(bs + 32 * 72 + kk * 16); \
        acc[0][0] = MFMA32(a0, b0, acc[0][0]); acc[0][1] = MFMA32(a0, b1, acc[0][1]); \
        acc[1][0] = MFMA32(a1, b0, acc[1][0]); acc[1][1] = MFMA32(a1, b1, acc[1][1]); } }
#define LDFRAG(P_, kk) P_##a0 = *(const bf16x8*)(as_ + (kk) * 16); P_##a1 = *(const bf16x8*)(as_ + 32 * 72 + (kk) * 16); \
                       P_##b0 = *(const bf16x8*)(bs_ + (kk) * 16); P_##b1 = *(const bf16x8*)(bs_ + 32 * 72 + (kk) * 16);
#define MFMA4(P_) acc[0][0] = MFMA32(P_##a0, P_##b0, acc[0][0]); acc[0][1] = MFMA32(P_##a0, P_##b1, acc[0][1]); \
                  acc[1][0] = MFMA32(P_##a1, P_##b0, acc[1][0]); acc[1][1] = MFMA32(P_##a1, P_##b1, acc[1][1]);
#define G_PIPE(buf_, SNEXT, nbuf_, dost_) { \
      const u16* as_ = As + (buf_) * 9216 + (wm * 64 + r) * 72 + h * 8; \
      const u16* bs_ = Bs + (buf_) * 9216 + (wn * 64 + r) * 72 + h * 8; \
      bf16x8 f_a0, f_a1, f_b0, f_b1, g_a0, g_a1, g_b0, g_b1; \
      LDFRAG(f_, 0) \
      LDFRAG(g_, 1) \
      __builtin_amdgcn_sched_barrier(0); \
      MFMA4(f_) if (dost_) { L_ST1(SNEXT, 0, nbuf_) } \
      __builtin_amdgcn_sched_barrier(0); \
      LDFRAG(f_, 2) \
      MFMA4(g_) if (dost_) { L_ST1(SNEXT, 1, nbuf_) } \
      __builtin_amdgcn_sched_barrier(0); \
      LDFRAG(g_, 3) \
      MFMA4(f_) if (dost_) { L_ST1(SNEXT, 2, nbuf_) } \
      __builtin_amdgcn_sched_barrier(0); \
      MFMA4(g_) if (dost_) { L_ST1(SNEXT, 3, nbuf_) } }
#define G_COMPUTE_NOLDS() { \
      _Pragma("unroll") for (int kk = 0; kk < 4; ++kk) { \
        acc[0][0] = MFMA32(pa0, pb0, acc[0][0]); acc[0][1] = MFMA32(pa0, pb1, acc[0][1]); \
        acc[1][0] = MFMA32(pa1, pb0, acc[1][0]); acc[1][1] = MFMA32(pa1, pb1, acc[1][1]); } }
    bf16x8 pa0 = *(const bf16x8*)(As + r * 72 + h * 8), pa1 = *(const bf16x8*)(As + (32 + r) * 72 + h * 8);
    bf16x8 pb0 = *(const bf16x8*)(Bs + r * 72 + h * 8), pb1 = *(const bf16x8*)(Bs + (32 + r) * 72 + h * 8);
    (void)pa0; (void)pa1; (void)pb0; (void)pb1;
    G_LOAD(0, 0);
    G_LOAD(1, 1);
    L_STORE(0, 0);
    __syncthreads();
    for (int kt = 0; kt < nk; kt += 2) {
      if (kt + 2 < nk) { G_LOAD(0, kt + 2); }
      { G_PIPE(0, 1, 1, true) }
      __syncthreads();
      if (kt + 3 < nk) { G_LOAD(1, kt + 3); }
      { const bool st_ = kt + 2 < nk; G_PIPE(1, 0, 0, st_) }
      __syncthreads();
    }
    if (AFF) {
      const int mrow_ = (mtile * 128 >= NLAT) ? 16 : ((mtile * 128) >> 11);
#pragma unroll
      for (int c = 0; c < 2; ++c) {
        const float swc = ea.sw[(size_t)mrow_ * ea.sw_stride + ntile * 128 + wn * 64 + c * 32 + r];
#pragma unroll
        for (int a = 0; a < 2; ++a)
#pragma unroll
          for (int i = 0; i < 16; ++i) {
            const int row = wm * 64 + a * 32 + (i & 3) + 8 * (i >> 2) + 4 * h;
            Cs[row * CP + wn * 64 + c * 32 + r] = acc[a][c][i] * rsb[row] + swc;
          }
      }
    } else {
#pragma unroll
      for (int a = 0; a < 2; ++a)
#pragma unroll
        for (int c = 0; c < 2; ++c)
#pragma unroll
          for (int i = 0; i < 16; ++i)
            Cs[(wm * 64 + a * 32 + (i & 3) + 8 * (i >> 2) + 4 * h) * CP + wn * 64 + c * 32 + r] = acc[a][c][i];
    }
    __syncthreads();
    epilogue<EPI>(p, ea, Cs, mtile, ntile);
    __syncthreads();
  }
}

template <int DQK, bool NA>
DI void attn_phase(const u16* __restrict__ Q, const u16* __restrict__ Kb, const u16* __restrict__ Vt, int HQ, int HK,
                           float scale, u16* __restrict__ mix, int coloff, bool do_ctx, const float* __restrict__ rpb, char* smem) {
  constexpr int KP = DQK + 8;
  constexpr int NKK = DQK / 16;
  constexpr int KCH = DQK / 32;
  const int tid = otid(), lane = tid & 63, w = tid >> 6, r = lane & 31, h = lane >> 5;
  u16* Ks = (u16*)smem;
  u16* Vs = (u16*)(smem + 13312);
  float* rpbs = (float*)(smem + 22528);
  const int grp_heads = HQ / HK;
  const int nqb = 16 + (do_ctx ? 2 : 0);
  const int upg = grp_heads * nqb;
  const int total = 16 * HK * upg;
  const float sl2 = scale * LOG2E;
  for (int u = blockIdx.x; u < total; u += gridDim.x) {
    const int xcd = u & 7, L = u >> 3;
    const int grp = (L / upg) * 8 + xcd, wi = L % upg;
    const int b = grp / HK, hk = grp % HK;
    const int hq = hk * grp_heads + wi / nqb, qb = wi % nqb;
    const bool lat = qb < 16;
    const int qpos0 = lat ? 256 + 128 * qb : 128 * (qb - 16);
    int ntiles = lat ? 36 : 4;
    int rs0 = 0, rw = 0, rsw = 0;
    if (NA && lat) {
      int r0 = 2 * qb;
      rs0 = min(max(r0 - 4, 0), 24);
      int rs1 = min(max(r0 + 1 - 4, 0), 24);
      ntiles = 4 + (rs1 + 8 - rs0);
      rw = r0 + (w >> 1);
      rsw = min(max(rw - 4, 0), 24);
    }
    const int qpos = qpos0 + w * 32 + r;
    bf16x8 qf[NKK];
    {
      const u16* qp = Q + (((size_t)b * HQ + hq) * SP + qpos) * DQK + 8 * h;
#pragma unroll
      for (int kk = 0; kk < NKK; ++kk) qf[kk] = *(const bf16x8*)(qp + 16 * kk);
    }
    f32x16 o0, o1;
#pragma unroll
    for (int i = 0; i < 16; ++i) { o0[i] = 0.f; o1[i] = 0.f; }
    float m = -1e30f, l = 0.f;
    const u16* kbase = Kb + ((size_t)b * HK + hk) * SP * DQK;
    const u16* vbase = Vt + ((size_t)b * HK + hk) * 64 * SP;
    uint4 rk0, rk1, rk2 = make_uint4(0, 0, 0, 0), rv0, rv1;
#define KPOS_OF(i) ((NA && lat && (i) >= 4) ? 256 + 64 * (rs0 + (i) - 4) : 64 * (i))
#define ATT_GLOAD(kp) do { \
      rk0 = *(const uint4*)(kbase + (size_t)(kp) * DQK + tid * 8); \
      rk1 = *(const uint4*)(kbase + (size_t)(kp) * DQK + (tid + 256) * 8); \
      if (KCH > 2) rk2 = *(const uint4*)(kbase + (size_t)(kp) * DQK + (tid + 512) * 8); \
      rv0 = *(const uint4*)(vbase + (size_t)(tid >> 3) * SP + (kp) + (tid & 7) * 8); \
      rv1 = *(const uint4*)(vbase + (size_t)((tid >> 3) + 32) * SP + (kp) + (tid & 7) * 8); } while (0)
    { const int kp0 = KPOS_OF(0); ATT_GLOAD(kp0); }
    for (int ti = 0; ti < ntiles; ++ti) {
      __syncthreads();
      { int c = tid; *(uint4*)(Ks + (c / (DQK / 8)) * KP + (c % (DQK / 8)) * 8) = rk0; }
      { int c = tid + 256; *(uint4*)(Ks + (c / (DQK / 8)) * KP + (c % (DQK / 8)) * 8) = rk1; }
      if (KCH > 2) { int c = tid + 512; *(uint4*)(Ks + (c / (DQK / 8)) * KP + (c % (DQK / 8)) * 8) = rk2; }
      *(uint4*)(Vs + (tid >> 3) * 72 + (tid & 7) * 8) = rv0;
      *(uint4*)(Vs + ((tid >> 3) + 32) * 72 + (tid & 7) * 8) = rv1;
      if (NA && ti == 0) { for (int q = tid; q < 465; q += NTHR) rpbs[q] = rpb[hq * 465 + q]; }
      __syncthreads();
      if (ti + 1 < ntiles) { const int kp1 = KPOS_OF(ti + 1); ATT_GLOAD(kp1); }
      bool active = true;
      int jrow = 0;
      if (NA && lat && ti >= 4) { jrow = rs0 + ti - 4; active = (jrow >= rsw) && (jrow < rsw + 8); }
      if (active) {
        f32x16 s0, s1;
#pragma unroll
        for (int i = 0; i < 16; ++i) { s0[i] = 0.f; s1[i] = 0.f; }
#pragma unroll
        for (int kk = 0; kk < NKK; ++kk) {
          bf16x8 k0 = *(const bf16x8*)(Ks + r * KP + 16 * kk + 8 * h);
          bf16x8 k1 = *(const bf16x8*)(Ks + (32 + r) * KP + 16 * kk + 8 * h);
          s0 = MFMA32(k0, qf[kk], s0);
          s1 = MFMA32(k1, qf[kk], s1);
        }
        if (NA && lat && ti >= 4) {
          const int qc = (w & 1) * 32 + r;
          const int cs = min(max(qc - 8, 0), 48);
          const float* brow = rpbs + (jrow - rw + 7) * 31 + (15 - qc);
#pragma unroll
          for (int i = 0; i < 16; ++i) {
            int kc0 = (i & 3) + 8 * (i >> 2) + 4 * h, kc1 = kc0 + 32;
            bool v0 = (kc0 >= cs) && (kc0 < cs + 16), v1 = (kc1 >= cs) && (kc1 < cs + 16);
            float b0 = v0 ? brow[kc0] : 0.f, b1 = v1 ? brow[kc1] : 0.f;
            s0[i] = v0 ? (s0[i] * sl2 + b0 * LOG2E) : -1e30f;
            s1[i] = v1 ? (s1[i] * sl2 + b1 * LOG2E) : -1e30f;
          }
        } else {
#pragma unroll
          for (int i = 0; i < 16; ++i) { s0[i] *= sl2; s1[i] *= sl2; }
        }
        float tm = s0[0];
#pragma unroll
        for (int i = 1; i < 16; ++i) tm = fmaxf(tm, s0[i]);
#pragma unroll
        for (int i = 0; i < 16; ++i) tm = fmaxf(tm, s1[i]);
        tm = fmaxf(tm, __shfl_xor(tm, 32));
        const float mn = fmaxf(m, tm);
        const float alpha = __builtin_amdgcn_exp2f(m - mn);
        m = mn;
        float ps = 0.f;
#pragma unroll
        for (int i = 0; i < 16; ++i) { s0[i] = __builtin_amdgcn_exp2f(s0[i] - mn); ps += s0[i]; s1[i] = __builtin_amdgcn_exp2f(s1[i] - mn); ps += s1[i]; }
        l = l * alpha + ps;
#pragma unroll
        for (int i = 0; i < 16; ++i) { o0[i] *= alpha; o1[i] *= alpha; }
#pragma unroll
        for (int kt = 0; kt < 2; ++kt) {
#pragma unroll
          for (int sp = 0; sp < 2; ++sp) {
            u32x4 pu;
            pu[0] = pack2(kt ? s1[8 * sp + 0] : s0[8 * sp + 0], kt ? s1[8 * sp + 1] : s0[8 * sp + 1]);
            pu[1] = pack2(kt ? s1[8 * sp + 2] : s0[8 * sp + 2], kt ? s1[8 * sp + 3] : s0[8 * sp + 3]);
            pu[2] = pack2(kt ? s1[8 * sp + 4] : s0[8 * sp + 4], kt ? s1[8 * sp + 5] : s0[8 * sp + 5]);
            pu[3] = pack2(kt ? s1[8 * sp + 6] : s0[8 * sp + 6], kt ? s1[8 * sp + 7] : s0[8 * sp + 7]);
            const bf16x8 pfv = __builtin_bit_cast(bf16x8, pu);
            const int ko = 32 * kt + 16 * sp + 4 * h;
            const uint2 a0 = *(const uint2*)(Vs + r * 72 + ko), a1 = *(const uint2*)(Vs + r * 72 + ko + 8);
            const uint2 c0 = *(const uint2*)(Vs + (32 + r) * 72 + ko), c1 = *(const uint2*)(Vs + (32 + r) * 72 + ko + 8);
            u32x4 vau, vbu;
            vau[0] = a0.x; vau[1] = a0.y; vau[2] = a1.x; vau[3] = a1.y;
            vbu[0] = c0.x; vbu[1] = c0.y; vbu[2] = c1.x; vbu[3] = c1.y;
            const bf16x8 vav = __builtin_bit_cast(bf16x8, vau), vbv = __builtin_bit_cast(bf16x8, vbu);
            o0 = MFMA32(vav, pfv, o0);
            o1 = MFMA32(vbv, pfv, o1);
          }
        }
      }
    }
    l += __shfl_xor(l, 32);
    const float inv = 1.f / l;
    const int R = tok_row(b, qpos);
    u16* op = mix + (size_t)R * 1024 + coloff + hq * 64 + 4 * h;
#pragma unroll
    for (int g4 = 0; g4 < 4; ++g4) {
      uint2 a, c;
      a.x = pack2(o0[4 * g4] * inv, o0[4 * g4 + 1] * inv); a.y = pack2(o0[4 * g4 + 2] * inv, o0[4 * g4 + 3] * inv);
      c.x = pack2(o1[4 * g4] * inv, o1[4 * g4 + 1] * inv); c.y = pack2(o1[4 * g4 + 2] * inv, o1[4 * g4 + 3] * inv);
      *(uint2*)(op + 8 * g4) = a;
      *(uint2*)(op + 32 + 8 * g4) = c;
    }
  }
  __syncthreads();
}

DI void s5_pass1(const P& p, int j, char* smem) {
  const int tid = otid(), lane = tid & 63, w = tid >> 6;
  const float* U = (const float*)(p.ws + E_U);
  float2* E = (float2*)(p.ws + E_E);
  const float2* SA = (const float2*)(p.ws + OFF_SA);
  const float* SBB = (const float*)(p.ws + OFF_SBB);
  float* us = (float*)smem + w * 1024;
  for (int item = blockIdx.x; item < 4608; item += gridDim.x) {
    const int unit = item * 4 + w;
    const int c = unit % 36; const int t1 = unit / 36; const int dir = t1 & 1; const int t2 = t1 >> 1; const int g = t2 & 15; const int b = t2 >> 4;
#pragma unroll
    for (int i = 0; i < 4; ++i) {
      int idx = lane + 64 * i; int step = idx >> 2, quad = idx & 3;
      int tau = 64 * c + step;
      int pos = dir ? (tau < 256 ? 255 - tau : 2559 - tau) : tau;
      int row = tok_row(b, pos);
      *(float4*)(us + step * 16 + quad * 4) = *(const float4*)(U + (size_t)row * 256 + 16 * g + 4 * quad);
    }
    const int tidx = ((j * 2 + dir) * 16 + g) * 64 + lane;
    const float2 a = SA[tidx];
    float bbr[16], bbi[16];
#pragma unroll
    for (int q = 0; q < 4; ++q) {
      float4 t = *(const float4*)(SBB + (size_t)tidx * 32 + 4 * q); bbr[4 * q] = t.x; bbr[4 * q + 1] = t.y; bbr[4 * q + 2] = t.z; bbr[4 * q + 3] = t.w;
      float4 t2_ = *(const float4*)(SBB + (size_t)tidx * 32 + 16 + 4 * q); bbi[4 * q] = t2_.x; bbi[4 * q + 1] = t2_.y; bbi[4 * q + 2] = t2_.z; bbi[4 * q + 3] = t2_.w;
    }
    __builtin_amdgcn_wave_barrier();
    float hr = 0.f, hi = 0.f;
#pragma unroll 4
    for (int step = 0; step < 64; ++step) {
      float bur = 0.f, bui = 0.f;
#pragma unroll
      for (int q = 0; q < 4; ++q) {
        float4 uv = *(const float4*)(us + step * 16 + 4 * q);
        bur += bbr[4 * q] * uv.x + bbr[4 * q + 1] * uv.y + bbr[4 * q + 2] * uv.z + bbr[4 * q + 3] * uv.w;
        bui += bbi[4 * q] * uv.x + bbi[4 * q + 1] * uv.y + bbi[4 * q + 2] * uv.z + bbi[4 * q + 3] * uv.w;
      }
      float nr = a.x * hr - a.y * hi + bur;
      float ni = a.x * hi + a.y * hr + bui;
      hr = nr; hi = ni;
    }
    E[((((size_t)b * 16 + g) * 2 + dir) * 36 + c) * 64 + lane] = make_float2(hr, hi);
    __syncthreads();
  }
}

DI void s5_pass2(const P& p, int j, char* smem) {
  const int tid = otid(), lane = tid & 63, w = tid >> 6;
  const float* U = (const float*)(p.ws + E_U);
  const float2* E = (const float2*)(p.ws + E_E);
  const float2* SA = (const float2*)(p.ws + OFF_SA);
  const float2* SAL = (const float2*)(p.ws + OFF_SAL);
  const float* SBB = (const float*)(p.ws + OFF_SBB);
  u16* YG = (u16*)(p.ws + E_YG);
  char* wb = smem + w * 12544;
  float* us = (float*)wb; u16* Hs = (u16*)(wb + 4096); float* ys = (float*)(wb + 4096 + 4352);
  const int pcol = lane & 15, fq = lane >> 4;
  for (int item = blockIdx.x; item < 4608; item += gridDim.x) {
    const int Pc = item % 36; const int t1 = item / 36; const int gp = t1 & 7; const int b = t1 >> 3;
    const int g = gp * 2 + (w >> 1), dir = w & 1;
#pragma unroll
    for (int i = 0; i < 4; ++i) {
      int idx = lane + 64 * i; int k = idx >> 2, quad = idx & 3;
      int lt = dir ? 63 - k : k;
      int row = tok_row(b, 64 * Pc + lt);
      *(float4*)(us + k * 16 + quad * 4) = *(const float4*)(U + (size_t)row * 256 + 16 * g + 4 * quad);
    }
    const int tidx = ((j * 2 + dir) * 16 + g) * 64 + lane;
    const float2 a = SA[tidx], aL = SAL[tidx];
    float bbr[16], bbi[16];
#pragma unroll
    for (int q = 0; q < 4; ++q) {
      float4 t = *(const float4*)(SBB + (size_t)tidx * 32 + 4 * q); bbr[4 * q] = t.x; bbr[4 * q + 1] = t.y; bbr[4 * q + 2] = t.z; bbr[4 * q + 3] = t.w;
      float4 t2_ = *(const float4*)(SBB + (size_t)tidx * 32 + 16 + 4 * q); bbi[4 * q] = t2_.x; bbi[4 * q + 1] = t2_.y; bbi[4 * q + 2] = t2_.z; bbi[4 * q + 3] = t2_.w;
    }
    const int c = dir ? (Pc < 4 ? 3 - Pc : 39 - Pc) : Pc;
    float hr = 0.f, hi = 0.f;
    {
      const float2* Eb = E + ((((size_t)b * 16 + g) * 2 + dir) * 36) * 64 + lane;
      for (int cc = 0; cc < c; ++cc) {
        float2 e = Eb[(size_t)cc * 64];
        float nr = aL.x * hr - aL.y * hi + e.x;
        float ni = aL.x * hi + aL.y * hr + e.y;
        hr = nr; hi = ni;
      }
    }
    bf16x8 cf[4];
    {
      const size_t cbase = ((size_t)((j * 2 + dir) * 16 + g) * 16 + pcol) * 64;
#pragma unroll
      for (int ks = 0; ks < 4; ++ks) {
        const float* src = (ks < 2 ? p.c_re : p.c_im) + cbase + 32 * (ks & 1) + 8 * fq;
        float4 t0 = *(const float4*)src, t1_ = *(const float4*)(src + 4);
        const float sg = ks < 2 ? 1.f : -1.f;
        u32x4 cu;
        cu[0] = pack2(sg * t0.x, sg * t0.y); cu[1] = pack2(sg * t0.z, sg * t0.w);
        cu[2] = pack2(sg * t1_.x, sg * t1_.y); cu[3] = pack2(sg * t1_.z, sg * t1_.w);
        cf[ks] = __builtin_bit_cast(bf16x8, cu);
      }
    }
    __builtin_amdgcn_wave_barrier();
#pragma unroll 1
    for (int sub = 0; sub < 4; ++sub) {
#pragma unroll 4
      for (int k16 = 0; k16 < 16; ++k16) {
        const int k = sub * 16 + k16;
        float bur = 0.f, bui = 0.f;
#pragma unroll
        for (int q = 0; q < 4; ++q) {
          float4 uv = *(const float4*)(us + k * 16 + 4 * q);
          bur += bbr[4 * q] * uv.x + bbr[4 * q + 1] * uv.y + bbr[4 * q + 2] * uv.z + bbr[4 * q + 3] * uv.w;
          bui += bbi[4 * q] * uv.x + bbi[4 * q + 1] * uv.y + bbi[4 * q + 2] * uv.z + bbi[4 * q + 3] * uv.w;
        }
        float nr = a.x * hr - a.y * hi + bur;
        float ni = a.x * hi + a.y * hr + bui;
        hr = nr; hi = ni;
        Hs[k16 * 136 + lane] = f2bf(hr);
        Hs[k16 * 136 + 64 + lane] = f2bf(hi);
      }
      __builtin_amdgcn_wave_barrier();
      f32x4 acc = {0.f, 0.f, 0.f, 0.f};
#pragma unroll
      for (int ks = 0; ks < 4; ++ks) {
        bf16x8 af = *(const bf16x8*)(Hs + pcol * 136 + 32 * ks + 8 * fq);
        acc = MFMA16(af, cf[ks], acc);
      }
#pragma unroll
      for (int jj = 0; jj < 4; ++jj) {
        int k = sub * 16 + 4 * fq + jj;
        int lt = dir ? 63 - k : k;
        ys[lt * 16 + pcol] = acc[jj];
      }
      __builtin_amdgcn_wave_barrier();
    }
    __syncthreads();
#pragma unroll
    for (int i = 0; i < 8; ++i) {
      int idx = tid + 256 * i; int gi = idx >> 10, lt = (idx >> 4) & 63, pp = idx & 15;
      const char* w0 = smem + (2 * gi) * 12544; const char* w1 = smem + (2 * gi + 1) * 12544;
      const int gg = gp * 2 + gi;
      float y = ((const float*)(w0 + 8448))[lt * 16 + pp] + ((const float*)(w1 + 8448))[lt * 16 + pp]
              + p.ssm_d[j * 256 + 16 * gg + pp] * ((const float*)w0)[lt * 16 + pp];
      float t = 0.7978845608028654f * (y + 0.044715f * y * y * y);
      float ge = 0.5f * y * (1.f + tanhf(t));
      int row = tok_row(b, 64 * Pc + lt);
      YG[(size_t)row * 256 + 16 * gg + pp] = f2bf(ge);
    }
    __syncthreads();
  }
}

__global__ void __launch_bounds__(NTHR, 2) fwd_megakernel(P p) {
  __shared__ __attribute__((aligned(16))) char smem[SMEM_BYTES];
  cg::grid_group grid = cg::this_grid();
  char* ws = p.ws;
  float* XC = (float*)(ws + OFF_XC);
  u16* ABUF = (u16*)(ws + OFF_ABUF);
  const float* modv = (const float*)(ws + OFF_MODV);

  __shared__ uint4 xb_words;
  unsigned* barw = (unsigned*)(ws + OFF_BAR);
  if (threadIdx.x == 0) xb_words = make_uint4(0u, 0u, 0u, 0u);
  if (blockIdx.x == 0) { for (int i = threadIdx.x; i < XCD_BAR_WORDS; i += NTHR) barw[i] = 0u; }
  for (int dd = 0; dd < DUPN(3); ++dd) prologue(p, smem);
  grid.sync();
  XcdBarrier xb = xcd_barrier_post(barw, (volatile LAS unsigned*)&xb_words);

  float* PSN = (float*)(ws + OFF_PSN);
  float* SW1 = (float*)(ws + OFF_SW1);
  float* SW2 = (float*)(ws + OFF_SW2);
  norm_phase(p.x, p.ctx, p.g_norm1, modv, 0, 1, NTOK, ABUF, PSN);
  for (int l = 0; l < 4; ++l) {
    const int jj = l >> 1;
    if (l & 1) sw_items(modv + (size_t)l * 17 * 6144, (const u16*)(ws + OFF_OIN + jj * SZ_OIN), 2432, SW1 + (size_t)l * 17 * 2560, 2560);
    else sw_items(modv + (size_t)l * 17 * 6144, (const u16*)(ws + OFF_EIN + jj * SZ_EIN), 1536, SW1 + (size_t)l * 17 * 2560, 2560);
  }
  GSYNC();

  for (int layer = 0; layer < 4; ++layer) {
    const int j = layer >> 1;
    const bool need_ctx = layer < 3;
    const float* xs_lat = layer == 0 ? p.x : p.out;
    const float* xs_ctx = layer == 0 ? p.ctx : XC;
    const float* modl = modv + (size_t)layer * 17 * 6144;
    EpiArgs ea{};
    ea.j = j; ea.gate = modl + 2 * 1024; ea.src_lat = xs_lat; ea.src_ctx = xs_ctx; ea.dst_lat = p.out; ea.dst_ctx = XC;
    ea.sw = SW1 + (size_t)layer * 17 * 2560; ea.sw_stride = 2560;
    ea.ng = p.g_norm2 + layer * 1024; ea.nscale = modl + 4 * 1024; ea.xg_dst = (u16*)(ws + OFF_XG2);

    if ((layer & 1) == 0) {
      for (int dd = 0; dd < DUPN(0); ++dd) gemm_phase<EPI_EVEN_IN>(p, ABUF, (const u16*)(ws + OFF_EIN + j * SZ_EIN), 1024, 288, 12, 6, ea, smem);
      GSYNC();
      for (int dd = 0; dd < DUPN(2); ++dd) s5_pass1(p, j, smem);
      for (int dd = 0; dd < DUPN(1); ++dd) attn_phase<64, false>((const u16*)(ws + E_Q), (const u16*)(ws + E_K), (const u16*)(ws + E_VT), 12, 4, 0.125f, ABUF, 0, need_ctx, nullptr, smem);
      ff_convert(p, layer, smem);
      GSYNC();
      for (int dd = 0; dd < DUPN(2); ++dd) s5_pass2(p, j, smem);
      sw_items(modl + 3 * 1024, (const u16*)(ws + OFF_FF1), 4096, SW2 + (size_t)layer * 17 * 4096, 4096);
      GSYNC();
      for (int dd = 0; dd < DUPN(0); ++dd) gemm_phase<EPI_GLU>(p, (const u16*)(ws + E_YG), (const u16*)(ws + OFF_GLU + j * SZ_GLU), 256, 288, 2, 6, ea, smem);
      GSYNC();
    } else {
      for (int dd = 0; dd < DUPN(0); ++dd) gemm_phase<EPI_ODD_IN>(p, ABUF, (const u16*)(ws + OFF_OIN + j * SZ_OIN), 1024, 288, 19, 6, ea, smem);
      GSYNC();
      for (int dd = 0; dd < DUPN(0); ++dd) gemm_phase<EPI_UQ>(p, (const u16*)(ws + O_CQ), (const u16*)(ws + OFF_UQ + j * SZ_UQ), 512, 288, 8, 6, ea, smem);
      for (int dd = 0; dd < DUPN(0); ++dd) gemm_phase<EPI_UKV>(p, (const u16*)(ws + O_CKV), (const u16*)(ws + OFF_UKV + j * SZ_UKV), 256, 288, 8, 6, ea, smem);
      for (int dd = 0; dd < DUPN(1); ++dd) attn_phase<64, true>((const u16*)(ws + O_NQ), (const u16*)(ws + O_NK), (const u16*)(ws + O_NVT), 8, 8, 0.125f, ABUF, 512, need_ctx,
                           p.rpb + (size_t)j * 8 * 465, smem);
      ff_convert(p, layer, smem);
      GSYNC();
      for (int dd = 0; dd < DUPN(1); ++dd) attn_phase<96, false>((const u16*)(ws + O_MQ), (const u16*)(ws + O_MK), (const u16*)(ws + O_MVT), 8, 8, 0.10206207261596577f, ABUF, 0,
                            need_ctx, nullptr, smem);
      sw_items(modl + 3 * 1024, (const u16*)(ws + OFF_FF1), 4096, SW2 + (size_t)layer * 17 * 4096, 4096);
      GSYNC();
    }
    const int mt = need_ctx ? 288 : 256;
    const int band = need_ctx ? 6 : 8;
    gemm_phase<EPI_RESID>(p, ABUF, (const u16*)(ws + ((layer & 1) ? OFF_OOUT : OFF_EOUT) + j * SZ_SQ), 1024, mt, 8, band, ea, smem);
    GSYNC();
    ea.sw = SW2 + (size_t)layer * 17 * 4096; ea.sw_stride = 4096;
    for (int dd = 0; dd < DUPN(0); ++dd) gemm_phase<EPI_RELU2>(p, (const u16*)(ws + OFF_XG2), (const u16*)(ws + OFF_FF1), 1024, mt, 32, band, ea, smem);
    GSYNC();
    ea.gate = modl + 5 * 1024; ea.src_lat = p.out; ea.src_ctx = XC;
    ea.ng = layer < 3 ? p.g_norm1 + (layer + 1) * 1024 : nullptr; ea.xg_dst = ABUF;
    ea.nscale = modv + (size_t)(layer + 1) * 17 * 6144 + 1 * 1024;
    gemm_phase<EPI_RESID>(p, (const u16*)(ws + OFF_H), (const u16*)(ws + OFF_FF2), 4096, mt, 8, band, ea, smem);
    GSYNC();
  }
  if (GPROBE >= 0) {
    EpiArgs ed{}; ed.j = 0;
    gemm_phase<EPI_RELU2, (GPROBE < 0 ? 0 : GPROBE)>(p, (const u16*)(ws + OFF_ABUF), (const u16*)(ws + OFF_FF1), 1024, 288, 32, 6, ed, smem);
  }
}

extern "C" void kernel_launch(void* const* d_in, const int* in_sizes, int n_in, void* d_out, int out_size, void* d_ws, size_t ws_size,
                              hipStream_t stream) {
  static int grid_blocks = 0;
  if (!grid_blocks) {
    int dev = 0, cus = 0, per_cu = 0;
    hipGetDevice(&dev);
    hipDeviceGetAttribute(&cus, hipDeviceAttributeMultiprocessorCount, dev);
    hipOccupancyMaxActiveBlocksPerMultiprocessor(&per_cu, fwd_megakernel, NTHR, 0);
    if (per_cu > 2) per_cu = 2;
    if (per_cu < 1) per_cu = 1;
    grid_blocks = cus * per_cu;
    grid_blocks &= ~7;
  }
  P p{};
  const float** f = (const float**)&p;
  for (int i = 0; i < 35; ++i) f[i] = (const float*)d_in[i];
  p.out = (float*)d_out;
  p.ws = (char*)d_ws;
  void* args[] = {&p};
  hipError_t e = hipLaunchCooperativeKernel((void*)fwd_megakernel, dim3(grid_blocks), dim3(NTHR), args, 0, stream);
  if (e != hipSuccess) fprintf(stderr, "cooperative launch failed: %s (grid %d)\n", hipGetErrorString(e), grid_blocks);
}
```

```cpp
#include <hip/hip_runtime.h>
#include <hip/hip_cooperative_groups.h>
#include <cstdio>
namespace cg = cooperative_groups;

typedef unsigned short u16;
using bf16x8 = __attribute__((ext_vector_type(8))) short;
using f32x16 = __attribute__((ext_vector_type(16))) float;
using f32x4 = __attribute__((ext_vector_type(4))) float;
typedef __attribute__((ext_vector_type(2))) __bf16 bf2_t;
using u32x4 = __attribute__((ext_vector_type(4))) unsigned;
#define DI __device__ __forceinline__
#define MFMA32(a, b, c) __builtin_amdgcn_mfma_f32_32x32x16_bf16((a), (b), (c), 0, 0, 0)
#define MFMA16(a, b, c) __builtin_amdgcn_mfma_f32_16x16x32_bf16((a), (b), (c), 0, 0, 0)

#ifndef GPROBE
#define GPROBE -1
#endif
#ifndef DUP_MASK
#define DUP_MASK 0
#endif
#define DUPN(bit) (((DUP_MASK) >> (bit)) & 1 ? 2 : 1)
constexpr int NTHR = 256;
constexpr int NLAT = 32768, NTOK = 36864, SP = 2304;
constexpr float EPSF = 1e-6f;
constexpr float LOG2E = 1.4426950408889634f;
constexpr int SMEM_BYTES = 73728 + 512;
constexpr int CP = 132;

constexpr size_t SZ_EIN = 1536ull * 1024 * 2, SZ_SQ = 1024ull * 1024 * 2, SZ_OIN = 2432ull * 1024 * 2;
constexpr size_t SZ_UQ = 1024ull * 512 * 2, SZ_UKV = 1024ull * 256 * 2, SZ_GLU = 256ull * 256 * 2;
constexpr size_t OFF_EIN = 0;
constexpr size_t OFF_EOUT = OFF_EIN + 2 * SZ_EIN;
constexpr size_t OFF_OIN = OFF_EOUT + 2 * SZ_SQ;
constexpr size_t OFF_OOUT = OFF_OIN + 2 * SZ_OIN;
constexpr size_t OFF_UQ = OFF_OOUT + 2 * SZ_SQ;
constexpr size_t OFF_UKV = OFF_UQ + 2 * SZ_UQ;
constexpr size_t OFF_GLU = OFF_UKV + 2 * SZ_UKV;
constexpr size_t OFF_FF1 = OFF_GLU + 2 * SZ_GLU;
constexpr size_t OFF_FF2 = OFF_FF1 + 4096ull * 1024 * 2;
constexpr size_t OFF_MODV = OFF_FF2 + 4096ull * 1024 * 2;
constexpr size_t OFF_ROPE = OFF_MODV + 4ull * 17 * 6144 * 4;
constexpr size_t OFF_SA = OFF_ROPE + 16384;
constexpr size_t OFF_SAL = OFF_SA + 4096 * 8;
constexpr size_t OFF_SBB = OFF_SAL + 4096 * 8;
constexpr size_t OFF_BAR = OFF_SBB + 4096ull * 32 * 4;
constexpr size_t OFF_PSN = OFF_BAR + 16384;
constexpr size_t OFF_SW1 = OFF_PSN + 36864ull * 8 * 4;
constexpr size_t OFF_SW2 = OFF_SW1 + 4ull * 17 * 2560 * 4;
constexpr size_t OFF_XC = OFF_SW2 + 4ull * 17 * 4096 * 4;
constexpr size_t OFF_ABUF = OFF_XC + 4096ull * 1024 * 4;
constexpr size_t OFF_R1 = OFF_ABUF + (size_t)NTOK * 1024 * 2;
constexpr size_t E_Q = OFF_R1;
constexpr size_t E_K = E_Q + 16ull * 12 * SP * 64 * 2;
constexpr size_t E_VT = E_K + 16ull * 4 * SP * 64 * 2;
constexpr size_t E_U = E_VT + 16ull * 4 * SP * 64 * 2;
constexpr size_t E_E = E_U + (size_t)NTOK * 256 * 4;
constexpr size_t E_YG = E_E + 16ull * 16 * 2 * 36 * 64 * 8;
constexpr size_t O_CQ = OFF_R1;
constexpr size_t O_CKV = O_CQ + (size_t)NTOK * 512 * 2;
constexpr size_t O_KR = O_CKV + (size_t)NTOK * 256 * 2;
constexpr size_t O_PS = O_KR + (size_t)NTOK * 32 * 4;
constexpr size_t O_NQ = O_PS + (size_t)NTOK * 8 * 4;
constexpr size_t O_NK = O_NQ + 16ull * 8 * SP * 64 * 2;
constexpr size_t O_NVT = O_NK + 16ull * 8 * SP * 64 * 2;
constexpr size_t O_MQ = O_NVT + 16ull * 8 * SP * 64 * 2;
constexpr size_t O_MK = O_MQ + 16ull * 8 * SP * 96 * 2;
constexpr size_t O_MVT = O_MK + 16ull * 8 * SP * 96 * 2;
constexpr size_t O_END = O_MVT + 16ull * 8 * SP * 64 * 2;
constexpr size_t OFF_H = OFF_R1;
constexpr size_t OFF_XG2 = OFF_H + (size_t)NTOK * 4096 * 2;
constexpr size_t WS_END = OFF_XG2 + (size_t)NTOK * 1024 * 2;
static_assert(WS_END <= 536870912ull, "workspace map exceeds 512 MiB");

struct P {
  const float *x, *c, *ctx, *c_ctx, *w_mod, *b_mod, *g_norm1, *g_norm2, *w_ff1, *w_ff2;
  const float *e_w_in, *e_w_out, *e_g_q, *e_g_k, *lam_re, *lam_im, *log_dt, *b_re, *b_im, *c_re, *c_im, *ssm_d, *w_glu, *b_glu;
  const float *o_w_in, *o_w_out, *g_cq, *g_ckv, *w_uq, *w_ukv, *g_mq, *g_mk, *g_nq, *g_nk, *rpb;
  float* out;
  char* ws;
};

DI unsigned pack2(float a, float b) { bf2_t v; v[0] = (__bf16)a; v[1] = (__bf16)b; return __builtin_bit_cast(unsigned, v); }
DI u16 f2bf(float a) { __bf16 v = (__bf16)a; return __builtin_bit_cast(u16, v); }
DI float bf2f(u16 v) { return __uint_as_float(((unsigned)v) << 16); }
#define GSYNC() do { for (int dd_ = 0; dd_ < DUPN(4); ++dd_) xcd_barrier(xb); } while (0)
DI int otid() { int t = threadIdx.x; asm volatile("" : "+v"(t)); return t; }
DI int tok_row(int b, int pos) { return pos < 256 ? NLAT + b * 256 + pos : b * 2048 + pos - 256; }


#define XB_TMO      128
#define XB_XCNT(j)  (256  + 64 * (j))
#define XB_XSUB(j)  (1280 + 64 * (j))
#define XB_XGEN(j)  (2304 + 64 * (j))
#define XB_TOP      3328
#define XB_TOPGEN   3392
#define XCD_BAR_WORDS 3456
#define XB_SPIN_CAP (1u << 22)
#define LAS __attribute__((address_space(3)))
DI unsigned xb_ld(unsigned* p) { return __hip_atomic_load(p, __ATOMIC_RELAXED, __HIP_MEMORY_SCOPE_AGENT); }
DI unsigned xb_add(unsigned* p, unsigned v) { return __hip_atomic_fetch_add(p, v, __ATOMIC_RELAXED, __HIP_MEMORY_SCOPE_AGENT); }
DI unsigned xb_xcc_id() { return (unsigned)__builtin_amdgcn_s_getreg((3 << 11) | 20) & 0xFu; }
#define XB_SPIN(cond, bar) do { unsigned _sp = 0; while (cond) { __builtin_amdgcn_s_sleep(1); \
    if ((++_sp & 255u) == 0u) { if (xb_ld(&(bar)[XB_TMO])) break; if (_sp > XB_SPIN_CAP) { atomicAdd(&(bar)[XB_TMO], 1u); break; } } } } while (0)
struct XcdBarrier { unsigned* bar; unsigned x; volatile LAS unsigned* st; };
DI XcdBarrier xcd_barrier_post(unsigned* bar, volatile LAS unsigned* st) {
  XcdBarrier b; b.bar = bar; b.x = xb_xcc_id(); b.st = st;
  if (threadIdx.x == 0) (void)xb_add(&bar[XB_XCNT(b.x)], 1u);
  return b;
}
DI void xcd_barrier_complete(unsigned* bar, unsigned x, unsigned& nloc, unsigned& nx) {
  const unsigned G = gridDim.x * gridDim.y * gridDim.z;
  unsigned sum, cnt, mine, sp = 0u;
  for (;;) {
    sum = 0u; cnt = 0u; mine = 0u;
#pragma unroll
    for (unsigned j = 0; j < 16; ++j) { const unsigned c = xb_ld(&bar[XB_XCNT(j)]); sum += c; cnt += (c > 0u) ? 1u : 0u; mine = (j == x) ? c : mine; }
    if (sum == G) break;
    __builtin_amdgcn_s_sleep(1);
    if ((++sp & 255u) == 0u) { if (xb_ld(&bar[XB_TMO])) break; if (sp > XB_SPIN_CAP) { atomicAdd(&bar[XB_TMO], 1u); break; } }
  }
  nloc = mine > 0u ? mine : 1u; nx = cnt > 0u ? cnt : 1u;
}
DI void xcd_barrier(const XcdBarrier& b) {
  asm volatile("s_waitcnt vmcnt(0)" ::: "memory");
  __syncthreads();
  if (threadIdx.x == 0) {
    unsigned* bar = b.bar;
    __builtin_amdgcn_s_waitcnt(0);
    unsigned nloc = b.st[0], nx = b.st[1];
    if (nloc == 0u) { xcd_barrier_complete(bar, b.x, nloc, nx); b.st[0] = nloc; b.st[1] = nx; }
    const unsigned old = xb_add(&bar[XB_XSUB(b.x)], 1u);
    const unsigned gen = old / nloc;
    if (old + 1u == (gen + 1u) * nloc) {
      __builtin_amdgcn_fence(__ATOMIC_RELEASE, "agent");
      asm volatile("s_waitcnt vmcnt(0)" ::: "memory");
      const unsigned og = xb_add(&bar[XB_TOP], 1u);
      const unsigned tg = og / nx;
      if (og + 1u == (tg + 1u) * nx) xb_add(&bar[XB_TOPGEN], 1u);
      else XB_SPIN(xb_ld(&bar[XB_TOPGEN]) == tg, bar);
      __builtin_amdgcn_fence(__ATOMIC_ACQUIRE, "agent");
      xb_add(&bar[XB_XGEN(b.x)], 1u);
      asm volatile("s_waitcnt vmcnt(0)" ::: "memory");
    } else {
      XB_SPIN(xb_ld(&bar[XB_XGEN(b.x)]) == gen, bar);
      __builtin_amdgcn_fence(__ATOMIC_ACQUIRE, "agent");
      asm volatile("s_waitcnt vmcnt(0)" ::: "memory");
    }
  }
  __syncthreads();
}

DI int map_col(int mapk, int n, int N) {
  if (mapk == 0) return n < N ? n : -1;
  if (mapk == 1) { if (n < 768) return n; if (n < 2304) return n + 32; if (n < 2336) return n - 2304 + 768; return -1; }
  int h = n >> 7, jj = n & 127; return jj < 96 ? h * 96 + jj : -1;
}
DI void tr_tile(const float* __restrict__ src, int K, int N, int Npad, int mapk, const float* __restrict__ ks,
                        u16* __restrict__ dst, int tile, char* smem) {
  float* tl = (float*)smem;
  const int tid = otid();
  const int tnn = Npad >> 6;
  const int n0 = (tile % tnn) * 64, k0 = (tile / tnn) * 64;
  const int nn = tid & 63;
  const int sn = map_col(mapk, n0 + nn, N);
#pragma unroll 4
  for (int i = 0; i < 16; ++i) {
    int kk = (tid >> 6) + 4 * i;
    float v = 0.f;
    if (sn >= 0) { v = src[(size_t)(k0 + kk) * N + sn]; if (ks) v *= ks[k0 + kk]; }
    tl[kk * 65 + nn] = v;
  }
  __syncthreads();
#pragma unroll 4
  for (int i = 0; i < 16; ++i) {
    int n2 = (tid >> 6) + 4 * i, kk = tid & 63;
    dst[(size_t)(n0 + n2) * K + k0 + kk] = f2bf(tl[kk * 65 + n2]);
  }
  __syncthreads();
}

DI void ff_convert(const P& p, int layer, char* smem) {
  u16* f1 = (u16*)(p.ws + OFF_FF1);
  u16* f2 = (u16*)(p.ws + OFF_FF2);
  const float* s1 = p.w_ff1 + (size_t)layer * 1024 * 4096;
  const float* s2 = p.w_ff2 + (size_t)layer * 4096 * 1024;
  for (int t = gridDim.x - 1 - blockIdx.x; t < 2048; t += gridDim.x) {
    if (t < 1024) tr_tile(s1, 1024, 4096, 4096, 0, nullptr, f1, t, smem);
    else tr_tile(s2, 4096, 1024, 1024, 0, nullptr, f2, t - 1024, smem);
  }
}

DI void prologue(const P& p, char* smem) {
  const int tid = otid();
  float* modv = (float*)(p.ws + OFF_MODV);
  for (int it = blockIdx.x; it < 384; it += gridDim.x) {
    float* cond = (float*)smem;
    for (int idx = tid; idx < 17 * 1024; idx += NTHR) {
      int bb = idx >> 10, k = idx & 1023;
      float v = bb < 16 ? p.c[bb * 1024 + k] : p.c_ctx[k];
      cond[idx] = v / (1.f + __expf(-v));
    }
    __syncthreads();
    const int l = it / 96, n = (it % 96) * 64 + (tid & 63), kq = tid >> 6;
    float acc[17];
#pragma unroll
    for (int i = 0; i < 17; ++i) acc[i] = 0.f;
    const float* wp = p.w_mod + ((size_t)l * 1024 + kq * 256) * 6144 + n;
    for (int k4 = 0; k4 < 64; ++k4) {
      float w0 = wp[(size_t)(k4 * 4 + 0) * 6144], w1 = wp[(size_t)(k4 * 4 + 1) * 6144];
      float w2 = wp[(size_t)(k4 * 4 + 2) * 6144], w3 = wp[(size_t)(k4 * 4 + 3) * 6144];
#pragma unroll
      for (int bb = 0; bb < 17; ++bb) {
        float4 c4 = *(const float4*)(cond + bb * 1024 + kq * 256 + k4 * 4);
        acc[bb] += c4.x * w0 + c4.y * w1 + c4.z * w2 + c4.w * w3;
      }
    }
    __syncthreads();
    float* red = (float*)smem;
#pragma unroll
    for (int bb = 0; bb < 17; ++bb) red[(kq * 17 + bb) * 64 + (tid & 63)] = acc[bb];
    __syncthreads();
    for (int o = tid; o < 17 * 64; o += NTHR) {
      int bb = o >> 6, nn = o & 63;
      int ncol = (it % 96) * 64 + nn;
      float s = red[(0 * 17 + bb) * 64 + nn] + red[(1 * 17 + bb) * 64 + nn] + red[(2 * 17 + bb) * 64 + nn] + red[(3 * 17 + bb) * 64 + nn];
      modv[((size_t)l * 17 + bb) * 6144 + ncol] = s + p.b_mod[l * 6144 + ncol];
    }
    __syncthreads();
  }
  {
    float* rt = (float*)(p.ws + OFF_ROPE);
    for (int idx = blockIdx.x * NTHR + tid; idx < 1024 + 512; idx += gridDim.x * NTHR) {
      if (idx < 1024) {
        int pos = idx >> 4, i = idx & 15;
        float f = powf(10000.f, -(float)(2 * i) / 32.f);
        float a = (float)pos * f;
        rt[idx] = cosf(a); rt[1024 + idx] = sinf(a);
      } else {
        int q = idx - 1024; int pos = q >> 3, i = q & 7;
        float f = powf(10000.f, -(float)(2 * i) / 16.f);
        float a = (float)pos * f;
        rt[2048 + q] = cosf(a); rt[2560 + q] = sinf(a);
      }
    }
    float2* SA = (float2*)(p.ws + OFF_SA);
    float2* SAL = (float2*)(p.ws + OFF_SAL);
    float* SBB = (float*)(p.ws + OFF_SBB);
    for (int idx = blockIdx.x * NTHR + tid; idx < 4096; idx += gridDim.x * NTHR) {
      float lre = p.lam_re[idx], lim = p.lam_im[idx];
      float dt = expf(p.log_dt[idx >> 6]);
      float mag = expf(lre * dt);
      float are = mag * cosf(lim * dt), aim = mag * sinf(lim * dt);
      float den = lre * lre + lim * lim;
      float fre = ((are - 1.f) * lre + aim * lim) / den;
      float fim = (aim * lre - (are - 1.f) * lim) / den;
      SA[idx] = make_float2(are, aim);
      float pr = are, pi = aim;
#pragma unroll
      for (int q = 0; q < 6; ++q) { float nr = pr * pr - pi * pi, ni = 2.f * pr * pi; pr = nr; pi = ni; }
      SAL[idx] = make_float2(pr, pi);
#pragma unroll
      for (int q = 0; q < 16; ++q) {
        float br = p.b_re[(size_t)idx * 16 + q], bi = p.b_im[(size_t)idx * 16 + q];
        SBB[(size_t)idx * 32 + q] = fre * br - fim * bi;
        SBB[(size_t)idx * 32 + 16 + q] = fre * bi + fim * br;
      }
    }
  }
  for (int t = gridDim.x - 1 - blockIdx.x; t < 3424; t += gridDim.x) {
    int j = t / 1712, r = t % 1712;
    if (r < 384) tr_tile(p.e_w_in + (size_t)j * 1024 * 1536, 1024, 1536, 1536, 0, nullptr, (u16*)(p.ws + OFF_EIN + j * SZ_EIN), r, smem);
    else if (r < 640) tr_tile(p.e_w_out + (size_t)j * 1024 * 1024, 1024, 1024, 1024, 0, nullptr, (u16*)(p.ws + OFF_EOUT + j * SZ_SQ), r - 384, smem);
    else if (r < 1248) tr_tile(p.o_w_in + (size_t)j * 1024 * 2336, 1024, 2336, 2432, 1, nullptr, (u16*)(p.ws + OFF_OIN + j * SZ_OIN), r - 640, smem);
    else if (r < 1504) tr_tile(p.o_w_out + (size_t)j * 1024 * 1024, 1024, 1024, 1024, 0, nullptr, (u16*)(p.ws + OFF_OOUT + j * SZ_SQ), r - 1248, smem);
    else if (r < 1632) tr_tile(p.w_uq + (size_t)j * 512 * 768, 512, 768, 1024, 2, p.g_cq + j * 512, (u16*)(p.ws + OFF_UQ + j * SZ_UQ), r - 1504, smem);
    else if (r < 1696) tr_tile(p.w_ukv + (size_t)j * 256 * 1024, 256, 1024, 1024, 0, p.g_ckv + j * 256, (u16*)(p.ws + OFF_UKV + j * SZ_UKV), r - 1632, smem);
    else tr_tile(p.w_glu + (size_t)j * 256 * 256, 256, 256, 256, 0, nullptr, (u16*)(p.ws + OFF_GLU + j * SZ_GLU), r - 1696, smem);
  }
}

DI void norm_phase(const float* __restrict__ xl, const float* __restrict__ xc, const float* __restrict__ g,
                           const float* __restrict__ modl, int shift_i, int scale_i, int nrows, u16* __restrict__ dst, float* __restrict__ psn) {
  const int tid_ = otid();
  const int lane = tid_ & 63;
  const int gw = blockIdx.x * 4 + (tid_ >> 6);
  for (int R = gw; R < nrows; R += gridDim.x * 4) {
    const float* src = R < NLAT ? xl + (size_t)R * 1024 : xc + (size_t)(R - NLAT) * 1024;
    const int mrow = R < NLAT ? (R >> 11) : 16;
    float4 v[4];
    float ss = 0.f;
#pragma unroll
    for (int i = 0; i < 4; ++i) {
      v[i] = *(const float4*)(src + lane * 4 + 256 * i);
      ss += v[i].x * v[i].x + v[i].y * v[i].y + v[i].z * v[i].z + v[i].w * v[i].w;
    }
#pragma unroll
    for (int o = 32; o >= 1; o >>= 1) ss += __shfl_xor(ss, o);
    if (lane < 8) psn[(size_t)R * 8 + lane] = lane == 0 ? ss : 0.f;
    const float* sc = modl + (size_t)mrow * 6144 + scale_i * 1024;
#pragma unroll
    for (int i = 0; i < 4; ++i) {
      int col = lane * 4 + 256 * i;
      float4 gg = *(const float4*)(g + col), c4 = *(const float4*)(sc + col);
      float y0 = v[i].x * gg.x * (1.f + c4.x);
      float y1 = v[i].y * gg.y * (1.f + c4.y);
      float y2 = v[i].z * gg.z * (1.f + c4.z);
      float y3 = v[i].w * gg.w * (1.f + c4.w);
      uint2 o2; o2.x = pack2(y0, y1); o2.y = pack2(y2, y3);
      *(uint2*)(dst + (size_t)R * 1024 + col) = o2;
    }
  }
}

DI void sw_items(const float* __restrict__ shift, const u16* __restrict__ Wt, int N, float* __restrict__ out, int ostride) {
  const int tid_ = otid();
  const int lane = tid_ & 63;
  const int gw = blockIdx.x * 4 + (tid_ >> 6);
  for (int n = gw; n < N; n += gridDim.x * 4) {
    const uint4 w0 = *(const uint4*)(Wt + (size_t)n * 1024 + lane * 16);
    const uint4 w1 = *(const uint4*)(Wt + (size_t)n * 1024 + lane * 16 + 8);
    float wf[16];
    wf[0] = __uint_as_float(w0.x << 16); wf[1] = __uint_as_float(w0.x & 0xffff0000u);
    wf[2] = __uint_as_float(w0.y << 16); wf[3] = __uint_as_float(w0.y & 0xffff0000u);
    wf[4] = __uint_as_float(w0.z << 16); wf[5] = __uint_as_float(w0.z & 0xffff0000u);
    wf[6] = __uint_as_float(w0.w << 16); wf[7] = __uint_as_float(w0.w & 0xffff0000u);
    wf[8] = __uint_as_float(w1.x << 16); wf[9] = __uint_as_float(w1.x & 0xffff0000u);
    wf[10] = __uint_as_float(w1.y << 16); wf[11] = __uint_as_float(w1.y & 0xffff0000u);
    wf[12] = __uint_as_float(w1.z << 16); wf[13] = __uint_as_float(w1.z & 0xffff0000u);
    wf[14] = __uint_as_float(w1.w << 16); wf[15] = __uint_as_float(w1.w & 0xffff0000u);
#pragma unroll 1
    for (int bb = 0; bb < 17; ++bb) {
      const float* sp = shift + (size_t)bb * 6144 + lane * 16;
      float acc = 0.f;
#pragma unroll
      for (int q = 0; q < 4; ++q) {
        float4 t = *(const float4*)(sp + 4 * q);
        acc += t.x * wf[4 * q] + t.y * wf[4 * q + 1] + t.z * wf[4 * q + 2] + t.w * wf[4 * q + 3];
      }
#pragma unroll
      for (int o = 32; o >= 1; o >>= 1) acc += __shfl_xor(acc, o);
      if (lane == 0) out[(size_t)bb * ostride + n] = acc;
    }
  }
}

enum { EPI_EVEN_IN = 0, EPI_ODD_IN, EPI_UQ, EPI_UKV, EPI_GLU, EPI_RESID, EPI_RELU2 };

struct EpiArgs {
  int j;
  const float* gate;
  const float* src_lat; const float* src_ctx; float* dst_lat; float* dst_ctx;
  const float* sw; int sw_stride;
  u16* xg_dst;
  const float* ng; const float* nscale;
};

DI void store16(u16* dst, const float* y) {
  uint4 a, b;
  a.x = pack2(y[0], y[1]); a.y = pack2(y[2], y[3]); a.z = pack2(y[4], y[5]); a.w = pack2(y[6], y[7]);
  b.x = pack2(y[8], y[9]); b.y = pack2(y[10], y[11]); b.z = pack2(y[12], y[13]); b.w = pack2(y[14], y[15]);
  *(uint4*)dst = a; *(uint4*)(dst + 8) = b;
}
DI void load16(const float* s, float* v) {
#pragma unroll
  for (int q = 0; q < 4; ++q) { float4 t = *(const float4*)(s + 4 * q); v[4 * q] = t.x; v[4 * q + 1] = t.y; v[4 * q + 2] = t.z; v[4 * q + 3] = t.w; }
}

DI void epi_head64(const P& p, const float* Cs, int b, int pos0, bool isctx, const float* __restrict__ g, bool rope,
                   u16* __restrict__ dstbase, int H, int head0) {
  const int tid = otid(), sub = tid & 7, hh = sub >> 2, jq = sub & 3;
  const float* rt = (const float*)(p.ws + OFF_ROPE);
#pragma unroll 1
  for (int pass = 0; pass < 4; ++pass) {
    const int row = pass * 32 + (tid >> 3);
    float v[16], pv[16];
    load16(Cs + row * CP + 16 * sub, v);
    float ss = 0.f;
#pragma unroll
    for (int i = 0; i < 16; ++i) ss += v[i] * v[i];
    ss += __shfl_xor(ss, 1); ss += __shfl_xor(ss, 2);
    const float rs = rsqrtf(ss * (1.f / 64.f) + EPSF);
#pragma unroll
    for (int i = 0; i < 16; ++i) v[i] = v[i] * rs * g[16 * jq + i];
    const int pos = pos0 + row;
    if (rope && !isctx) {
      load16(Cs + row * CP + 16 * (sub ^ 1), pv);
      const int lp = pos - 256;
      const int ti = (jq < 2) ? (lp >> 6) : (lp & 63);
      const float sgn = (jq & 1) ? 1.f : -1.f;
#pragma unroll
      for (int i = 0; i < 16; ++i) {
        float pn = pv[i] * rs * g[16 * (jq ^ 1) + i];
        float cs = rt[ti * 16 + i], sn = rt[1024 + ti * 16 + i];
        v[i] = v[i] * cs + sgn * pn * sn;
      }
    }
    store16(dstbase + (((size_t)b * H + head0 + hh) * SP + pos) * 64 + 16 * jq, v);
  }
}

DI void epi_vt(const float* Cs, int b, int pos0, u16* __restrict__ dstbase, int H, int head0, int c0, int ncols, float mul_unused) {
  const int tid = otid();
  const int cl = tid % ncols, tg = tid / ncols, ngrp = NTHR / ncols;
  const int col = c0 + cl;
  const int head = head0 + (cl >> 6), d = cl & 63;
  u16* drow = dstbase + (((size_t)b * H + head) * 64 + d) * SP + pos0;
  for (int tk = tg; tk < 16; tk += ngrp) {
    float y[8];
#pragma unroll
    for (int e = 0; e < 8; ++e) y[e] = Cs[(tk * 8 + e) * CP + col];
    uint4 a; a.x = pack2(y[0], y[1]); a.y = pack2(y[2], y[3]); a.z = pack2(y[4], y[5]); a.w = pack2(y[6], y[7]);
    *(uint4*)(drow + tk * 8) = a;
  }
}

template <int EPI>
DI void epilogue(const P& p, const EpiArgs& ea, float* Cs, int mtile, int ntile) {
  const int tid = otid();
  const int m0 = mtile * 128, n0 = ntile * 128;
  const bool isctx = m0 >= NLAT;
  const int b = isctx ? ((m0 - NLAT) >> 8) : (m0 >> 11);
  const int pos0 = isctx ? ((m0 - NLAT) & 255) : 256 + (m0 & 2047);
  const int mrow = isctx ? 16 : b;
  char* ws = p.ws;
  if (EPI == EPI_RESID) {
    const int c4 = (tid & 31) * 4;
    const int n = n0 + c4;
    const int R0 = m0 + (tid >> 5);
    const float* src = (isctx ? ea.src_ctx + (size_t)(R0 - NLAT) * 1024 : ea.src_lat + (size_t)R0 * 1024) + n;
    float* dst = (isctx ? ea.dst_ctx + (size_t)(R0 - NLAT) * 1024 : ea.dst_lat + (size_t)R0 * 1024) + n;
    const float4 gv = *(const float4*)(ea.gate + (size_t)mrow * 6144 + n);
    float4 gmv = make_float4(0.f, 0.f, 0.f, 0.f);
    if (ea.ng) {
      float4 g4 = *(const float4*)(ea.ng + n), s4 = *(const float4*)(ea.nscale + (size_t)mrow * 6144 + n);
      gmv.x = g4.x * (1.f + s4.x); gmv.y = g4.y * (1.f + s4.y); gmv.z = g4.z * (1.f + s4.z); gmv.w = g4.w * (1.f + s4.w);
    }
    float4 xv[16];
#pragma unroll
    for (int pass = 0; pass < 16; ++pass) xv[pass] = *(const float4*)(src + (size_t)pass * 8 * 1024);
#pragma unroll
    for (int pass = 0; pass < 16; ++pass) {
      const int row = pass * 8 + (tid >> 5);
      float4 a = *(const float4*)(Cs + row * CP + c4);
      float4 o; o.x = xv[pass].x + gv.x * a.x; o.y = xv[pass].y + gv.y * a.y; o.z = xv[pass].z + gv.z * a.z; o.w = xv[pass].w + gv.w * a.w;
      *(float4*)(dst + (size_t)pass * 8 * 1024) = o;
      if (ea.ng) {
        float ss = o.x * o.x + o.y * o.y + o.z * o.z + o.w * o.w;
#pragma unroll
        for (int q = 16; q >= 1; q >>= 1) ss += __shfl_xor(ss, q);
        const int R = m0 + row;
        if ((tid & 31) == 0) ((float*)(ws + OFF_PSN))[(size_t)R * 8 + ntile] = ss;
        uint2 xo; xo.x = pack2(o.x * gmv.x, o.y * gmv.y); xo.y = pack2(o.z * gmv.z, o.w * gmv.w);
        *(uint2*)(ea.xg_dst + (size_t)R * 1024 + n) = xo;
      }
    }
  } else if (EPI == EPI_RELU2 || EPI == EPI_GLU) {
    const int c4 = (tid & 31) * 4;
    const int n = n0 + c4;
#pragma unroll 4
    for (int pass = 0; pass < 16; ++pass) {
      const int row = pass * 8 + (tid >> 5);
      const int R = m0 + row;
      float4 a = *(const float4*)(Cs + row * CP + c4);
      if (EPI == EPI_RELU2) {
        float r0 = fmaxf(a.x, 0.f), r1 = fmaxf(a.y, 0.f), r2 = fmaxf(a.z, 0.f), r3 = fmaxf(a.w, 0.f);
        uint2 o; o.x = pack2(r0 * r0, r1 * r1); o.y = pack2(r2 * r2, r3 * r3);
        *(uint2*)((u16*)(ws + OFF_H) + (size_t)R * 4096 + n) = o;
      } else {
        const u16* yg = (const u16*)(ws + E_YG) + (size_t)R * 256 + n;
        uint2 yv = *(const uint2*)yg;
        float4 bg = *(const float4*)(p.b_glu + ea.j * 256 + n);
        float y0 = __uint_as_float(yv.x << 16), y1 = __uint_as_float(yv.x & 0xffff0000u);
        float y2 = __uint_as_float(yv.y << 16), y3 = __uint_as_float(yv.y & 0xffff0000u);
        float o0 = y0 / (1.f + __expf(-(a.x + bg.x))), o1 = y1 / (1.f + __expf(-(a.y + bg.y)));
        float o2 = y2 / (1.f + __expf(-(a.z + bg.z))), o3 = y3 / (1.f + __expf(-(a.w + bg.w)));
        uint2 o; o.x = pack2(o0, o1); o.y = pack2(o2, o3);
        *(uint2*)((u16*)(ws + OFF_ABUF) + (size_t)R * 1024 + 768 + n) = o;
      }
    }
  } else if (EPI == EPI_EVEN_IN) {
    if (ntile < 6) epi_head64(p, Cs, b, pos0, isctx, p.e_g_q + ea.j * 64, true, (u16*)(ws + E_Q), 12, ntile * 2);
    else if (ntile < 8) epi_head64(p, Cs, b, pos0, isctx, p.e_g_k + ea.j * 64, true, (u16*)(ws + E_K), 4, (ntile - 6) * 2);
    else if (ntile < 10) epi_vt(Cs, b, pos0, (u16*)(ws + E_VT), 4, (ntile - 8) * 2, 0, 128, 1.f);
    else {
      const int c4 = (tid & 31) * 4;
      float* U = (float*)(ws + E_U);
      for (int pass = 0; pass < 16; ++pass) {
        const int row = pass * 8 + (tid >> 5);
        *(float4*)(U + (size_t)(m0 + row) * 256 + (ntile - 10) * 128 + c4) = *(const float4*)(Cs + row * CP + c4);
      }
    }
  } else if (EPI == EPI_ODD_IN) {
    if (ntile < 6) {
      const int c4 = (tid & 31) * 4;
      float* PS = (float*)(ws + O_PS);
      for (int pass = 0; pass < 16; ++pass) {
        const int row = pass * 8 + (tid >> 5);
        const int R = m0 + row;
        float4 a = *(const float4*)(Cs + row * CP + c4);
        float ss = a.x * a.x + a.y * a.y + a.z * a.z + a.w * a.w;
#pragma unroll
        for (int o = 16; o >= 1; o >>= 1) ss += __shfl_xor(ss, o);
        if ((tid & 31) == 0) PS[(size_t)R * 8 + ntile] = ss;
        uint2 o; o.x = pack2(a.x, a.y); o.y = pack2(a.z, a.w);
        if (ntile < 4) *(uint2*)((u16*)(ws + O_CQ) + (size_t)R * 512 + n0 + c4) = o;
        else *(uint2*)((u16*)(ws + O_CKV) + (size_t)R * 256 + (n0 - 512) + c4) = o;
      }
    } else if (ntile < 10) epi_head64(p, Cs, b, pos0, isctx, p.g_nq + ea.j * 64, false, (u16*)(ws + O_NQ), 8, (ntile - 6) * 2);
    else if (ntile < 14) epi_head64(p, Cs, b, pos0, isctx, p.g_nk + ea.j * 64, false, (u16*)(ws + O_NK), 8, (ntile - 10) * 2);
    else if (ntile < 18) epi_vt(Cs, b, pos0, (u16*)(ws + O_NVT), 8, (ntile - 14) * 2, 0, 128, 1.f);
    else {
      float* KR = (float*)(ws + O_KR);
      const int c4 = (tid & 7) * 4;
      for (int pass = 0; pass < 4; ++pass) {
        const int row = pass * 32 + (tid >> 3);
        *(float4*)(KR + (size_t)(m0 + row) * 32 + c4) = *(const float4*)(Cs + row * CP + c4);
      }
    }
  } else if (EPI == EPI_UQ || EPI == EPI_UKV) {
    const int sub = tid & 7;
    const float* PS = (const float*)(ws + O_PS);
    const float* rt = (const float*)(ws + OFF_ROPE);
    const float* gm = (EPI == EPI_UQ ? p.g_mq : p.g_mk) + ea.j * 96;
    u16* dstb = (u16*)(ws + (EPI == EPI_UQ ? O_MQ : O_MK));
    const float* KR = (const float*)(ws + O_KR);
#pragma unroll 1
    for (int pass = 0; pass < 4; ++pass) {
      const int row = pass * 32 + (tid >> 3);
      const int R = m0 + row;
      float rstd;
      if (EPI == EPI_UQ) {
        float4 ps = *(const float4*)(PS + (size_t)R * 8);
        rstd = rsqrtf((ps.x + ps.y + ps.z + ps.w) * (1.f / 512.f) + EPSF);
      } else {
        float2 ps = *(const float2*)(PS + (size_t)R * 8 + 4);
        rstd = rsqrtf((ps.x + ps.y) * (1.f / 256.f) + EPSF);
      }
      float v[16];
      if (EPI == EPI_UQ) {
        load16(Cs + row * CP + 16 * sub, v);
#pragma unroll
        for (int i = 0; i < 16; ++i) v[i] *= rstd;
      } else {
        if (sub < 4) {
          load16(Cs + row * CP + 16 * sub, v);
#pragma unroll
          for (int i = 0; i < 16; ++i) v[i] *= rstd;
        } else if (sub < 6) {
          load16(KR + (size_t)R * 32 + 16 * (sub - 4), v);
        } else {
#pragma unroll
          for (int i = 0; i < 16; ++i) v[i] = 0.f;
        }
      }
      float ss = 0.f;
#pragma unroll
      for (int i = 0; i < 16; ++i) ss += v[i] * v[i];
      ss += __shfl_xor(ss, 1); ss += __shfl_xor(ss, 2); ss += __shfl_xor(ss, 4);
      const float rs = rsqrtf(ss * (1.f / 96.f) + EPSF);
      if (sub < 6) {
#pragma unroll
        for (int i = 0; i < 16; ++i) v[i] = v[i] * rs * gm[16 * sub + i];
        const int pos = pos0 + row;
        if (sub >= 4 && !isctx) {
          const int lp = pos - 256;
          const int ti = (sub == 4) ? (lp >> 6) : (lp & 63);
#pragma unroll
          for (int i = 0; i < 8; ++i) {
            float cs = rt[2048 + ti * 8 + i], sn = rt[2560 + ti * 8 + i];
            float x1 = v[i], x2 = v[i + 8];
            v[i] = x1 * cs - x2 * sn;
            v[i + 8] = x2 * cs + x1 * sn;
          }
        }
        store16(dstb + (((size_t)b * 8 + ntile) * SP + pos) * 96 + 16 * sub, v);
      }
    }
    if (EPI == EPI_UKV) {
      const int cl = tid & 63, tg = tid >> 6;
      u16* drow = (u16*)(ws + O_MVT) + (((size_t)b * 8 + ntile) * 64 + cl) * SP + pos0;
      for (int tk = tg; tk < 16; tk += 4) {
        float y[8];
#pragma unroll
        for (int e = 0; e < 8; ++e) {
          const int R = m0 + tk * 8 + e;
          float2 ps = *(const float2*)(PS + (size_t)R * 8 + 4);
          float rstd = rsqrtf((ps.x + ps.y) * (1.f / 256.f) + EPSF);
          y[e] = Cs[(tk * 8 + e) * CP + 64 + cl] * rstd;
        }
        uint4 a; a.x = pack2(y[0], y[1]); a.y = pack2(y[2], y[3]); a.z = pack2(y[4], y[5]); a.w = pack2(y[6], y[7]);
        *(uint4*)(drow + tk * 8) = a;
      }
    }
  }
}

template <int EPI, int PROBE = 0>
DI void gemm_phase(const P& p, const u16* __restrict__ A, const u16* __restrict__ Bt, int K, int mt, int ntn, int band,
                           const EpiArgs& ea, char* smem) {
  const int tid = otid(), lane = tid & 63, w = tid >> 6, wm = w >> 1, wn = w & 1, r = lane & 31, h = lane >> 5;
  u16* As = (u16*)smem;
  u16* Bs = As + 2 * 9216;
  float* Cs = (float*)smem;
  const int total = mt * ntn;
  const int mper = mt >> 3;
  const int nk = K >> 6;
  const int lrow = tid >> 3, lkc = (tid & 7) * 8;
  for (int t = blockIdx.x; t < total; t += gridDim.x) {
    const int xcd = t & 7, L = t >> 3;
    const int bandsz = band * ntn;
    const int bi = L / bandsz, rr = L - bi * bandsz;
    const int full = (ntn >> 3) * (band * 8);
    int mi_, ni_;
    if (rr < full) { int ch = rr / (band * 8); int wv = rr - ch * (band * 8); mi_ = wv % band; ni_ = ch * 8 + wv / band; }
    else { int r2 = rr - full; mi_ = r2 % band; ni_ = (ntn >> 3) * 8 + r2 / band; }
    const int mtile = xcd * mper + bi * band + mi_;
    const int ntile = ni_;
    constexpr bool AFF = (EPI == EPI_EVEN_IN || EPI == EPI_ODD_IN || EPI == EPI_RELU2);
    float* rsb = (float*)(smem + 73728);
    if (AFF && tid < 128) {
      const float* ps = (const float*)(p.ws + OFF_PSN) + (size_t)(mtile * 128 + tid) * 8;
      float4 p0 = *(const float4*)ps, p1 = *(const float4*)(ps + 4);
      rsb[tid] = rsqrtf((p0.x + p0.y + p0.z + p0.w + p1.x + p1.y + p1.z + p1.w) * (1.f / 1024.f) + EPSF);
    }
    const u16* Ag = A + (size_t)(mtile * 128 + lrow) * K + lkc;
    const u16* Bg = Bt + (size_t)(ntile * 128 + lrow) * K + lkc;
    f32x16 acc[2][2];
#pragma unroll
    for (int a = 0; a < 2; ++a)
#pragma unroll
      for (int c = 0; c < 2; ++c)
#pragma unroll
        for (int i = 0; i < 16; ++i) acc[a][c][i] = 0.f;
    uint4 ra0_0, ra0_1, ra0_2, ra0_3, rb0_0, rb0_1, rb0_2, rb0_3, ra1_0, ra1_1, ra1_2, ra1_3, rb1_0, rb1_1, rb1_2, rb1_3;
#define G_LD1(S, i, kt_) ra##S##_##i = *(const uint4*)(Ag + (size_t)(32 * i) * K + (kt_) * 64); rb##S##_##i = *(const uint4*)(Bg + (size_t)(32 * i) * K + (kt_) * 64);
#define G_LOAD(S, kt_) { G_LD1(S, 0, kt_) G_LD1(S, 1, kt_) G_LD1(S, 2, kt_) G_LD1(S, 3, kt_) }
#define L_ST1(S, i, buf_) *(uint4*)(As + (buf_) * 9216 + (lrow + 32 * i) * 72 + lkc) = ra##S##_##i; *(uint4*)(Bs + (buf_) * 9216 + (lrow + 32 * i) * 72 + lkc) = rb##S##_##i;
#define L_STORE(S, buf_) { L_ST1(S, 0, buf_) L_ST1(S, 1, buf_) L_ST1(S, 2, buf_) L_ST1(S, 3, buf_) }
#define G_COMPUTE(buf_) { \
      const u16* as = As + (buf_) * 9216 + (wm * 64 + r) * 72 + h * 8; \
      const u16* bs = Bs + (buf_) * 9216 + (wn * 64 + r) * 72 + h * 8; \
      _Pragma("unroll") for (int kk = 0; kk < 4; ++kk) { \
        bf16x8 a0 = *(const bf16x8*)(as + kk * 16), a1 = *(const bf16x8*)(as + 32 * 72 + kk * 16); \
        bf16x8 b0 = *(const bf16x8*)(bs + kk * 16), b1 = *(const bf16x8*)(bs + 32 * 72 + kk * 16); \
        acc[0][0] = MFMA32(a0, b0, acc[0][0]); acc[0][1] = MFMA32(a0, b1, acc[0][1]); \
        acc[1][0] = MFMA32(a1, b0, acc[1][0]); acc[1][1] = MFMA32(a1, b1, acc[1][1]); } }
#define LDFRAG(P_, kk) P_##a0 = *(const bf16x8*)(as_ + (kk) * 16); P_##a1 = *(const bf16x8*)(as_ + 32 * 72 + (kk) * 16); \
                       P_##b0 = *(const bf16x8*)(bs_ + (kk) * 16); P_##b1 = *(const bf16x8*)(bs_ + 32 * 72 + (kk) * 16);
#define MFMA4(P_) acc[0][0] = MFMA32(P_##a0, P_##b0, acc[0][0]); acc[0][1] = MFMA32(P_##a0, P_##b1, acc[0][1]); \
                  acc[1][0] = MFMA32(P_##a1, P_##b0, acc[1][0]); acc[1][1] = MFMA32(P_##a1, P_##b1, acc[1][1]);
#define G_PIPE(buf_, SNEXT, nbuf_, dost_) { \
      const u16* as_ = As + (buf_) * 9216 + (wm * 64 + r) * 72 + h * 8; \
      const u16* bs_ = Bs + (buf_) * 9216 + (wn * 64 + r) * 72 + h * 8; \
      bf16x8 f_a0, f_a1, f_b0, f_b1, g_a0, g_a1, g_b0, g_b1; \
      LDFRAG(f_, 0) \
      LDFRAG(g_, 1) \
      __builtin_amdgcn_sched_barrier(0); \
      MFMA4(f_) if (dost_) { L_ST1(SNEXT, 0, nbuf_) } \
      __builtin_amdgcn_sched_barrier(0); \
      LDFRAG(f_, 2) \
      MFMA4(g_) if (dost_) { L_ST1(SNEXT, 1, nbuf_) } \
      __builtin_amdgcn_sched_barrier(0); \
      LDFRAG(g_, 3) \
      MFMA4(f_) if (dost_) { L_ST1(SNEXT, 2, nbuf_) } \
      __builtin_amdgcn_sched_barrier(0); \
      MFMA4(g_) if (dost_) { L_ST1(SNEXT, 3, nbuf_) } }
#define G_COMPUTE_NOLDS() { \
      _Pragma("unroll") for (int kk = 0; kk < 4; ++kk) { \
        acc[0][0] = MFMA32(pa0, pb0, acc[0][0]); acc[0][1] = MFMA32(pa0, pb1, acc[0][1]); \
        acc[1][0] = MFMA32(pa1, pb0, acc[1][0]); acc[1][1] = MFMA32(pa1, pb1, acc[1][1]); } }
    bf16x8 pa0 = *(const bf16x8*)(As + r * 72 + h * 8), pa1 = *(const bf16x8*)(As + (32 + r) * 72 + h * 8);
    bf16x8 pb0 = *(const bf16x8*)(Bs + r * 72 + h * 8), pb1 = *(const bf16x8*)(Bs + (32 + r) * 72 + h * 8);
    (void)pa0; (void)pa1; (void)pb0; (void)pb1;
    G_LOAD(0, 0);
    G_LOAD(1, 1);
    L_STORE(0, 0);
    __syncthreads();
    for (int kt = 0; kt < nk; kt += 2) {
      if (kt + 2 < nk) { G_LOAD(0, kt + 2); }
      { G_PIPE(0, 1, 1, true) }
      __syncthreads();
      if (kt + 3 < nk) { G_LOAD(1, kt + 3); }
      { const bool st_ = kt + 2 < nk; G_PIPE(1, 0, 0, st_) }
      __syncthreads();
    }
    if (AFF) {
      const int mrow_ = (mtile * 128 >= NLAT) ? 16 : ((mtile * 128) >> 11);
#pragma unroll
      for (int c = 0; c < 2; ++c) {
        const float swc = ea.sw[(size_t)mrow_ * ea.sw_stride + ntile * 128 + wn * 64 + c * 32 + r];
#pragma unroll
        for (int a = 0; a < 2; ++a)
#pragma unroll
          for (int i = 0; i < 16; ++i) {
            const int row = wm * 64 + a * 32 + (i & 3) + 8 * (i >> 2) + 4 * h;
            Cs[row * CP + wn * 64 + c * 32 + r] = acc[a][c][i] * rsb[row] + swc;
          }
      }
    } else {
#pragma unroll
      for (int a = 0; a < 2; ++a)
#pragma unroll
        for (int c = 0; c < 2; ++c)
#pragma unroll
          for (int i = 0; i < 16; ++i)
            Cs[(wm * 64 + a * 32 + (i & 3) + 8 * (i >> 2) + 4 * h) * CP + wn * 64 + c * 32 + r] = acc[a][c][i];
    }
    __syncthreads();
    epilogue<EPI>(p, ea, Cs, mtile, ntile);
    __syncthreads();
  }
}

template <int DQK, bool NA>
DI void attn_phase(const u16* __restrict__ Q, const u16* __restrict__ Kb, const u16* __restrict__ Vt, int HQ, int HK,
                           float scale, u16* __restrict__ mix, int coloff, bool do_ctx, const float* __restrict__ rpb, char* smem) {
  constexpr int KP = DQK + 8;
  constexpr int NKK = DQK / 16;
  constexpr int KCH = DQK / 32;
  const int tid = otid(), lane = tid & 63, w = tid >> 6, r = lane & 31, h = lane >> 5;
  constexpr int STG = 64 * KP * 2 + 64 * 72 * 2;
  float* rpbs = (float*)(smem + 2 * STG);
  const int grp_heads = HQ / HK;
  const int nqb = 16 + (do_ctx ? 2 : 0);
  const int upg = grp_heads * nqb;
  const int total = 16 * HK * upg;
  const float sl2 = scale * LOG2E;
  for (int u = blockIdx.x; u < total; u += gridDim.x) {
    const int xcd = u & 7, L = u >> 3;
    const int grp = (L / upg) * 8 + xcd, wi = L % upg;
    const int b = grp / HK, hk = grp % HK;
    const int hq = hk * grp_heads + wi / nqb, qb = wi % nqb;
    const bool lat = qb < 16;
    const int qpos0 = lat ? 256 + 128 * qb : 128 * (qb - 16);
    int ntiles = lat ? 36 : 4;
    int rs0 = 0, rw = 0, rsw = 0;
    if (NA && lat) {
      int r0 = 2 * qb;
      rs0 = min(max(r0 - 4, 0), 24);
      int rs1 = min(max(r0 + 1 - 4, 0), 24);
      ntiles = 4 + (rs1 + 8 - rs0);
      rw = r0 + (w >> 1);
      rsw = min(max(rw - 4, 0), 24);
    }
    const int qpos = qpos0 + w * 32 + r;
    bf16x8 qf[NKK];
    {
      const u16* qp = Q + (((size_t)b * HQ + hq) * SP + qpos) * DQK + 8 * h;
#pragma unroll
      for (int kk = 0; kk < NKK; ++kk) qf[kk] = *(const bf16x8*)(qp + 16 * kk);
    }
    f32x16 o0, o1;
#pragma unroll
    for (int i = 0; i < 16; ++i) { o0[i] = 0.f; o1[i] = 0.f; }
    float m = -1e30f, l = 0.f;
    const u16* kbase = Kb + ((size_t)b * HK + hk) * SP * DQK;
    const u16* vbase = Vt + ((size_t)b * HK + hk) * 64 * SP;
    uint4 rk0, rk1, rk2 = make_uint4(0, 0, 0, 0), rv0, rv1;
#define KPOS_OF(i) ((NA && lat && (i) >= 4) ? 256 + 64 * (rs0 + (i) - 4) : 64 * (i))
#define ATT_GLOAD(kp) do { \
      rk0 = *(const uint4*)(kbase + (size_t)(kp) * DQK + tid * 8); \
      rk1 = *(const uint4*)(kbase + (size_t)(kp) * DQK + (tid + 256) * 8); \
      if (KCH > 2) rk2 = *(const uint4*)(kbase + (size_t)(kp) * DQK + (tid + 512) * 8); \
      rv0 = *(const uint4*)(vbase + (size_t)(tid >> 3) * SP + (kp) + (tid & 7) * 8); \
      rv1 = *(const uint4*)(vbase + (size_t)((tid >> 3) + 32) * SP + (kp) + (tid & 7) * 8); } while (0)
#define ATT_LSTORE(buf_) do { u16* Ks_ = (u16*)(smem + (buf_) * STG); u16* Vs_ = (u16*)(smem + (buf_) * STG + 64 * KP * 2); \
      { int c = tid; *(uint4*)(Ks_ + (c / (DQK / 8)) * KP + (c % (DQK / 8)) * 8) = rk0; } \
      { int c = tid + 256; *(uint4*)(Ks_ + (c / (DQK / 8)) * KP + (c % (DQK / 8)) * 8) = rk1; } \
      if (KCH > 2) { int c = tid + 512; *(uint4*)(Ks_ + (c / (DQK / 8)) * KP + (c % (DQK / 8)) * 8) = rk2; } \
      *(uint4*)(Vs_ + (tid >> 3) * 72 + (tid & 7) * 8) = rv0; \
      *(uint4*)(Vs_ + ((tid >> 3) + 32) * 72 + (tid & 7) * 8) = rv1; } while (0)
    { const int kp0 = KPOS_OF(0); ATT_GLOAD(kp0); }
    __syncthreads();
    ATT_LSTORE(0);
    if (NA) { for (int q = tid; q < 465; q += NTHR) rpbs[q] = rpb[hq * 465 + q]; }
    if (ntiles > 1) { const int kp1 = KPOS_OF(1); ATT_GLOAD(kp1); }
    __syncthreads();
    for (int ti = 0; ti < ntiles; ++ti) {
      if (ti + 1 < ntiles) ATT_LSTORE((ti + 1) & 1);
      if (ti + 2 < ntiles) { const int kp2 = KPOS_OF(ti + 2); ATT_GLOAD(kp2); }
      const u16* Ks = (const u16*)(smem + (ti & 1) * STG);
      const u16* Vs = (const u16*)(smem + (ti & 1) * STG + 64 * KP * 2);
      bool active = true;
      int jrow = 0;
      if (NA && lat && ti >= 4) { jrow = rs0 + ti - 4; active = (jrow >= rsw) && (jrow < rsw + 8); }
      if (active) {
        f32x16 s0, s1;
#pragma unroll
        for (int i = 0; i < 16; ++i) { s0[i] = 0.f; s1[i] = 0.f; }
#pragma unroll
        for (int kk = 0; kk < NKK; ++kk) {
          bf16x8 k0 = *(const bf16x8*)(Ks + r * KP + 16 * kk + 8 * h);
          bf16x8 k1 = *(const bf16x8*)(Ks + (32 + r) * KP + 16 * kk + 8 * h);
          s0 = MFMA32(k0, qf[kk], s0);
          s1 = MFMA32(k1, qf[kk], s1);
        }
        if (NA && lat && ti >= 4) {
          const int qc = (w & 1) * 32 + r;
          const int cs = min(max(qc - 8, 0), 48);
          const float* brow = rpbs + (jrow - rw + 7) * 31 + (15 - qc);
#pragma unroll
          for (int i = 0; i < 16; ++i) {
            int kc0 = (i & 3) + 8 * (i >> 2) + 4 * h, kc1 = kc0 + 32;
            bool v0 = (kc0 >= cs) && (kc0 < cs + 16), v1 = (kc1 >= cs) && (kc1 < cs + 16);
            float b0 = v0 ? brow[kc0] : 0.f, b1 = v1 ? brow[kc1] : 0.f;
            s0[i] = v0 ? (s0[i] * sl2 + b0 * LOG2E) : -1e30f;
            s1[i] = v1 ? (s1[i] * sl2 + b1 * LOG2E) : -1e30f;
          }
        }
        const float sc = (NA && lat && ti >= 4) ? 1.f : sl2;
        float tm = s0[0];
#pragma unroll
        for (int i = 1; i < 16; ++i) tm = fmaxf(tm, s0[i]);
#pragma unroll
        for (int i = 0; i < 16; ++i) tm = fmaxf(tm, s1[i]);
        tm = fmaxf(tm, __shfl_xor(tm, 32)) * sc;
        if (__any(tm > m + 8.f)) {
          const float mn = fmaxf(m, tm);
          const float alpha = __builtin_amdgcn_exp2f(m - mn);
          m = mn;
          l *= alpha;
#pragma unroll
          for (int i = 0; i < 16; ++i) { o0[i] *= alpha; o1[i] *= alpha; }
        }
        float ps = 0.f;
#pragma unroll
        for (int i = 0; i < 16; ++i) {
          s0[i] = __builtin_amdgcn_exp2f(__builtin_fmaf(s0[i], sc, -m)); ps += s0[i];
          s1[i] = __builtin_amdgcn_exp2f(__builtin_fmaf(s1[i], sc, -m)); ps += s1[i];
        }
        l += ps;
#pragma unroll
        for (int kt = 0; kt < 2; ++kt) {
#pragma unroll
          for (int sp = 0; sp < 2; ++sp) {
            u32x4 pu;
            pu[0] = pack2(kt ? s1[8 * sp + 0] : s0[8 * sp + 0], kt ? s1[8 * sp + 1] : s0[8 * sp + 1]);
            pu[1] = pack2(kt ? s1[8 * sp + 2] : s0[8 * sp + 2], kt ? s1[8 * sp + 3] : s0[8 * sp + 3]);
            pu[2] = pack2(kt ? s1[8 * sp + 4] : s0[8 * sp + 4], kt ? s1[8 * sp + 5] : s0[8 * sp + 5]);
            pu[3] = pack2(kt ? s1[8 * sp + 6] : s0[8 * sp + 6], kt ? s1[8 * sp + 7] : s0[8 * sp + 7]);
            const bf16x8 pfv = __builtin_bit_cast(bf16x8, pu);
            const int ko = 32 * kt + 16 * sp + 4 * h;
            const uint2 a0 = *(const uint2*)(Vs + r * 72 + ko), a1 = *(const uint2*)(Vs + r * 72 + ko + 8);
            const uint2 c0 = *(const uint2*)(Vs + (32 + r) * 72 + ko), c1 = *(const uint2*)(Vs + (32 + r) * 72 + ko + 8);
            u32x4 vau, vbu;
            vau[0] = a0.x; vau[1] = a0.y; vau[2] = a1.x; vau[3] = a1.y;
            vbu[0] = c0.x; vbu[1] = c0.y; vbu[2] = c1.x; vbu[3] = c1.y;
            const bf16x8 vav = __builtin_bit_cast(bf16x8, vau), vbv = __builtin_bit_cast(bf16x8, vbu);
            o0 = MFMA32(vav, pfv, o0);
            o1 = MFMA32(vbv, pfv, o1);
          }
        }
      }
      __syncthreads();
    }
    l += __shfl_xor(l, 32);
    const float inv = 1.f / l;
    const int R = tok_row(b, qpos);
    u16* op = mix + (size_t)R * 1024 + coloff + hq * 64 + 4 * h;
#pragma unroll
    for (int g4 = 0; g4 < 4; ++g4) {
      uint2 a, c;
      a.x = pack2(o0[4 * g4] * inv, o0[4 * g4 + 1] * inv); a.y = pack2(o0[4 * g4 + 2] * inv, o0[4 * g4 + 3] * inv);
      c.x = pack2(o1[4 * g4] * inv, o1[4 * g4 + 1] * inv); c.y = pack2(o1[4 * g4 + 2] * inv, o1[4 * g4 + 3] * inv);
      *(uint2*)(op + 8 * g4) = a;
      *(uint2*)(op + 32 + 8 * g4) = c;
    }
  }
  __syncthreads();
}

DI void s5_bfrags(const float* __restrict__ SBB, int tbase, int lane, bf16x8* bfrag) {
  const int col = lane & 15, fq = lane >> 4;
#pragma unroll
  for (int nt = 0; nt < 8; ++nt) {
    const float* src = SBB + (size_t)(tbase + 16 * (nt & 3) + col) * 32 + (nt >> 2) * 16 + 8 * (fq & 1);
    float4 t0 = *(const float4*)src, t1 = *(const float4*)(src + 4);
    u32x4 cu;
    cu[0] = pack2(t0.x, t0.y); cu[1] = pack2(t0.z, t0.w); cu[2] = pack2(t1.x, t1.y); cu[3] = pack2(t1.z, t1.w);
    bfrag[nt] = __builtin_bit_cast(bf16x8, cu);
  }
}
DI void s5_bu16(const float* __restrict__ urow, int lane, const bf16x8* bfrag, float* Bus) {
  const int col = lane & 15, fq = lane >> 4;
  float4 u0 = *(const float4*)(urow + 8 * (fq & 1)), u1 = *(const float4*)(urow + 8 * (fq & 1) + 4);
  float uv[8] = {u0.x, u0.y, u0.z, u0.w, u1.x, u1.y, u1.z, u1.w};
  u32x4 au;
#pragma unroll
  for (int q = 0; q < 4; ++q) {
    float h0 = bf2f(f2bf(uv[2 * q])), h1 = bf2f(f2bf(uv[2 * q + 1]));
    float x0 = fq < 2 ? uv[2 * q] : uv[2 * q] - h0;
    float x1 = fq < 2 ? uv[2 * q + 1] : uv[2 * q + 1] - h1;
    au[q] = pack2(x0, x1);
  }
  const bf16x8 af = __builtin_bit_cast(bf16x8, au);
  f32x4 a0 = {0.f, 0.f, 0.f, 0.f}, a1 = a0, a2 = a0, a3 = a0, a4 = a0, a5 = a0, a6 = a0, a7 = a0;
  a0 = MFMA16(af, bfrag[0], a0); a1 = MFMA16(af, bfrag[1], a1); a2 = MFMA16(af, bfrag[2], a2); a3 = MFMA16(af, bfrag[3], a3);
  a4 = MFMA16(af, bfrag[4], a4); a5 = MFMA16(af, bfrag[5], a5); a6 = MFMA16(af, bfrag[6], a6); a7 = MFMA16(af, bfrag[7], a7);
  asm volatile("s_nop 15\n\ts_nop 15" : "+v"(a0), "+v"(a1), "+v"(a2), "+v"(a3), "+v"(a4), "+v"(a5), "+v"(a6), "+v"(a7));
#define BUS_ST(nt_, A_) _Pragma("unroll") for (int jj = 0; jj < 4; ++jj) Bus[(4 * fq + jj) * 132 + 16 * (nt_) + col] = A_[jj];
  BUS_ST(0, a0) BUS_ST(1, a1) BUS_ST(2, a2) BUS_ST(3, a3) BUS_ST(4, a4) BUS_ST(5, a5) BUS_ST(6, a6) BUS_ST(7, a7)
}

DI void s5_pass1(const P& p, int j, char* smem) {
  const int tid = otid(), lane = tid & 63, w = tid >> 6;
  const float* U = (const float*)(p.ws + E_U);
  float2* E = (float2*)(p.ws + E_E);
  const float2* SA = (const float2*)(p.ws + OFF_SA);
  const float* SBB = (const float*)(p.ws + OFF_SBB);
  float* Bus = (float*)(smem + w * 16896);
  for (int item = blockIdx.x; item < 4608; item += gridDim.x) {
    const int unit = item * 4 + w;
    const int c = unit % 36; const int t1 = unit / 36; const int dir = t1 & 1; const int t2 = t1 >> 1; const int g = t2 & 15; const int b = t2 >> 4;
    const int tbase = ((j * 2 + dir) * 16 + g) * 64;
    const float2 a = SA[tbase + lane];
    bf16x8 bfrag[8];
    s5_bfrags(SBB, tbase, lane, bfrag);
    float hr = 0.f, hi = 0.f;
#pragma unroll 1
    for (int sub = 0; sub < 4; ++sub) {
      const int tau = 64 * c + sub * 16 + (lane & 15);
      const int pos = dir ? (tau < 256 ? 255 - tau : 2559 - tau) : tau;
      s5_bu16(U + (size_t)tok_row(b, pos) * 256 + 16 * g, lane, bfrag, Bus);
      asm volatile("s_waitcnt lgkmcnt(0)" ::: "memory");
#pragma unroll
      for (int k16 = 0; k16 < 16; ++k16) {
        const float bur = Bus[k16 * 132 + lane], bui = Bus[k16 * 132 + 64 + lane];
        const float nr = a.x * hr - a.y * hi + bur;
        const float ni = a.x * hi + a.y * hr + bui;
        hr = nr; hi = ni;
      }
      asm volatile("s_waitcnt lgkmcnt(0)" ::: "memory");
    }
    E[((((size_t)b * 16 + g) * 2 + dir) * 36 + c) * 64 + lane] = make_float2(hr, hi);
  }
  __syncthreads();
}

DI void s5_pass2(const P& p, int j, char* smem) {
  const int tid = otid(), lane = tid & 63, w = tid >> 6;
  const float* U = (const float*)(p.ws + E_U);
  const float2* E = (const float2*)(p.ws + E_E);
  const float2* SA = (const float2*)(p.ws + OFF_SA);
  const float2* SAL = (const float2*)(p.ws + OFF_SAL);
  const float* SBB = (const float*)(p.ws + OFF_SBB);
  u16* YG = (u16*)(p.ws + E_YG);
  char* wb = smem + w * 16896;
  float* Bus = (float*)wb; u16* Hs = (u16*)(wb + 8448); float* ys = (float*)(wb + 8448 + 4352);
  const int pcol = lane & 15, fq = lane >> 4;
  for (int item = blockIdx.x; item < 4608; item += gridDim.x) {
    const int Pc = item % 36; const int t1 = item / 36; const int gp = t1 & 7; const int b = t1 >> 3;
    const int g = gp * 2 + (w >> 1), dir = w & 1;
    const int tbase = ((j * 2 + dir) * 16 + g) * 64;
    const float2 a = SA[tbase + lane], aL = SAL[tbase + lane];
    bf16x8 bfrag[8];
    s5_bfrags(SBB, tbase, lane, bfrag);
    const int c = dir ? (Pc < 4 ? 3 - Pc : 39 - Pc) : Pc;
    float hr = 0.f, hi = 0.f;
    {
      const float2* Eb = E + ((((size_t)b * 16 + g) * 2 + dir) * 36) * 64 + lane;
      for (int cc = 0; cc < c; ++cc) {
        float2 e = Eb[(size_t)cc * 64];
        float nr = aL.x * hr - aL.y * hi + e.x;
        float ni = aL.x * hi + aL.y * hr + e.y;
        hr = nr; hi = ni;
      }
    }
    bf16x8 cf[4];
    {
      const size_t cbase = ((size_t)((j * 2 + dir) * 16 + g) * 16 + pcol) * 64;
#pragma unroll
      for (int ks = 0; ks < 4; ++ks) {
        const float* src = (ks < 2 ? p.c_re : p.c_im) + cbase + 32 * (ks & 1) + 8 * fq;
        float4 t0 = *(const float4*)src, t1_ = *(const float4*)(src + 4);
        const float sg = ks < 2 ? 1.f : -1.f;
        u32x4 cu;
        cu[0] = pack2(sg * t0.x, sg * t0.y); cu[1] = pack2(sg * t0.z, sg * t0.w);
        cu[2] = pack2(sg * t1_.x, sg * t1_.y); cu[3] = pack2(sg * t1_.z, sg * t1_.w);
        cf[ks] = __builtin_bit_cast(bf16x8, cu);
      }
    }
    const float dsk = p.ssm_d[j * 256 + 16 * g + pcol];
#pragma unroll 1
    for (int sub = 0; sub < 4; ++sub) {
      {
        const int k = sub * 16 + (lane & 15);
        const int lt = dir ? 63 - k : k;
        s5_bu16(U + (size_t)tok_row(b, 64 * Pc + lt) * 256 + 16 * g, lane, bfrag, Bus);
      }
      asm volatile("s_waitcnt lgkmcnt(0)" ::: "memory");
#pragma unroll
      for (int k16 = 0; k16 < 16; ++k16) {
        const float bur = Bus[k16 * 132 + lane], bui = Bus[k16 * 132 + 64 + lane];
        const float nr = a.x * hr - a.y * hi + bur;
        const float ni = a.x * hi + a.y * hr + bui;
        hr = nr; hi = ni;
        Hs[k16 * 136 + lane] = f2bf(hr);
        Hs[k16 * 136 + 64 + lane] = f2bf(hi);
      }
      asm volatile("s_waitcnt lgkmcnt(0)" ::: "memory");
      f32x4 acc = {0.f, 0.f, 0.f, 0.f};
#pragma unroll
      for (int ks = 0; ks < 4; ++ks) {
        bf16x8 af = *(const bf16x8*)(Hs + pcol * 136 + 32 * ks + 8 * fq);
        acc = MFMA16(af, cf[ks], acc);
      }
#pragma unroll
      for (int jj = 0; jj < 4; ++jj) {
        const int k = sub * 16 + 4 * fq + jj;
        const int lt = dir ? 63 - k : k;
        float yv = acc[jj];
        if (dir == 0) yv += dsk * U[(size_t)tok_row(b, 64 * Pc + lt) * 256 + 16 * g + pcol];
        ys[lt * 16 + pcol] = yv;
      }
      asm volatile("s_waitcnt lgkmcnt(0)" ::: "memory");
    }
    __syncthreads();
#pragma unroll
    for (int i = 0; i < 8; ++i) {
      int idx = tid + 256 * i; int gi = idx >> 10, lt = (idx >> 4) & 63, pp = idx & 15;
      const char* w0 = smem + (2 * gi) * 16896; const char* w1 = smem + (2 * gi + 1) * 16896;
      const int gg = gp * 2 + gi;
      float y = ((const float*)(w0 + 12800))[lt * 16 + pp] + ((const float*)(w1 + 12800))[lt * 16 + pp];
      float t = 0.7978845608028654f * (y + 0.044715f * y * y * y);
      float ge = 0.5f * y * (1.f + tanhf(t));
      int row = tok_row(b, 64 * Pc + lt);
      YG[(size_t)row * 256 + 16 * gg + pp] = f2bf(ge);
    }
    __syncthreads();
  }
}

__global__ void __launch_bounds__(NTHR, 2) fwd_megakernel(P p) {
  __shared__ __attribute__((aligned(16))) char smem[SMEM_BYTES];
  cg::grid_group grid = cg::this_grid();
  char* ws = p.ws;
  float* XC = (float*)(ws + OFF_XC);
  u16* ABUF = (u16*)(ws + OFF_ABUF);
  const float* modv = (const float*)(ws + OFF_MODV);

  __shared__ uint4 xb_words;
  unsigned* barw = (unsigned*)(ws + OFF_BAR);
  if (threadIdx.x == 0) xb_words = make_uint4(0u, 0u, 0u, 0u);
  if (blockIdx.x == 0) { for (int i = threadIdx.x; i < XCD_BAR_WORDS; i += NTHR) barw[i] = 0u; }
  for (int dd = 0; dd < DUPN(3); ++dd) prologue(p, smem);
  grid.sync();
  XcdBarrier xb = xcd_barrier_post(barw, (volatile LAS unsigned*)&xb_words);

  float* PSN = (float*)(ws + OFF_PSN);
  float* SW1 = (float*)(ws + OFF_SW1);
  float* SW2 = (float*)(ws + OFF_SW2);
  norm_phase(p.x, p.ctx, p.g_norm1, modv, 0, 1, NTOK, ABUF, PSN);
  for (int l = 0; l < 4; ++l) {
    const int jj = l >> 1;
    if (l & 1) sw_items(modv + (size_t)l * 17 * 6144, (const u16*)(ws + OFF_OIN + jj * SZ_OIN), 2432, SW1 + (size_t)l * 17 * 2560, 2560);
    else sw_items(modv + (size_t)l * 17 * 6144, (const u16*)(ws + OFF_EIN + jj * SZ_EIN), 1536, SW1 + (size_t)l * 17 * 2560, 2560);
  }
  GSYNC();

  for (int layer = 0; layer < 4; ++layer) {
    const int j = layer >> 1;
    const bool need_ctx = layer < 3;
    const float* xs_lat = layer == 0 ? p.x : p.out;
    const float* xs_ctx = layer == 0 ? p.ctx : XC;
    const float* modl = modv + (size_t)layer * 17 * 6144;
    EpiArgs ea{};
    ea.j = j; ea.gate = modl + 2 * 1024; ea.src_lat = xs_lat; ea.src_ctx = xs_ctx; ea.dst_lat = p.out; ea.dst_ctx = XC;
    ea.sw = SW1 + (size_t)layer * 17 * 2560; ea.sw_stride = 2560;
    ea.ng = p.g_norm2 + layer * 1024; ea.nscale = modl + 4 * 1024; ea.xg_dst = (u16*)(ws + OFF_XG2);

    if ((layer & 1) == 0) {
      for (int dd = 0; dd < DUPN(0); ++dd) gemm_phase<EPI_EVEN_IN>(p, ABUF, (const u16*)(ws + OFF_EIN + j * SZ_EIN), 1024, 288, 12, 6, ea, smem);
      GSYNC();
      for (int dd = 0; dd < DUPN(2); ++dd) s5_pass1(p, j, smem);
      for (int dd = 0; dd < DUPN(1); ++dd) attn_phase<64, false>((const u16*)(ws + E_Q), (const u16*)(ws + E_K), (const u16*)(ws + E_VT), 12, 4, 0.125f, ABUF, 0, need_ctx, nullptr, smem);
      ff_convert(p, layer, smem);
      GSYNC();
      for (int dd = 0; dd < DUPN(2); ++dd) s5_pass2(p, j, smem);
      sw_items(modl + 3 * 1024, (const u16*)(ws + OFF_FF1), 4096, SW2 + (size_t)layer * 17 * 4096, 4096);
      GSYNC();
      for (int dd = 0; dd < DUPN(0); ++dd) gemm_phase<EPI_GLU>(p, (const u16*)(ws + E_YG), (const u16*)(ws + OFF_GLU + j * SZ_GLU), 256, 288, 2, 6, ea, smem);
      GSYNC();
    } else {
      for (int dd = 0; dd < DUPN(0); ++dd) gemm_phase<EPI_ODD_IN>(p, ABUF, (const u16*)(ws + OFF_OIN + j * SZ_OIN), 1024, 288, 19, 6, ea, smem);
      GSYNC();
      for (int dd = 0; dd < DUPN(0); ++dd) gemm_phase<EPI_UQ>(p, (const u16*)(ws + O_CQ), (const u16*)(ws + OFF_UQ + j * SZ_UQ), 512, 288, 8, 6, ea, smem);
      for (int dd = 0; dd < DUPN(0); ++dd) gemm_phase<EPI_UKV>(p, (const u16*)(ws + O_CKV), (const u16*)(ws + OFF_UKV + j * SZ_UKV), 256, 288, 8, 6, ea, smem);
      for (int dd = 0; dd < DUPN(1); ++dd) attn_phase<64, true>((const u16*)(ws + O_NQ), (const u16*)(ws + O_NK), (const u16*)(ws + O_NVT), 8, 8, 0.125f, ABUF, 512, need_ctx,
                           p.rpb + (size_t)j * 8 * 465, smem);
      ff_convert(p, layer, smem);
      GSYNC();
      for (int dd = 0; dd < DUPN(1); ++dd) attn_phase<96, false>((const u16*)(ws + O_MQ), (const u16*)(ws + O_MK), (const u16*)(ws + O_MVT), 8, 8, 0.10206207261596577f, ABUF, 0,
                            need_ctx, nullptr, smem);
      sw_items(modl + 3 * 1024, (const u16*)(ws + OFF_FF1), 4096, SW2 + (size_t)layer * 17 * 4096, 4096);
      GSYNC();
    }
    const int mt = need_ctx ? 288 : 256;
    const int band = need_ctx ? 6 : 8;
    gemm_phase<EPI_RESID>(p, ABUF, (const u16*)(ws + ((layer & 1) ? OFF_OOUT : OFF_EOUT) + j * SZ_SQ), 1024, mt, 8, band, ea, smem);
    GSYNC();
    ea.sw = SW2 + (size_t)layer * 17 * 4096; ea.sw_stride = 4096;
    for (int dd = 0; dd < DUPN(0); ++dd) gemm_phase<EPI_RELU2>(p, (const u16*)(ws + OFF_XG2), (const u16*)(ws + OFF_FF1), 1024, mt, 32, band, ea, smem);
    GSYNC();
    ea.gate = modl + 5 * 1024; ea.src_lat = p.out; ea.src_ctx = XC;
    ea.ng = layer < 3 ? p.g_norm1 + (layer + 1) * 1024 : nullptr; ea.xg_dst = ABUF;
    ea.nscale = modv + (size_t)(layer + 1) * 17 * 6144 + 1 * 1024;
    gemm_phase<EPI_RESID>(p, (const u16*)(ws + OFF_H), (const u16*)(ws + OFF_FF2), 4096, mt, 8, band, ea, smem);
    GSYNC();
  }
  if (GPROBE >= 0) {
    EpiArgs ed{}; ed.j = 0;
    gemm_phase<EPI_RELU2, (GPROBE < 0 ? 0 : GPROBE)>(p, (const u16*)(ws + OFF_ABUF), (const u16*)(ws + OFF_FF1), 1024, 288, 32, 6, ed, smem);
  }
}

extern "C" void kernel_launch(void* const* d_in, const int* in_sizes, int n_in, void* d_out, int out_size, void* d_ws, size_t ws_size,
                              hipStream_t stream) {
  static int grid_blocks = 0;
  if (!grid_blocks) {
    int dev = 0, cus = 0, per_cu = 0;
    hipGetDevice(&dev);
    hipDeviceGetAttribute(&cus, hipDeviceAttributeMultiprocessorCount, dev);
    hipOccupancyMaxActiveBlocksPerMultiprocessor(&per_cu, fwd_megakernel, NTHR, 0);
    if (per_cu > 2) per_cu = 2;
    if (per_cu < 1) per_cu = 1;
    grid_blocks = cus * per_cu;
    grid_blocks &= ~7;
  }
  P p{};
  const float** f = (const float**)&p;
  for (int i = 0; i < 35; ++i) f[i] = (const float*)d_in[i];
  p.out = (float*)d_out;
  p.ws = (char*)d_ws;
  void* args[] = {&p};
  hipError_t e = hipLaunchCooperativeKernel((void*)fwd_megakernel, dim3(grid_blocks), dim3(NTHR), args, 0, stream);
  if (e != hipSuccess) fprintf(stderr, "cooperative launch failed: %s (grid %d)\n", hipGetErrorString(e), grid_blocks);
}
```

```cpp
#include <hip/hip_runtime.h>
#include <hip/hip_cooperative_groups.h>
#include <cstdio>
namespace cg = cooperative_groups;

typedef unsigned short u16;
using bf16x8 = __attribute__((ext_vector_type(8))) short;
using f32x16 = __attribute__((ext_vector_type(16))) float;
using f32x4 = __attribute__((ext_vector_type(4))) float;
typedef __attribute__((ext_vector_type(2))) __bf16 bf2_t;
using u32x4 = __attribute__((ext_vector_type(4))) unsigned;
#define DI __device__ __forceinline__
#define MFMA32(a, b, c) __builtin_amdgcn_mfma_f32_32x32x16_bf16((a), (b), (c), 0, 0, 0)
#define MFMA16(a, b, c) __builtin_amdgcn_mfma_f32_16x16x32_bf16((a), (b), (c), 0, 0, 0)

#ifndef GPROBE
#define GPROBE -1
#endif
#ifndef DUP_MASK
#define DUP_MASK 0
#endif
#define DUPN(bit) (((DUP_MASK) >> (bit)) & 1 ? 2 : 1)
constexpr int NTHR = 256;
constexpr int NLAT = 32768, NTOK = 36864, SP = 2304;
constexpr float EPSF = 1e-6f;
constexpr float LOG2E = 1.4426950408889634f;
constexpr int SMEM_BYTES = 73728 + 512;
constexpr int CP = 132;

constexpr size_t SZ_EIN = 1536ull * 1024 * 2, SZ_SQ = 1024ull * 1024 * 2, SZ_OIN = 2432ull * 1024 * 2;
constexpr size_t SZ_UQ = 1024ull * 512 * 2, SZ_UKV = 1024ull * 256 * 2, SZ_GLU = 256ull * 256 * 2;
constexpr size_t OFF_EIN = 0;
constexpr size_t OFF_EOUT = OFF_EIN + 2 * SZ_EIN;
constexpr size_t OFF_OIN = OFF_EOUT + 2 * SZ_SQ;
constexpr size_t OFF_OOUT = OFF_OIN + 2 * SZ_OIN;
constexpr size_t OFF_UQ = OFF_OOUT + 2 * SZ_SQ;
constexpr size_t OFF_UKV = OFF_UQ + 2 * SZ_UQ;
constexpr size_t OFF_GLU = OFF_UKV + 2 * SZ_UKV;
constexpr size_t OFF_FF1 = OFF_GLU + 2 * SZ_GLU;
constexpr size_t OFF_FF2 = OFF_FF1 + 4096ull * 1024 * 2;
constexpr size_t OFF_MODV = OFF_FF2 + 4096ull * 1024 * 2;
constexpr size_t OFF_ROPE = OFF_MODV + 4ull * 17 * 6144 * 4;
constexpr size_t OFF_SA = OFF_ROPE + 16384;
constexpr size_t OFF_SAL = OFF_SA + 4096 * 8;
constexpr size_t OFF_SBB = OFF_SAL + 4096 * 8;
constexpr size_t OFF_BAR = OFF_SBB + 4096ull * 32 * 4;
constexpr size_t OFF_PSN = OFF_BAR + 16384;
constexpr size_t OFF_SW1 = OFF_PSN + 36864ull * 8 * 4;
constexpr size_t OFF_SW2 = OFF_SW1 + 4ull * 17 * 2560 * 4;
constexpr size_t OFF_XC = OFF_SW2 + 4ull * 17 * 4096 * 4;
constexpr size_t OFF_ABUF = OFF_XC + 4096ull * 1024 * 4;
constexpr size_t OFF_R1 = OFF_ABUF + (size_t)NTOK * 1024 * 2;
constexpr size_t E_Q = OFF_R1;
constexpr size_t E_K = E_Q + 16ull * 12 * SP * 64 * 2;
constexpr size_t E_VT = E_K + 16ull * 4 * SP * 64 * 2;
constexpr size_t E_U = E_VT + 16ull * 4 * SP * 64 * 2;
constexpr size_t E_E = E_U + (size_t)NTOK * 256 * 4;
constexpr size_t E_YG = E_E + 16ull * 16 * 2 * 36 * 64 * 8;
constexpr size_t O_CQ = OFF_R1;
constexpr size_t O_CKV = O_CQ + (size_t)NTOK * 512 * 2;
constexpr size_t O_KR = O_CKV + (size_t)NTOK * 256 * 2;
constexpr size_t O_PS = O_KR + (size_t)NTOK * 32 * 4;
constexpr size_t O_NQ = O_PS + (size_t)NTOK * 8 * 4;
constexpr size_t O_NK = O_NQ + 16ull * 8 * SP * 64 * 2;
constexpr size_t O_NVT = O_NK + 16ull * 8 * SP * 64 * 2;
constexpr size_t O_MQ = O_NVT + 16ull * 8 * SP * 64 * 2;
constexpr size_t O_MK = O_MQ + 16ull * 8 * SP * 96 * 2;
constexpr size_t O_MVT = O_MK + 16ull * 8 * SP * 96 * 2;
constexpr size_t O_END = O_MVT + 16ull * 8 * SP * 64 * 2;
constexpr size_t OFF_H = OFF_R1;
constexpr size_t OFF_XG2 = OFF_H + (size_t)NTOK * 4096 * 2;
constexpr size_t WS_END = OFF_XG2 + (size_t)NTOK * 1024 * 2;
static_assert(WS_END <= 536870912ull, "workspace map exceeds 512 MiB");

struct P {
  const float *x, *c, *ctx, *c_ctx, *w_mod, *b_mod, *g_norm1, *g_norm2, *w_ff1, *w_ff2;
  const float *e_w_in, *e_w_out, *e_g_q, *e_g_k, *lam_re, *lam_im, *log_dt, *b_re, *b_im, *c_re, *c_im, *ssm_d, *w_glu, *b_glu;
  const float *o_w_in, *o_w_out, *g_cq, *g_ckv, *w_uq, *w_ukv, *g_mq, *g_mk, *g_nq, *g_nk, *rpb;
  float* out;
  char* ws;
};

DI unsigned pack2(float a, float b) { bf2_t v; v[0] = (__bf16)a; v[1] = (__bf16)b; return __builtin_bit_cast(unsigned, v); }
DI u16 f2bf(float a) { __bf16 v = (__bf16)a; return __builtin_bit_cast(u16, v); }
DI float bf2f(u16 v) { return __uint_as_float(((unsigned)v) << 16); }
#define GSYNC() do { for (int dd_ = 0; dd_ < DUPN(4); ++dd_) xcd_barrier(xb); } while (0)
DI int otid() { int t = threadIdx.x; asm volatile("" : "+v"(t)); return t; }
DI int tok_row(int b, int pos) { return pos < 256 ? NLAT + b * 256 + pos : b * 2048 + pos - 256; }


#define XB_TMO      128
#define XB_XCNT(j)  (256  + 64 * (j))
#define XB_XSUB(j)  (1280 + 64 * (j))
#define XB_XGEN(j)  (2304 + 64 * (j))
#define XB_TOP      3328
#define XB_TOPGEN   3392
#define XCD_BAR_WORDS 3456
#define XB_SPIN_CAP (1u << 22)
#define LAS __attribute__((address_space(3)))
DI unsigned xb_ld(unsigned* p) { return __hip_atomic_load(p, __ATOMIC_RELAXED, __HIP_MEMORY_SCOPE_AGENT); }
DI unsigned xb_add(unsigned* p, unsigned v) { return __hip_atomic_fetch_add(p, v, __ATOMIC_RELAXED, __HIP_MEMORY_SCOPE_AGENT); }
DI unsigned xb_xcc_id() { return (unsigned)__builtin_amdgcn_s_getreg((3 << 11) | 20) & 0xFu; }
#define XB_SPIN(cond, bar) do { unsigned _sp = 0; while (cond) { __builtin_amdgcn_s_sleep(1); \
    if ((++_sp & 255u) == 0u) { if (xb_ld(&(bar)[XB_TMO])) break; if (_sp > XB_SPIN_CAP) { atomicAdd(&(bar)[XB_TMO], 1u); break; } } } } while (0)
struct XcdBarrier { unsigned* bar; unsigned x; volatile LAS unsigned* st; };
DI XcdBarrier xcd_barrier_post(unsigned* bar, volatile LAS unsigned* st) {
  XcdBarrier b; b.bar = bar; b.x = xb_xcc_id(); b.st = st;
  if (threadIdx.x == 0) (void)xb_add(&bar[XB_XCNT(b.x)], 1u);
  return b;
}
DI void xcd_barrier_complete(unsigned* bar, unsigned x, unsigned& nloc, unsigned& nx) {
  const unsigned G = gridDim.x * gridDim.y * gridDim.z;
  unsigned sum, cnt, mine, sp = 0u;
  for (;;) {
    sum = 0u; cnt = 0u; mine = 0u;
#pragma unroll
    for (unsigned j = 0; j < 16; ++j) { const unsigned c = xb_ld(&bar[XB_XCNT(j)]); sum += c; cnt += (c > 0u) ? 1u : 0u; mine = (j == x) ? c : mine; }
    if (sum == G) break;
    __builtin_amdgcn_s_sleep(1);
    if ((++sp & 255u) == 0u) { if (xb_ld(&bar[XB_TMO])) break; if (sp > XB_SPIN_CAP) { atomicAdd(&bar[XB_TMO], 1u); break; } }
  }
  nloc = mine > 0u ? mine : 1u; nx = cnt > 0u ? cnt : 1u;
}
DI void xcd_barrier(const XcdBarrier& b) {
  asm volatile("s_waitcnt vmcnt(0)" ::: "memory");
  __syncthreads();
  if (threadIdx.x == 0) {
    unsigned* bar = b.bar;
    __builtin_amdgcn_s_waitcnt(0);
    unsigned nloc = b.st[0], nx = b.st[1];
    if (nloc == 0u) { xcd_barrier_complete(bar, b.x, nloc, nx); b.st[0] = nloc; b.st[1] = nx; }
    const unsigned old = xb_add(&bar[XB_XSUB(b.x)], 1u);
    const unsigned gen = old / nloc;
    if (old + 1u == (gen + 1u) * nloc) {
      __builtin_amdgcn_fence(__ATOMIC_RELEASE, "agent");
      asm volatile("s_waitcnt vmcnt(0)" ::: "memory");
      const unsigned og = xb_add(&bar[XB_TOP], 1u);
      const unsigned tg = og / nx;
      if (og + 1u == (tg + 1u) * nx) xb_add(&bar[XB_TOPGEN], 1u);
      else XB_SPIN(xb_ld(&bar[XB_TOPGEN]) == tg, bar);
      __builtin_amdgcn_fence(__ATOMIC_ACQUIRE, "agent");
      xb_add(&bar[XB_XGEN(b.x)], 1u);
      asm volatile("s_waitcnt vmcnt(0)" ::: "memory");
    } else {
      XB_SPIN(xb_ld(&bar[XB_XGEN(b.x)]) == gen, bar);
      __builtin_amdgcn_fence(__ATOMIC_ACQUIRE, "agent");
      asm volatile("s_waitcnt vmcnt(0)" ::: "memory");
    }
  }
  __syncthreads();
}

DI int map_col(int mapk, int n, int N) {
  if (mapk == 0) return n < N ? n : -1;
  if (mapk == 1) { if (n < 768) return n; if (n < 2304) return n + 32; if (n < 2336) return n - 2304 + 768; return -1; }
  int h = n >> 7, jj = n & 127; return jj < 96 ? h * 96 + jj : -1;
}
DI void tr_tile(const float* __restrict__ src, int K, int N, int Npad, int mapk, const float* __restrict__ ks,
                        u16* __restrict__ dst, int tile, char* smem) {
  float* tl = (float*)smem;
  const int tid = otid();
  const int tnn = Npad >> 6;
  const int n0 = (tile % tnn) * 64, k0 = (tile / tnn) * 64;
  const int nn = tid & 63;
  const int sn = map_col(mapk, n0 + nn, N);
#pragma unroll 4
  for (int i = 0; i < 16; ++i) {
    int kk = (tid >> 6) + 4 * i;
    float v = 0.f;
    if (sn >= 0) { v = src[(size_t)(k0 + kk) * N + sn]; if (ks) v *= ks[k0 + kk]; }
    tl[kk * 65 + nn] = v;
  }
  __syncthreads();
#pragma unroll 4
  for (int i = 0; i < 16; ++i) {
    int n2 = (tid >> 6) + 4 * i, kk = tid & 63;
    dst[(size_t)(n0 + n2) * K + k0 + kk] = f2bf(tl[kk * 65 + n2]);
  }
  __syncthreads();
}

DI void ff_convert(const P& p, int layer, char* smem) {
  u16* f1 = (u16*)(p.ws + OFF_FF1);
  u16* f2 = (u16*)(p.ws + OFF_FF2);
  const float* s1 = p.w_ff1 + (size_t)layer * 1024 * 4096;
  const float* s2 = p.w_ff2 + (size_t)layer * 4096 * 1024;
  for (int t = gridDim.x - 1 - blockIdx.x; t < 2048; t += gridDim.x) {
    if (t < 1024) tr_tile(s1, 1024, 4096, 4096, 0, nullptr, f1, t, smem);
    else tr_tile(s2, 4096, 1024, 1024, 0, nullptr, f2, t - 1024, smem);
  }
}

DI void prologue(const P& p, char* smem) {
  const int tid = otid();
  float* modv = (float*)(p.ws + OFF_MODV);
  for (int it = blockIdx.x; it < 384; it += gridDim.x) {
    float* cond = (float*)smem;
    for (int idx = tid; idx < 17 * 1024; idx += NTHR) {
      int bb = idx >> 10, k = idx & 1023;
      float v = bb < 16 ? p.c[bb * 1024 + k] : p.c_ctx[k];
      cond[idx] = v / (1.f + __expf(-v));
    }
    __syncthreads();
    const int l = it / 96, n = (it % 96) * 64 + (tid & 63), kq = tid >> 6;
    float acc[17];
#pragma unroll
    for (int i = 0; i < 17; ++i) acc[i] = 0.f;
    const float* wp = p.w_mod + ((size_t)l * 1024 + kq * 256) * 6144 + n;
#pragma unroll 4
    for (int k4 = 0; k4 < 64; ++k4) {
      float w0 = wp[(size_t)(k4 * 4 + 0) * 6144], w1 = wp[(size_t)(k4 * 4 + 1) * 6144];
      float w2 = wp[(size_t)(k4 * 4 + 2) * 6144], w3 = wp[(size_t)(k4 * 4 + 3) * 6144];
#pragma unroll
      for (int bb = 0; bb < 17; ++bb) {
        float4 c4 = *(const float4*)(cond + bb * 1024 + kq * 256 + k4 * 4);
        acc[bb] += c4.x * w0 + c4.y * w1 + c4.z * w2 + c4.w * w3;
      }
    }
    __syncthreads();
    float* red = (float*)smem;
#pragma unroll
    for (int bb = 0; bb < 17; ++bb) red[(kq * 17 + bb) * 64 + (tid & 63)] = acc[bb];
    __syncthreads();
    for (int o = tid; o < 17 * 64; o += NTHR) {
      int bb = o >> 6, nn = o & 63;
      int ncol = (it % 96) * 64 + nn;
      float s = red[(0 * 17 + bb) * 64 + nn] + red[(1 * 17 + bb) * 64 + nn] + red[(2 * 17 + bb) * 64 + nn] + red[(3 * 17 + bb) * 64 + nn];
      modv[((size_t)l * 17 + bb) * 6144 + ncol] = s + p.b_mod[l * 6144 + ncol];
    }
    __syncthreads();
  }
  {
    float* rt = (float*)(p.ws + OFF_ROPE);
    for (int idx = blockIdx.x * NTHR + tid; idx < 1024 + 512; idx += gridDim.x * NTHR) {
      if (idx < 1024) {
        int pos = idx >> 4, i = idx & 15;
        float f = powf(10000.f, -(float)(2 * i) / 32.f);
        float a = (float)pos * f;
        rt[idx] = cosf(a); rt[1024 + idx] = sinf(a);
      } else {
        int q = idx - 1024; int pos = q >> 3, i = q & 7;
        float f = powf(10000.f, -(float)(2 * i) / 16.f);
        float a = (float)pos * f;
        rt[2048 + q] = cosf(a); rt[2560 + q] = sinf(a);
      }
    }
    float2* SA = (float2*)(p.ws + OFF_SA);
    float2* SAL = (float2*)(p.ws + OFF_SAL);
    float* SBB = (float*)(p.ws + OFF_SBB);
    for (int idx = blockIdx.x * NTHR + tid; idx < 4096; idx += gridDim.x * NTHR) {
      float lre = p.lam_re[idx], lim = p.lam_im[idx];
      float dt = expf(p.log_dt[idx >> 6]);
      float mag = expf(lre * dt);
      float are = mag * cosf(lim * dt), aim = mag * sinf(lim * dt);
      float den = lre * lre + lim * lim;
      float fre = ((are - 1.f) * lre + aim * lim) / den;
      float fim = (aim * lre - (are - 1.f) * lim) / den;
      SA[idx] = make_float2(are, aim);
      float pr = are, pi = aim;
#pragma unroll
      for (int q = 0; q < 6; ++q) { float nr = pr * pr - pi * pi, ni = 2.f * pr * pi; pr = nr; pi = ni; }
      SAL[idx] = make_float2(pr, pi);
#pragma unroll
      for (int q = 0; q < 16; ++q) {
        float br = p.b_re[(size_t)idx * 16 + q], bi = p.b_im[(size_t)idx * 16 + q];
        SBB[(size_t)idx * 32 + q] = fre * br - fim * bi;
        SBB[(size_t)idx * 32 + 16 + q] = fre * bi + fim * br;
      }
    }
  }
  for (int t = gridDim.x - 1 - blockIdx.x; t < 3424; t += gridDim.x) {
    int j = t / 1712, r = t % 1712;
    if (r < 384) tr_tile(p.e_w_in + (size_t)j * 1024 * 1536, 1024, 1536, 1536, 0, nullptr, (u16*)(p.ws + OFF_EIN + j * SZ_EIN), r, smem);
    else if (r < 640) tr_tile(p.e_w_out + (size_t)j * 1024 * 1024, 1024, 1024, 1024, 0, nullptr, (u16*)(p.ws + OFF_EOUT + j * SZ_SQ), r - 384, smem);
    else if (r < 1248) tr_tile(p.o_w_in + (size_t)j * 1024 * 2336, 1024, 2336, 2432, 1, nullptr, (u16*)(p.ws + OFF_OIN + j * SZ_OIN), r - 640, smem);
    else if (r < 1504) tr_tile(p.o_w_out + (size_t)j * 1024 * 1024, 1024, 1024, 1024, 0, nullptr, (u16*)(p.ws + OFF_OOUT + j * SZ_SQ), r - 1248, smem);
    else if (r < 1632) tr_tile(p.w_uq + (size_t)j * 512 * 768, 512, 768, 1024, 2, p.g_cq + j * 512, (u16*)(p.ws + OFF_UQ + j * SZ_UQ), r - 1504, smem);
    else if (r < 1696) tr_tile(p.w_ukv + (size_t)j * 256 * 1024, 256, 1024, 1024, 0, p.g_ckv + j * 256, (u16*)(p.ws + OFF_UKV + j * SZ_UKV), r - 1632, smem);
    else tr_tile(p.w_glu + (size_t)j * 256 * 256, 256, 256, 256, 0, nullptr, (u16*)(p.ws + OFF_GLU + j * SZ_GLU), r - 1696, smem);
  }
}

DI void norm_phase(const float* __restrict__ xl, const float* __restrict__ xc, const float* __restrict__ g,
                           const float* __restrict__ modl, int shift_i, int scale_i, int nrows, u16* __restrict__ dst, float* __restrict__ psn) {
  const int tid_ = otid();
  const int lane = tid_ & 63;
  const int gw = blockIdx.x * 4 + (tid_ >> 6);
  for (int R = gw; R < nrows; R += gridDim.x * 4) {
    const float* src = R < NLAT ? xl + (size_t)R * 1024 : xc + (size_t)(R - NLAT) * 1024;
    const int mrow = R < NLAT ? (R >> 11) : 16;
    float4 v[4];
    float ss = 0.f;
#pragma unroll
    for (int i = 0; i < 4; ++i) {
      v[i] = *(const float4*)(src + lane * 4 + 256 * i);
      ss += v[i].x * v[i].x + v[i].y * v[i].y + v[i].z * v[i].z + v[i].w * v[i].w;
    }
#pragma unroll
    for (int o = 32; o >= 1; o >>= 1) ss += __shfl_xor(ss, o);
    if (lane < 8) psn[(size_t)R * 8 + lane] = lane == 0 ? ss : 0.f;
    const float* sc = modl + (size_t)mrow * 6144 + scale_i * 1024;
#pragma unroll
    for (int i = 0; i < 4; ++i) {
      int col = lane * 4 + 256 * i;
      float4 gg = *(const float4*)(g + col), c4 = *(const float4*)(sc + col);
      float y0 = v[i].x * gg.x * (1.f + c4.x);
      float y1 = v[i].y * gg.y * (1.f + c4.y);
      float y2 = v[i].z * gg.z * (1.f + c4.z);
      float y3 = v[i].w * gg.w * (1.f + c4.w);
      uint2 o2; o2.x = pack2(y0, y1); o2.y = pack2(y2, y3);
      *(uint2*)(dst + (size_t)R * 1024 + col) = o2;
    }
  }
}

DI void sw_items(const float* __restrict__ shift, const u16* __restrict__ Wt, int N, float* __restrict__ out, int ostride) {
  const int tid_ = otid();
  const int lane = tid_ & 63;
  const int gw = blockIdx.x * 4 + (tid_ >> 6);
  for (int n = gw; n < N; n += gridDim.x * 4) {
    const uint4 w0 = *(const uint4*)(Wt + (size_t)n * 1024 + lane * 16);
    const uint4 w1 = *(const uint4*)(Wt + (size_t)n * 1024 + lane * 16 + 8);
    float wf[16];
    wf[0] = __uint_as_float(w0.x << 16); wf[1] = __uint_as_float(w0.x & 0xffff0000u);
    wf[2] = __uint_as_float(w0.y << 16); wf[3] = __uint_as_float(w0.y & 0xffff0000u);
    wf[4] = __uint_as_float(w0.z << 16); wf[5] = __uint_as_float(w0.z & 0xffff0000u);
    wf[6] = __uint_as_float(w0.w << 16); wf[7] = __uint_as_float(w0.w & 0xffff0000u);
    wf[8] = __uint_as_float(w1.x << 16); wf[9] = __uint_as_float(w1.x & 0xffff0000u);
    wf[10] = __uint_as_float(w1.y << 16); wf[11] = __uint_as_float(w1.y & 0xffff0000u);
    wf[12] = __uint_as_float(w1.z << 16); wf[13] = __uint_as_float(w1.z & 0xffff0000u);
    wf[14] = __uint_as_float(w1.w << 16); wf[15] = __uint_as_float(w1.w & 0xffff0000u);
#pragma unroll 1
    for (int bb = 0; bb < 17; ++bb) {
      const float* sp = shift + (size_t)bb * 6144 + lane * 16;
      float acc = 0.f;
#pragma unroll
      for (int q = 0; q < 4; ++q) {
        float4 t = *(const float4*)(sp + 4 * q);
        acc += t.x * wf[4 * q] + t.y * wf[4 * q + 1] + t.z * wf[4 * q + 2] + t.w * wf[4 * q + 3];
      }
#pragma unroll
      for (int o = 32; o >= 1; o >>= 1) acc += __shfl_xor(acc, o);
      if (lane == 0) out[(size_t)bb * ostride + n] = acc;
    }
  }
}

enum { EPI_EVEN_IN = 0, EPI_ODD_IN, EPI_UQ, EPI_UKV, EPI_GLU, EPI_RESID, EPI_RELU2 };

struct EpiArgs {
  int j;
  const float* gate;
  const float* src_lat; const float* src_ctx; float* dst_lat; float* dst_ctx;
  const float* sw; int sw_stride;
  u16* xg_dst;
  const float* ng; const float* nscale;
};

DI void store16(u16* dst, const float* y) {
  uint4 a, b;
  a.x = pack2(y[0], y[1]); a.y = pack2(y[2], y[3]); a.z = pack2(y[4], y[5]); a.w = pack2(y[6], y[7]);
  b.x = pack2(y[8], y[9]); b.y = pack2(y[10], y[11]); b.z = pack2(y[12], y[13]); b.w = pack2(y[14], y[15]);
  *(uint4*)dst = a; *(uint4*)(dst + 8) = b;
}
DI void load16(const float* s, float* v) {
#pragma unroll
  for (int q = 0; q < 4; ++q) { float4 t = *(const float4*)(s + 4 * q); v[4 * q] = t.x; v[4 * q + 1] = t.y; v[4 * q + 2] = t.z; v[4 * q + 3] = t.w; }
}

DI void epi_head64(const P& p, const float* Cs, int b, int pos0, bool isctx, const float* __restrict__ g, bool rope,
                   u16* __restrict__ dstbase, int H, int head0) {
  const int tid = otid(), sub = tid & 7, hh = sub >> 2, jq = sub & 3;
  const float* rt = (const float*)(p.ws + OFF_ROPE);
#pragma unroll 1
  for (int pass = 0; pass < 4; ++pass) {
    const int row = pass * 32 + (tid >> 3);
    float v[16], pv[16];
    load16(Cs + row * CP + 16 * sub, v);
    float ss = 0.f;
#pragma unroll
    for (int i = 0; i < 16; ++i) ss += v[i] * v[i];
    ss += __shfl_xor(ss, 1); ss += __shfl_xor(ss, 2);
    const float rs = rsqrtf(ss * (1.f / 64.f) + EPSF);
#pragma unroll
    for (int i = 0; i < 16; ++i) v[i] = v[i] * rs * g[16 * jq + i];
    const int pos = pos0 + row;
    if (rope && !isctx) {
      load16(Cs + row * CP + 16 * (sub ^ 1), pv);
      const int lp = pos - 256;
      const int ti = (jq < 2) ? (lp >> 6) : (lp & 63);
      const float sgn = (jq & 1) ? 1.f : -1.f;
#pragma unroll
      for (int i = 0; i < 16; ++i) {
        float pn = pv[i] * rs * g[16 * (jq ^ 1) + i];
        float cs = rt[ti * 16 + i], sn = rt[1024 + ti * 16 + i];
        v[i] = v[i] * cs + sgn * pn * sn;
      }
    }
    store16(dstbase + (((size_t)b * H + head0 + hh) * SP + pos) * 64 + 16 * jq, v);
  }
}

DI void epi_vt(const float* Cs, int b, int pos0, u16* __restrict__ dstbase, int H, int head0, int c0, int ncols, float mul_unused) {
  const int tid = otid();
  const int cl = tid % ncols, tg = tid / ncols, ngrp = NTHR / ncols;
  const int col = c0 + cl;
  const int head = head0 + (cl >> 6), d = cl & 63;
  u16* drow = dstbase + (((size_t)b * H + head) * 64 + d) * SP + pos0;
  for (int tk = tg; tk < 16; tk += ngrp) {
    float y[8];
#pragma unroll
    for (int e = 0; e < 8; ++e) y[e] = Cs[(tk * 8 + e) * CP + col];
    uint4 a; a.x = pack2(y[0], y[1]); a.y = pack2(y[2], y[3]); a.z = pack2(y[4], y[5]); a.w = pack2(y[6], y[7]);
    *(uint4*)(drow + tk * 8) = a;
  }
}

template <int EPI>
DI void epilogue(const P& p, const EpiArgs& ea, float* Cs, int mtile, int ntile) {
  const int tid = otid();
  const int m0 = mtile * 128, n0 = ntile * 128;
  const bool isctx = m0 >= NLAT;
  const int b = isctx ? ((m0 - NLAT) >> 8) : (m0 >> 11);
  const int pos0 = isctx ? ((m0 - NLAT) & 255) : 256 + (m0 & 2047);
  const int mrow = isctx ? 16 : b;
  char* ws = p.ws;
  if (EPI == EPI_RESID) {
    const int c4 = (tid & 31) * 4;
    const int n = n0 + c4;
    const int R0 = m0 + (tid >> 5);
    const float* src = (isctx ? ea.src_ctx + (size_t)(R0 - NLAT) * 1024 : ea.src_lat + (size_t)R0 * 1024) + n;
    float* dst = (isctx ? ea.dst_ctx + (size_t)(R0 - NLAT) * 1024 : ea.dst_lat + (size_t)R0 * 1024) + n;
    const float4 gv = *(const float4*)(ea.gate + (size_t)mrow * 6144 + n);
    float4 gmv = make_float4(0.f, 0.f, 0.f, 0.f);
    if (ea.ng) {
      float4 g4 = *(const float4*)(ea.ng + n), s4 = *(const float4*)(ea.nscale + (size_t)mrow * 6144 + n);
      gmv.x = g4.x * (1.f + s4.x); gmv.y = g4.y * (1.f + s4.y); gmv.z = g4.z * (1.f + s4.z); gmv.w = g4.w * (1.f + s4.w);
    }
    float4 xv[16];
#pragma unroll
    for (int pass = 0; pass < 16; ++pass) xv[pass] = *(const float4*)(src + (size_t)pass * 8 * 1024);
#pragma unroll
    for (int pass = 0; pass < 16; ++pass) {
      const int row = pass * 8 + (tid >> 5);
      float4 a = *(const float4*)(Cs + row * CP + c4);
      float4 o; o.x = xv[pass].x + gv.x * a.x; o.y = xv[pass].y + gv.y * a.y; o.z = xv[pass].z + gv.z * a.z; o.w = xv[pass].w + gv.w * a.w;
      *(float4*)(dst + (size_t)pass * 8 * 1024) = o;
      if (ea.ng) {
        float ss = o.x * o.x + o.y * o.y + o.z * o.z + o.w * o.w;
#pragma unroll
        for (int q = 16; q >= 1; q >>= 1) ss += __shfl_xor(ss, q);
        const int R = m0 + row;
        if ((tid & 31) == 0) ((float*)(ws + OFF_PSN))[(size_t)R * 8 + ntile] = ss;
        uint2 xo; xo.x = pack2(o.x * gmv.x, o.y * gmv.y); xo.y = pack2(o.z * gmv.z, o.w * gmv.w);
        *(uint2*)(ea.xg_dst + (size_t)R * 1024 + n) = xo;
      }
    }
  } else if (EPI == EPI_RELU2 || EPI == EPI_GLU) {
    const int c4 = (tid & 31) * 4;
    const int n = n0 + c4;
#pragma unroll 4
    for (int pass = 0; pass < 16; ++pass) {
      const int row = pass * 8 + (tid >> 5);
      const int R = m0 + row;
      float4 a = *(const float4*)(Cs + row * CP + c4);
      if (EPI == EPI_RELU2) {
        float r0 = fmaxf(a.x, 0.f), r1 = fmaxf(a.y, 0.f), r2 = fmaxf(a.z, 0.f), r3 = fmaxf(a.w, 0.f);
        uint2 o; o.x = pack2(r0 * r0, r1 * r1); o.y = pack2(r2 * r2, r3 * r3);
        *(uint2*)((u16*)(ws + OFF_H) + (size_t)R * 4096 + n) = o;
      } else {
        const u16* yg = (const u16*)(ws + E_YG) + (size_t)R * 256 + n;
        uint2 yv = *(const uint2*)yg;
        float4 bg = *(const float4*)(p.b_glu + ea.j * 256 + n);
        float y0 = __uint_as_float(yv.x << 16), y1 = __uint_as_float(yv.x & 0xffff0000u);
        float y2 = __uint_as_float(yv.y << 16), y3 = __uint_as_float(yv.y & 0xffff0000u);
        float o0 = y0 / (1.f + __expf(-(a.x + bg.x))), o1 = y1 / (1.f + __expf(-(a.y + bg.y)));
        float o2 = y2 / (1.f + __expf(-(a.z + bg.z))), o3 = y3 / (1.f + __expf(-(a.w + bg.w)));
        uint2 o; o.x = pack2(o0, o1); o.y = pack2(o2, o3);
        *(uint2*)((u16*)(ws + OFF_ABUF) + (size_t)R * 1024 + 768 + n) = o;
      }
    }
  } else if (EPI == EPI_EVEN_IN) {
    if (ntile < 6) epi_head64(p, Cs, b, pos0, isctx, p.e_g_q + ea.j * 64, true, (u16*)(ws + E_Q), 12, ntile * 2);
    else if (ntile < 8) epi_head64(p, Cs, b, pos0, isctx, p.e_g_k + ea.j * 64, true, (u16*)(ws + E_K), 4, (ntile - 6) * 2);
    else if (ntile < 10) epi_vt(Cs, b, pos0, (u16*)(ws + E_VT), 4, (ntile - 8) * 2, 0, 128, 1.f);
    else {
      const int c4 = (tid & 31) * 4;
      float* U = (float*)(ws + E_U);
      for (int pass = 0; pass < 16; ++pass) {
        const int row = pass * 8 + (tid >> 5);
        *(float4*)(U + (size_t)(m0 + row) * 256 + (ntile - 10) * 128 + c4) = *(const float4*)(Cs + row * CP + c4);
      }
    }
  } else if (EPI == EPI_ODD_IN) {
    if (ntile < 6) {
      const int c4 = (tid & 31) * 4;
      float* PS = (float*)(ws + O_PS);
      for (int pass = 0; pass < 16; ++pass) {
        const int row = pass * 8 + (tid >> 5);
        const int R = m0 + row;
        float4 a = *(const float4*)(Cs + row * CP + c4);
        float ss = a.x * a.x + a.y * a.y + a.z * a.z + a.w * a.w;
#pragma unroll
        for (int o = 16; o >= 1; o >>= 1) ss += __shfl_xor(ss, o);
        if ((tid & 31) == 0) PS[(size_t)R * 8 + ntile] = ss;
        uint2 o; o.x = pack2(a.x, a.y); o.y = pack2(a.z, a.w);
        if (ntile < 4) *(uint2*)((u16*)(ws + O_CQ) + (size_t)R * 512 + n0 + c4) = o;
        else *(uint2*)((u16*)(ws + O_CKV) + (size_t)R * 256 + (n0 - 512) + c4) = o;
      }
    } else if (ntile < 10) epi_head64(p, Cs, b, pos0, isctx, p.g_nq + ea.j * 64, false, (u16*)(ws + O_NQ), 8, (ntile - 6) * 2);
    else if (ntile < 14) epi_head64(p, Cs, b, pos0, isctx, p.g_nk + ea.j * 64, false, (u16*)(ws + O_NK), 8, (ntile - 10) * 2);
    else if (ntile < 18) epi_vt(Cs, b, pos0, (u16*)(ws + O_NVT), 8, (ntile - 14) * 2, 0, 128, 1.f);
    else {
      float* KR = (float*)(ws + O_KR);
      const int c4 = (tid & 7) * 4;
      for (int pass = 0; pass < 4; ++pass) {
        const int row = pass * 32 + (tid >> 3);
        *(float4*)(KR + (size_t)(m0 + row) * 32 + c4) = *(const float4*)(Cs + row * CP + c4);
      }
    }
  } else if (EPI == EPI_UQ || EPI == EPI_UKV) {
    const int sub = tid & 7;
    const float* PS = (const float*)(ws + O_PS);
    const float* rt = (const float*)(ws + OFF_ROPE);
    const float* gm = (EPI == EPI_UQ ? p.g_mq : p.g_mk) + ea.j * 96;
    u16* dstb = (u16*)(ws + (EPI == EPI_UQ ? O_MQ : O_MK));
    const float* KR = (const float*)(ws + O_KR);
#pragma unroll 1
    for (int pass = 0; pass < 4; ++pass) {
      const int row = pass * 32 + (tid >> 3);
      const int R = m0 + row;
      float rstd;
      if (EPI == EPI_UQ) {
        float4 ps = *(const float4*)(PS + (size_t)R * 8);
        rstd = rsqrtf((ps.x + ps.y + ps.z + ps.w) * (1.f / 512.f) + EPSF);
      } else {
        float2 ps = *(const float2*)(PS + (size_t)R * 8 + 4);
        rstd = rsqrtf((ps.x + ps.y) * (1.f / 256.f) + EPSF);
      }
      float v[16];
      if (EPI == EPI_UQ) {
        load16(Cs + row * CP + 16 * sub, v);
#pragma unroll
        for (int i = 0; i < 16; ++i) v[i] *= rstd;
      } else {
        if (sub < 4) {
          load16(Cs + row * CP + 16 * sub, v);
#pragma unroll
          for (int i = 0; i < 16; ++i) v[i] *= rstd;
        } else if (sub < 6) {
          load16(KR + (size_t)R * 32 + 16 * (sub - 4), v);
        } else {
#pragma unroll
          for (int i = 0; i < 16; ++i) v[i] = 0.f;
        }
      }
      float ss = 0.f;
#pragma unroll
      for (int i = 0; i < 16; ++i) ss += v[i] * v[i];
      ss += __shfl_xor(ss, 1); ss += __shfl_xor(ss, 2); ss += __shfl_xor(ss, 4);
      const float rs = rsqrtf(ss * (1.f / 96.f) + EPSF);
      if (sub < 6) {
#pragma unroll
        for (int i = 0; i < 16; ++i) v[i] = v[i] * rs * gm[16 * sub + i];
        const int pos = pos0 + row;
        if (sub >= 4 && !isctx) {
          const int lp = pos - 256;
          const int ti = (sub == 4) ? (lp >> 6) : (lp & 63);
#pragma unroll
          for (int i = 0; i < 8; ++i) {
            float cs = rt[2048 + ti * 8 + i], sn = rt[2560 + ti * 8 + i];
            float x1 = v[i], x2 = v[i + 8];
            v[i] = x1 * cs - x2 * sn;
            v[i + 8] = x2 * cs + x1 * sn;
          }
        }
        store16(dstb + (((size_t)b * 8 + ntile) * SP + pos) * 96 + 16 * sub, v);
      }
    }
    if (EPI == EPI_UKV) {
      const int cl = tid & 63, tg = tid >> 6;
      u16* drow = (u16*)(ws + O_MVT) + (((size_t)b * 8 + ntile) * 64 + cl) * SP + pos0;
      for (int tk = tg; tk < 16; tk += 4) {
        float y[8];
#pragma unroll
        for (int e = 0; e < 8; ++e) {
          const int R = m0 + tk * 8 + e;
          float2 ps = *(const float2*)(PS + (size_t)R * 8 + 4);
          float rstd = rsqrtf((ps.x + ps.y) * (1.f / 256.f) + EPSF);
          y[e] = Cs[(tk * 8 + e) * CP + 64 + cl] * rstd;
        }
        uint4 a; a.x = pack2(y[0], y[1]); a.y = pack2(y[2], y[3]); a.z = pack2(y[4], y[5]); a.w = pack2(y[6], y[7]);
        *(uint4*)(drow + tk * 8) = a;
      }
    }
  }
}

template <int EPI, int PROBE = 0>
DI void gemm_phase(const P& p, const u16* __restrict__ A, const u16* __restrict__ Bt, int K, int mt, int ntn, int band,
                           const EpiArgs& ea, char* smem) {
  const int tid = otid(), lane = tid & 63, w = tid >> 6, wm = w >> 1, wn = w & 1, r = lane & 31, h = lane >> 5;
  u16* As = (u16*)smem;
  u16* Bs = As + 2 * 9216;
  float* Cs = (float*)smem;
  const int total = mt * ntn;
  const int mper = mt >> 3;
  const int nk = K >> 6;
  const int lrow = tid >> 3, lkc = (tid & 7) * 8;
  for (int t = blockIdx.x; t < total; t += gridDim.x) {
    const int xcd = t & 7, L = t >> 3;
    const int bandsz = band * ntn;
    const int bi = L / bandsz, rr = L - bi * bandsz;
    const int full = (ntn >> 3) * (band * 8);
    int mi_, ni_;
    if (rr < full) { int ch = rr / (band * 8); int wv = rr - ch * (band * 8); mi_ = wv % band; ni_ = ch * 8 + wv / band; }
    else { int r2 = rr - full; mi_ = r2 % band; ni_ = (ntn >> 3) * 8 + r2 / band; }
    const int mtile = xcd * mper + bi * band + mi_;
    const int ntile = ni_;
    constexpr bool AFF = (EPI == EPI_EVEN_IN || EPI == EPI_ODD_IN || EPI == EPI_RELU2);
    float* rsb = (float*)(smem + 73728);
    if (AFF && tid < 128) {
      const float* ps = (const float*)(p.ws + OFF_PSN) + (size_t)(mtile * 128 + tid) * 8;
      float4 p0 = *(const float4*)ps, p1 = *(const float4*)(ps + 4);
      rsb[tid] = rsqrtf((p0.x + p0.y + p0.z + p0.w + p1.x + p1.y + p1.z + p1.w) * (1.f / 1024.f) + EPSF);
    }
    const u16* Ag = A + (size_t)(mtile * 128 + lrow) * K + lkc;
    const u16* Bg = Bt + (size_t)(ntile * 128 + lrow) * K + lkc;
    f32x16 acc[2][2];
#pragma unroll
    for (int a = 0; a < 2; ++a)
#pragma unroll
      for (int c = 0; c < 2; ++c)
#pragma unroll
        for (int i = 0; i < 16; ++i) acc[a][c][i] = 0.f;
    uint4 ra0_0, ra0_1, ra0_2, ra0_3, rb0_0, rb0_1, rb0_2, rb0_3, ra1_0, ra1_1, ra1_2, ra1_3, rb1_0, rb1_1, rb1_2, rb1_3;
#define G_LD1(S, i, kt_) ra##S##_##i = *(const uint4*)(Ag + (size_t)(32 * i) * K + (kt_) * 64); rb##S##_##i = *(const uint4*)(Bg + (size_t)(32 * i) * K + (kt_) * 64);
#define G_LOAD(S, kt_) { G_LD1(S, 0, kt_) G_LD1(S, 1, kt_) G_LD1(S, 2, kt_) G_LD1(S, 3, kt_) }
#define L_ST1(S, i, buf_) *(uint4*)(As + (buf_) * 9216 + (lrow + 32 * i) * 72 + lkc) = ra##S##_##i; *(uint4*)(Bs + (buf_) * 9216 + (lrow + 32 * i) * 72 + lkc) = rb##S##_##i;
#define L_STORE(S, buf_) { L_ST1(S, 0, buf_) L_ST1(S, 1, buf_) L_ST1(S, 2, buf_) L_ST1(S, 3, buf_) }
#define G_COMPUTE(buf_) { \
      const u16* as = As + (buf_) * 9216 + (wm * 64 + r) * 72 + h * 8; \
      const u16* bs = Bs + (buf_) * 9216 + (wn * 64 + r) * 72 + h * 8; \
      _Pragma("unroll") for (int kk = 0; kk < 4; ++kk) { \
        bf16x8 a0 = *(const bf16x8*)(as + kk * 16), a1 = *(const bf16x8*)(as + 32 * 72 + kk * 16); \
        bf16x8 b0 = *(const bf16x8*)(bs + kk * 16), b1 = *(const bf16x8*)(bs + 32 * 72 + kk * 16); \
        acc[0][0] = MFMA32(a0, b0, acc[0][0]); acc[0][1] = MFMA32(a0, b1, acc[0][1]); \
        acc[1][0] = MFMA32(a1, b0, acc[1][0]); acc[1][1] = MFMA32(a1, b1, acc[1][1]); } }
#define LDFRAG(P_, kk) P_##a0 = *(const bf16x8*)(as_ + (kk) * 16); P_##a1 = *(const bf16x8*)(as_ + 32 * 72 + (kk) * 16); \
                       P_##b0 = *(const bf16x8*)(bs_ + (kk) * 16); P_##b1 = *(const bf16x8*)(bs_ + 32 * 72 + (kk) * 16);
#define MFMA4(P_) acc[0][0] = MFMA32(P_##a0, P_##b0, acc[0][0]); acc[0][1] = MFMA32(P_##a0, P_##b1, acc[0][1]); \
                  acc[1][0] = MFMA32(P_##a1, P_##b0, acc[1][0]); acc[1][1] = MFMA32(P_##a1, P_##b1, acc[1][1]);
#define G_PIPE(buf_, SNEXT, nbuf_, dost_) { \
      const u16* as_ = As + (buf_) * 9216 + (wm * 64 + r) * 72 + h * 8; \
      const u16* bs_ = Bs + (buf_) * 9216 + (wn * 64 + r) * 72 + h * 8; \
      bf16x8 f_a0, f_a1, f_b0, f_b1, g_a0, g_a1, g_b0, g_b1; \
      LDFRAG(f_, 0) \
      LDFRAG(g_, 1) \
      __builtin_amdgcn_sched_barrier(0); \
      MFMA4(f_) if (dost_) { L_ST1(SNEXT, 0, nbuf_) } \
      __builtin_amdgcn_sched_barrier(0); \
      LDFRAG(f_, 2) \
      MFMA4(g_) if (dost_) { L_ST1(SNEXT, 1, nbuf_) } \
      __builtin_amdgcn_sched_barrier(0); \
      LDFRAG(g_, 3) \
      MFMA4(f_) if (dost_) { L_ST1(SNEXT, 2, nbuf_) } \
      __builtin_amdgcn_sched_barrier(0); \
      MFMA4(g_) if (dost_) { L_ST1(SNEXT, 3, nbuf_) } }
#define G_COMPUTE_NOLDS() { \
      _Pragma("unroll") for (int kk = 0; kk < 4; ++kk) { \
        acc[0][0] = MFMA32(pa0, pb0, acc[0][0]); acc[0][1] = MFMA32(pa0, pb1, acc[0][1]); \
        acc[1][0] = MFMA32(pa1, pb0, acc[1][0]); acc[1][1] = MFMA32(pa1, pb1, acc[1][1]); } }
    bf16x8 pa0 = *(const bf16x8*)(As + r * 72 + h * 8), pa1 = *(const bf16x8*)(As + (32 + r) * 72 + h * 8);
    bf16x8 pb0 = *(const bf16x8*)(Bs + r * 72 + h * 8), pb1 = *(const bf16x8*)(Bs + (32 + r) * 72 + h * 8);
    (void)pa0; (void)pa1; (void)pb0; (void)pb1;
    G_LOAD(0, 0);
    G_LOAD(1, 1);
    L_STORE(0, 0);
    __syncthreads();
    for (int kt = 0; kt < nk; kt += 2) {
      if (kt + 2 < nk) { G_LOAD(0, kt + 2); }
      { G_PIPE(0, 1, 1, true) }
      __syncthreads();
      if (kt + 3 < nk) { G_LOAD(1, kt + 3); }
      { const bool st_ = kt + 2 < nk; G_PIPE(1, 0, 0, st_) }
      __syncthreads();
    }
    if (AFF) {
      const int mrow_ = (mtile * 128 >= NLAT) ? 16 : ((mtile * 128) >> 11);
#pragma unroll
      for (int c = 0; c < 2; ++c) {
        const float swc = ea.sw[(size_t)mrow_ * ea.sw_stride + ntile * 128 + wn * 64 + c * 32 + r];
#pragma unroll
        for (int a = 0; a < 2; ++a)
#pragma unroll
          for (int i = 0; i < 16; ++i) {
            const int row = wm * 64 + a * 32 + (i & 3) + 8 * (i >> 2) + 4 * h;
            Cs[row * CP + wn * 64 + c * 32 + r] = acc[a][c][i] * rsb[row] + swc;
          }
      }
    } else {
#pragma unroll
      for (int a = 0; a < 2; ++a)
#pragma unroll
        for (int c = 0; c < 2; ++c)
#pragma unroll
          for (int i = 0; i < 16; ++i)
            Cs[(wm * 64 + a * 32 + (i & 3) + 8 * (i >> 2) + 4 * h) * CP + wn * 64 + c * 32 + r] = acc[a][c][i];
    }
    __syncthreads();
    epilogue<EPI>(p, ea, Cs, mtile, ntile);
    __syncthreads();
  }
}

template <int DQK, bool NA>
DI void attn_phase(const u16* __restrict__ Q, const u16* __restrict__ Kb, const u16* __restrict__ Vt, int HQ, int HK,
                           float scale, u16* __restrict__ mix, int coloff, bool do_ctx, const float* __restrict__ rpb, char* smem) {
  constexpr int KP = DQK + 8;
  constexpr int NKK = DQK / 16;
  constexpr int KCH = DQK / 32;
  const int tid = otid(), lane = tid & 63, w = tid >> 6, r = lane & 31, h = lane >> 5;
  constexpr int STG = 64 * KP * 2 + 64 * 72 * 2;
  float* rpbs = (float*)(smem + 2 * STG);
  const int grp_heads = HQ / HK;
  const int nlat = 16 * HK * grp_heads * 16;
  const int total = nlat + (do_ctx ? 16 * HK * grp_heads * 2 : 0);
  const float sl2 = scale * LOG2E;
  for (int u = blockIdx.x; u < total; u += gridDim.x) {
    const bool lat = u < nlat;
    const int v_ = lat ? u : u - nlat;
    const int nq_ = lat ? 16 : 2;
    const int upg = grp_heads * nq_;
    const int xcd = v_ & 7, L = v_ >> 3;
    const int grp = (L / upg) * 8 + xcd, wi = L % upg;
    const int b = grp / HK, hk = grp % HK;
    const int hq = hk * grp_heads + wi / nq_, qb = wi % nq_;
    const int qpos0 = lat ? 256 + 128 * qb : 128 * qb;
    int ntiles = lat ? 36 : 4;
    int rs0 = 0, rw = 0, rsw = 0;
    if (NA && lat) {
      int r0 = 2 * qb;
      rs0 = min(max(r0 - 4, 0), 24);
      int rs1 = min(max(r0 + 1 - 4, 0), 24);
      ntiles = 4 + (rs1 + 8 - rs0);
      rw = r0 + (w >> 1);
      rsw = min(max(rw - 4, 0), 24);
    }
    const int qpos = qpos0 + w * 32 + r;
    bf16x8 qf[NKK];
    {
      const u16* qp = Q + (((size_t)b * HQ + hq) * SP + qpos) * DQK + 8 * h;
#pragma unroll
      for (int kk = 0; kk < NKK; ++kk) qf[kk] = *(const bf16x8*)(qp + 16 * kk);
    }
    f32x16 o0, o1;
#pragma unroll
    for (int i = 0; i < 16; ++i) { o0[i] = 0.f; o1[i] = 0.f; }
    float m = -1e30f, l = 0.f;
    const u16* kbase = Kb + ((size_t)b * HK + hk) * SP * DQK;
    const u16* vbase = Vt + ((size_t)b * HK + hk) * 64 * SP;
    uint4 rk0, rk1, rk2 = make_uint4(0, 0, 0, 0), rv0, rv1;
#define KPOS_OF(i) ((NA && lat && (i) >= 4) ? 256 + 64 * (rs0 + (i) - 4) : 64 * (i))
#define ATT_GLOAD(kp) do { \
      rk0 = *(const uint4*)(kbase + (size_t)(kp) * DQK + tid * 8); \
      rk1 = *(const uint4*)(kbase + (size_t)(kp) * DQK + (tid + 256) * 8); \
      if (KCH > 2) rk2 = *(const uint4*)(kbase + (size_t)(kp) * DQK + (tid + 512) * 8); \
      rv0 = *(const uint4*)(vbase + (size_t)(tid >> 3) * SP + (kp) + (tid & 7) * 8); \
      rv1 = *(const uint4*)(vbase + (size_t)((tid >> 3) + 32) * SP + (kp) + (tid & 7) * 8); } while (0)
#define ATT_LSTORE(buf_) do { u16* Ks_ = (u16*)(smem + (buf_) * STG); u16* Vs_ = (u16*)(smem + (buf_) * STG + 64 * KP * 2); \
      { int c = tid; *(uint4*)(Ks_ + (c / (DQK / 8)) * KP + (c % (DQK / 8)) * 8) = rk0; } \
      { int c = tid + 256; *(uint4*)(Ks_ + (c / (DQK / 8)) * KP + (c % (DQK / 8)) * 8) = rk1; } \
      if (KCH > 2) { int c = tid + 512; *(uint4*)(Ks_ + (c / (DQK / 8)) * KP + (c % (DQK / 8)) * 8) = rk2; } \
      *(uint4*)(Vs_ + (tid >> 3) * 72 + (tid & 7) * 8) = rv0; \
      *(uint4*)(Vs_ + ((tid >> 3) + 32) * 72 + (tid & 7) * 8) = rv1; } while (0)
    { const int kp0 = KPOS_OF(0); ATT_GLOAD(kp0); }
    __syncthreads();
    ATT_LSTORE(0);
    if (NA) { for (int q = tid; q < 465; q += NTHR) rpbs[q] = rpb[hq * 465 + q]; }
    if (ntiles > 1) { const int kp1 = KPOS_OF(1); ATT_GLOAD(kp1); }
    __syncthreads();
    for (int ti = 0; ti < ntiles; ++ti) {
      if (ti + 1 < ntiles) ATT_LSTORE((ti + 1) & 1);
      if (ti + 2 < ntiles) { const int kp2 = KPOS_OF(ti + 2); ATT_GLOAD(kp2); }
      const u16* Ks = (const u16*)(smem + (ti & 1) * STG);
      const u16* Vs = (const u16*)(smem + (ti & 1) * STG + 64 * KP * 2);
      bool active = true;
      int jrow = 0;
      if (NA && lat && ti >= 4) { jrow = rs0 + ti - 4; active = (jrow >= rsw) && (jrow < rsw + 8); }
      if (active) {
        f32x16 s0, s1;
#pragma unroll
        for (int i = 0; i < 16; ++i) { s0[i] = 0.f; s1[i] = 0.f; }
#pragma unroll
        for (int kk = 0; kk < NKK; ++kk) {
          bf16x8 k0 = *(const bf16x8*)(Ks + r * KP + 16 * kk + 8 * h);
          bf16x8 k1 = *(const bf16x8*)(Ks + (32 + r) * KP + 16 * kk + 8 * h);
          s0 = MFMA32(k0, qf[kk], s0);
          s1 = MFMA32(k1, qf[kk], s1);
        }
        if (NA && lat && ti >= 4) {
          const int qc = (w & 1) * 32 + r;
          const int cs = min(max(qc - 8, 0), 48);
          const float* brow = rpbs + (jrow - rw + 7) * 31 + (15 - qc);
#pragma unroll
          for (int i = 0; i < 16; ++i) {
            int kc0 = (i & 3) + 8 * (i >> 2) + 4 * h, kc1 = kc0 + 32;
            bool v0 = (kc0 >= cs) && (kc0 < cs + 16), v1 = (kc1 >= cs) && (kc1 < cs + 16);
            float b0 = v0 ? brow[kc0] : 0.f, b1 = v1 ? brow[kc1] : 0.f;
            s0[i] = v0 ? (s0[i] * sl2 + b0 * LOG2E) : -1e30f;
            s1[i] = v1 ? (s1[i] * sl2 + b1 * LOG2E) : -1e30f;
          }
        }
        const float sc = (NA && lat && ti >= 4) ? 1.f : sl2;
        float tm = s0[0];
#pragma unroll
        for (int i = 1; i < 16; ++i) tm = fmaxf(tm, s0[i]);
#pragma unroll
        for (int i = 0; i < 16; ++i) tm = fmaxf(tm, s1[i]);
        tm = fmaxf(tm, __shfl_xor(tm, 32)) * sc;
        if (__any(tm > m + 8.f)) {
          const float mn = fmaxf(m, tm);
          const float alpha = __builtin_amdgcn_exp2f(m - mn);
          m = mn;
          l *= alpha;
#pragma unroll
          for (int i = 0; i < 16; ++i) { o0[i] *= alpha; o1[i] *= alpha; }
        }
        float ps = 0.f;
#pragma unroll
        for (int i = 0; i < 16; ++i) {
          s0[i] = __builtin_amdgcn_exp2f(__builtin_fmaf(s0[i], sc, -m)); ps += s0[i];
          s1[i] = __builtin_amdgcn_exp2f(__builtin_fmaf(s1[i], sc, -m)); ps += s1[i];
        }
        l += ps;
#pragma unroll
        for (int kt = 0; kt < 2; ++kt) {
#pragma unroll
          for (int sp = 0; sp < 2; ++sp) {
            u32x4 pu;
            pu[0] = pack2(kt ? s1[8 * sp + 0] : s0[8 * sp + 0], kt ? s1[8 * sp + 1] : s0[8 * sp + 1]);
            pu[1] = pack2(kt ? s1[8 * sp + 2] : s0[8 * sp + 2], kt ? s1[8 * sp + 3] : s0[8 * sp + 3]);
            pu[2] = pack2(kt ? s1[8 * sp + 4] : s0[8 * sp + 4], kt ? s1[8 * sp + 5] : s0[8 * sp + 5]);
            pu[3] = pack2(kt ? s1[8 * sp + 6] : s0[8 * sp + 6], kt ? s1[8 * sp + 7] : s0[8 * sp + 7]);
            const bf16x8 pfv = __builtin_bit_cast(bf16x8, pu);
            const int ko = 32 * kt + 16 * sp + 4 * h;
            const uint2 a0 = *(const uint2*)(Vs + r * 72 + ko), a1 = *(const uint2*)(Vs + r * 72 + ko + 8);
            const uint2 c0 = *(const uint2*)(Vs + (32 + r) * 72 + ko), c1 = *(const uint2*)(Vs + (32 + r) * 72 + ko + 8);
            u32x4 vau, vbu;
            vau[0] = a0.x; vau[1] = a0.y; vau[2] = a1.x; vau[3] = a1.y;
            vbu[0] = c0.x; vbu[1] = c0.y; vbu[2] = c1.x; vbu[3] = c1.y;
            const bf16x8 vav = __builtin_bit_cast(bf16x8, vau), vbv = __builtin_bit_cast(bf16x8, vbu);
            o0 = MFMA32(vav, pfv, o0);
            o1 = MFMA32(vbv, pfv, o1);
          }
        }
      }
      __syncthreads();
    }
    l += __shfl_xor(l, 32);
    const float inv = 1.f / l;
    const int R = tok_row(b, qpos);
    u16* op = mix + (size_t)R * 1024 + coloff + hq * 64 + 4 * h;
#pragma unroll
    for (int g4 = 0; g4 < 4; ++g4) {
      uint2 a, c;
      a.x = pack2(o0[4 * g4] * inv, o0[4 * g4 + 1] * inv); a.y = pack2(o0[4 * g4 + 2] * inv, o0[4 * g4 + 3] * inv);
      c.x = pack2(o1[4 * g4] * inv, o1[4 * g4 + 1] * inv); c.y = pack2(o1[4 * g4 + 2] * inv, o1[4 * g4 + 3] * inv);
      *(uint2*)(op + 8 * g4) = a;
      *(uint2*)(op + 32 + 8 * g4) = c;
    }
  }
  __syncthreads();
}

DI void s5_bfrags(const float* __restrict__ SBB, int tbase, int lane, bf16x8* bfrag) {
  const int col = lane & 15, fq = lane >> 4;
#pragma unroll
  for (int nt = 0; nt < 8; ++nt) {
    const float* src = SBB + (size_t)(tbase + 16 * (nt & 3) + col) * 32 + (nt >> 2) * 16 + 8 * (fq & 1);
    float4 t0 = *(const float4*)src, t1 = *(const float4*)(src + 4);
    u32x4 cu;
    cu[0] = pack2(t0.x, t0.y); cu[1] = pack2(t0.z, t0.w); cu[2] = pack2(t1.x, t1.y); cu[3] = pack2(t1.z, t1.w);
    bfrag[nt] = __builtin_bit_cast(bf16x8, cu);
  }
}
DI void s5_bu16(const float* __restrict__ urow, int lane, const bf16x8* bfrag, float* Bus) {
  const int col = lane & 15, fq = lane >> 4;
  float4 u0 = *(const float4*)(urow + 8 * (fq & 1)), u1 = *(const float4*)(urow + 8 * (fq & 1) + 4);
  float uv[8] = {u0.x, u0.y, u0.z, u0.w, u1.x, u1.y, u1.z, u1.w};
  u32x4 au;
#pragma unroll
  for (int q = 0; q < 4; ++q) {
    float h0 = bf2f(f2bf(uv[2 * q])), h1 = bf2f(f2bf(uv[2 * q + 1]));
    float x0 = fq < 2 ? uv[2 * q] : uv[2 * q] - h0;
    float x1 = fq < 2 ? uv[2 * q + 1] : uv[2 * q + 1] - h1;
    au[q] = pack2(x0, x1);
  }
  const bf16x8 af = __builtin_bit_cast(bf16x8, au);
  f32x4 a0 = {0.f, 0.f, 0.f, 0.f}, a1 = a0, a2 = a0, a3 = a0, a4 = a0, a5 = a0, a6 = a0, a7 = a0;
  a0 = MFMA16(af, bfrag[0], a0); a1 = MFMA16(af, bfrag[1], a1); a2 = MFMA16(af, bfrag[2], a2); a3 = MFMA16(af, bfrag[3], a3);
  a4 = MFMA16(af, bfrag[4], a4); a5 = MFMA16(af, bfrag[5], a5); a6 = MFMA16(af, bfrag[6], a6); a7 = MFMA16(af, bfrag[7], a7);
  asm volatile("s_nop 15\n\ts_nop 15" : "+v"(a0), "+v"(a1), "+v"(a2), "+v"(a3), "+v"(a4), "+v"(a5), "+v"(a6), "+v"(a7));
#define BUS_ST(nt_, A_) _Pragma("unroll") for (int jj = 0; jj < 4; ++jj) Bus[(4 * fq + jj) * 132 + 16 * (nt_) + col] = A_[jj];
  BUS_ST(0, a0) BUS_ST(1, a1) BUS_ST(2, a2) BUS_ST(3, a3) BUS_ST(4, a4) BUS_ST(5, a5) BUS_ST(6, a6) BUS_ST(7, a7)
}

DI void s5_pass1(const P& p, int j, char* smem) {
  const int tid = otid(), lane = tid & 63, w = tid >> 6;
  const float* U = (const float*)(p.ws + E_U);
  float2* E = (float2*)(p.ws + E_E);
  const float2* SA = (const float2*)(p.ws + OFF_SA);
  const float* SBB = (const float*)(p.ws + OFF_SBB);
  float* Bus = (float*)(smem + w * 16896);
  for (int item = blockIdx.x; item < 4608; item += gridDim.x) {
    const int unit = item * 4 + w;
    const int c = unit % 36; const int t1 = unit / 36; const int dir = t1 & 1; const int t2 = t1 >> 1; const int g = t2 & 15; const int b = t2 >> 4;
    const int tbase = ((j * 2 + dir) * 16 + g) * 64;
    const float2 a = SA[tbase + lane];
    bf16x8 bfrag[8];
    s5_bfrags(SBB, tbase, lane, bfrag);
    float hr = 0.f, hi = 0.f;
#pragma unroll 1
    for (int sub = 0; sub < 4; ++sub) {
      const int tau = 64 * c + sub * 16 + (lane & 15);
      const int pos = dir ? (tau < 256 ? 255 - tau : 2559 - tau) : tau;
      s5_bu16(U + (size_t)tok_row(b, pos) * 256 + 16 * g, lane, bfrag, Bus);
      asm volatile("s_waitcnt lgkmcnt(0)" ::: "memory");
#pragma unroll
      for (int k16 = 0; k16 < 16; ++k16) {
        const float bur = Bus[k16 * 132 + lane], bui = Bus[k16 * 132 + 64 + lane];
        const float nr = a.x * hr - a.y * hi + bur;
        const float ni = a.x * hi + a.y * hr + bui;
        hr = nr; hi = ni;
      }
      asm volatile("s_waitcnt lgkmcnt(0)" ::: "memory");
    }
    E[((((size_t)b * 16 + g) * 2 + dir) * 36 + c) * 64 + lane] = make_float2(hr, hi);
  }
  __syncthreads();
}

DI void s5_pass2(const P& p, int j, char* smem) {
  const int tid = otid(), lane = tid & 63, w = tid >> 6;
  const float* U = (const float*)(p.ws + E_U);
  const float2* E = (const float2*)(p.ws + E_E);
  const float2* SA = (const float2*)(p.ws + OFF_SA);
  const float2* SAL = (const float2*)(p.ws + OFF_SAL);
  const float* SBB = (const float*)(p.ws + OFF_SBB);
  u16* YG = (u16*)(p.ws + E_YG);
  char* wb = smem + w * 16896;
  float* Bus = (float*)wb; u16* Hs = (u16*)(wb + 8448); float* ys = (float*)(wb + 8448 + 4352);
  const int pcol = lane & 15, fq = lane >> 4;
  for (int item = blockIdx.x; item < 4608; item += gridDim.x) {
    const int Pc = item % 36; const int t1 = item / 36; const int gp = t1 & 7; const int b = t1 >> 3;
    const int g = gp * 2 + (w >> 1), dir = w & 1;
    const int tbase = ((j * 2 + dir) * 16 + g) * 64;
    const float2 a = SA[tbase + lane], aL = SAL[tbase + lane];
    bf16x8 bfrag[8];
    s5_bfrags(SBB, tbase, lane, bfrag);
    const int c = dir ? (Pc < 4 ? 3 - Pc : 39 - Pc) : Pc;
    float hr = 0.f, hi = 0.f;
    {
      const float2* Eb = E + ((((size_t)b * 16 + g) * 2 + dir) * 36) * 64 + lane;
      for (int cc = 0; cc < c; ++cc) {
        float2 e = Eb[(size_t)cc * 64];
        float nr = aL.x * hr - aL.y * hi + e.x;
        float ni = aL.x * hi + aL.y * hr + e.y;
        hr = nr; hi = ni;
      }
    }
    bf16x8 cf[4];
    {
      const size_t cbase = ((size_t)((j * 2 + dir) * 16 + g) * 16 + pcol) * 64;
#pragma unroll
      for (int ks = 0; ks < 4; ++ks) {
        const float* src = (ks < 2 ? p.c_re : p.c_im) + cbase + 32 * (ks & 1) + 8 * fq;
        float4 t0 = *(const float4*)src, t1_ = *(const float4*)(src + 4);
        const float sg = ks < 2 ? 1.f : -1.f;
        u32x4 cu;
        cu[0] = pack2(sg * t0.x, sg * t0.y); cu[1] = pack2(sg * t0.z, sg * t0.w);
        cu[2] = pack2(sg * t1_.x, sg * t1_.y); cu[3] = pack2(sg * t1_.z, sg * t1_.w);
        cf[ks] = __builtin_bit_cast(bf16x8, cu);
      }
    }
    const float dsk = p.ssm_d[j * 256 + 16 * g + pcol];
#pragma unroll 1
    for (int sub = 0; sub < 4; ++sub) {
      {
        const int k = sub * 16 + (lane & 15);
        const int lt = dir ? 63 - k : k;
        s5_bu16(U + (size_t)tok_row(b, 64 * Pc + lt) * 256 + 16 * g, lane, bfrag, Bus);
      }
      asm volatile("s_waitcnt lgkmcnt(0)" ::: "memory");
#pragma unroll
      for (int k16 = 0; k16 < 16; ++k16) {
        const float bur = Bus[k16 * 132 + lane], bui = Bus[k16 * 132 + 64 + lane];
        const float nr = a.x * hr - a.y * hi + bur;
        const float ni = a.x * hi + a.y * hr + bui;
        hr = nr; hi = ni;
        Hs[k16 * 136 + lane] = f2bf(hr);
        Hs[k16 * 136 + 64 + lane] = f2bf(hi);
      }
      asm volatile("s_waitcnt lgkmcnt(0)" ::: "memory");
      f32x4 acc = {0.f, 0.f, 0.f, 0.f};
#pragma unroll
      for (int ks = 0; ks < 4; ++ks) {
        bf16x8 af = *(const bf16x8*)(Hs + pcol * 136 + 32 * ks + 8 * fq);
        acc = MFMA16(af, cf[ks], acc);
      }
      asm volatile("s_nop 15\n\ts_nop 15" : "+v"(acc));
#pragma unroll
      for (int jj = 0; jj < 4; ++jj) {
        const int k = sub * 16 + 4 * fq + jj;
        const int lt = dir ? 63 - k : k;
        float yv = acc[jj];
        if (dir == 0) yv += dsk * U[(size_t)tok_row(b, 64 * Pc + lt) * 256 + 16 * g + pcol];
        ys[lt * 16 + pcol] = yv;
      }
      asm volatile("s_waitcnt lgkmcnt(0)" ::: "memory");
    }
    __syncthreads();
#pragma unroll
    for (int i = 0; i < 8; ++i) {
      int idx = tid + 256 * i; int gi = idx >> 10, lt = (idx >> 4) & 63, pp = idx & 15;
      const char* w0 = smem + (2 * gi) * 16896; const char* w1 = smem + (2 * gi + 1) * 16896;
      const int gg = gp * 2 + gi;
      float y = ((const float*)(w0 + 12800))[lt * 16 + pp] + ((const float*)(w1 + 12800))[lt * 16 + pp];
      float t = 0.7978845608028654f * (y + 0.044715f * y * y * y);
      float ge = 0.5f * y * (1.f + tanhf(t));
      int row = tok_row(b, 64 * Pc + lt);
      YG[(size_t)row * 256 + 16 * gg + pp] = f2bf(ge);
    }
    __syncthreads();
  }
}

__global__ void __launch_bounds__(NTHR, 2) fwd_megakernel(P p) {
  __shared__ __attribute__((aligned(16))) char smem[SMEM_BYTES];
  cg::grid_group grid = cg::this_grid();
  char* ws = p.ws;
  float* XC = (float*)(ws + OFF_XC);
  u16* ABUF = (u16*)(ws + OFF_ABUF);
  const float* modv = (const float*)(ws + OFF_MODV);

  __shared__ uint4 xb_words;
  unsigned* barw = (unsigned*)(ws + OFF_BAR);
  if (threadIdx.x == 0) xb_words = make_uint4(0u, 0u, 0u, 0u);
  if (blockIdx.x == 0) { for (int i = threadIdx.x; i < XCD_BAR_WORDS; i += NTHR) barw[i] = 0u; }
  for (int dd = 0; dd < DUPN(3); ++dd) prologue(p, smem);
  grid.sync();
  XcdBarrier xb = xcd_barrier_post(barw, (volatile LAS unsigned*)&xb_words);

  float* PSN = (float*)(ws + OFF_PSN);
  float* SW1 = (float*)(ws + OFF_SW1);
  float* SW2 = (float*)(ws + OFF_SW2);
  norm_phase(p.x, p.ctx, p.g_norm1, modv, 0, 1, NTOK, ABUF, PSN);
  for (int l = 0; l < 4; ++l) {
    const int jj = l >> 1;
    if (l & 1) sw_items(modv + (size_t)l * 17 * 6144, (const u16*)(ws + OFF_OIN + jj * SZ_OIN), 2432, SW1 + (size_t)l * 17 * 2560, 2560);
    else sw_items(modv + (size_t)l * 17 * 6144, (const u16*)(ws + OFF_EIN + jj * SZ_EIN), 1536, SW1 + (size_t)l * 17 * 2560, 2560);
  }
  GSYNC();

  for (int layer = 0; layer < 4; ++layer) {
    const int j = layer >> 1;
    const bool need_ctx = layer < 3;
    const float* xs_lat = layer == 0 ? p.x : p.out;
    const float* xs_ctx = layer == 0 ? p.ctx : XC;
    const float* modl = modv + (size_t)layer * 17 * 6144;
    EpiArgs ea{};
    ea.j = j; ea.gate = modl + 2 * 1024; ea.src_lat = xs_lat; ea.src_ctx = xs_ctx; ea.dst_lat = p.out; ea.dst_ctx = XC;
    ea.sw = SW1 + (size_t)layer * 17 * 2560; ea.sw_stride = 2560;
    ea.ng = p.g_norm2 + layer * 1024; ea.nscale = modl + 4 * 1024; ea.xg_dst = (u16*)(ws + OFF_XG2);

    if ((layer & 1) == 0) {
      for (int dd = 0; dd < DUPN(0); ++dd) gemm_phase<EPI_EVEN_IN>(p, ABUF, (const u16*)(ws + OFF_EIN + j * SZ_EIN), 1024, 288, 12, 6, ea, smem);
      GSYNC();
      for (int dd = 0; dd < DUPN(2); ++dd) s5_pass1(p, j, smem);
      for (int dd = 0; dd < DUPN(1); ++dd) attn_phase<64, false>((const u16*)(ws + E_Q), (const u16*)(ws + E_K), (const u16*)(ws + E_VT), 12, 4, 0.125f, ABUF, 0, need_ctx, nullptr, smem);
      ff_convert(p, layer, smem);
      GSYNC();
      for (int dd = 0; dd < DUPN(2); ++dd) s5_pass2(p, j, smem);
      sw_items(modl + 3 * 1024, (const u16*)(ws + OFF_FF1), 4096, SW2 + (size_t)layer * 17 * 4096, 4096);
      GSYNC();
      for (int dd = 0; dd < DUPN(0); ++dd) gemm_phase<EPI_GLU>(p, (const u16*)(ws + E_YG), (const u16*)(ws + OFF_GLU + j * SZ_GLU), 256, 288, 2, 6, ea, smem);
      GSYNC();
    } else {
      for (int dd = 0; dd < DUPN(0); ++dd) gemm_phase<EPI_ODD_IN>(p, ABUF, (const u16*)(ws + OFF_OIN + j * SZ_OIN), 1024, 288, 19, 6, ea, smem);
      GSYNC();
      for (int dd = 0; dd < DUPN(0); ++dd) gemm_phase<EPI_UQ>(p, (const u16*)(ws + O_CQ), (const u16*)(ws + OFF_UQ + j * SZ_UQ), 512, 288, 8, 6, ea, smem);
      for (int dd = 0; dd < DUPN(0); ++dd) gemm_phase<EPI_UKV>(p, (const u16*)(ws + O_CKV), (const u16*)(ws + OFF_UKV + j * SZ_UKV), 256, 288, 8, 6, ea, smem);
      for (int dd = 0; dd < DUPN(1); ++dd) attn_phase<64, true>((const u16*)(ws + O_NQ), (const u16*)(ws + O_NK), (const u16*)(ws + O_NVT), 8, 8, 0.125f, ABUF, 512, need_ctx,
                           p.rpb + (size_t)j * 8 * 465, smem);
      ff_convert(p, layer, smem);
      GSYNC();
      for (int dd = 0; dd < DUPN(1); ++dd) attn_phase<96, false>((const u16*)(ws + O_MQ), (const u16*)(ws + O_MK), (const u16*)(ws + O_MVT), 8, 8, 0.10206207261596577f, ABUF, 0,
                            need_ctx, nullptr, smem);
      sw_items(modl + 3 * 1024, (const u16*)(ws + OFF_FF1), 4096, SW2 + (size_t)layer * 17 * 4096, 4096);
      GSYNC();
    }
    const int mt = need_ctx ? 288 : 256;
    const int band = need_ctx ? 6 : 8;
    gemm_phase<EPI_RESID>(p, ABUF, (const u16*)(ws + ((layer & 1) ? OFF_OOUT : OFF_EOUT) + j * SZ_SQ), 1024, mt, 8, band, ea, smem);
    GSYNC();
    ea.sw = SW2 + (size_t)layer * 17 * 4096; ea.sw_stride = 4096;
    for (int dd = 0; dd < DUPN(0); ++dd) gemm_phase<EPI_RELU2>(p, (const u16*)(ws + OFF_XG2), (const u16*)(ws + OFF_FF1), 1024, mt, 32, band, ea, smem);
    GSYNC();
    ea.gate = modl + 5 * 1024; ea.src_lat = p.out; ea.src_ctx = XC;
    ea.ng = layer < 3 ? p.g_norm1 + (layer + 1) * 1024 : nullptr; ea.xg_dst = ABUF;
    ea.nscale = modv + (size_t)(layer + 1) * 17 * 6144 + 1 * 1024;
    gemm_phase<EPI_RESID>(p, (const u16*)(ws + OFF_H), (const u16*)(ws + OFF_FF2), 4096, mt, 8, band, ea, smem);
    GSYNC();
  }
  if (GPROBE >= 0) {
    EpiArgs ed{}; ed.j = 0;
    gemm_phase<EPI_RELU2, (GPROBE < 0 ? 0 : GPROBE)>(p, (const u16*)(ws + OFF_ABUF), (const u16*)(ws + OFF_FF1), 1024, 288, 32, 6, ed, smem);
  }
}

extern "C" void kernel_launch(void* const* d_in, const int* in_sizes, int n_in, void* d_out, int out_size, void* d_ws, size_t ws_size,
                              hipStream_t stream) {
  static int grid_blocks = 0;
  if (!grid_blocks) {
    int dev = 0, cus = 0, per_cu = 0;
    hipGetDevice(&dev);
    hipDeviceGetAttribute(&cus, hipDeviceAttributeMultiprocessorCount, dev);
    hipOccupancyMaxActiveBlocksPerMultiprocessor(&per_cu, fwd_megakernel, NTHR, 0);
    if (per_cu > 2) per_cu = 2;
    if (per_cu < 1) per_cu = 1;
    grid_blocks = cus * per_cu;
    grid_blocks &= ~7;
  }
  P p{};
  const float** f = (const float**)&p;
  for (int i = 0; i < 35; ++i) f[i] = (const float*)d_in[i];
  p.out = (float*)d_out;
  p.ws = (char*)d_ws;
  void* args[] = {&p};
  hipError_t e = hipLaunchCooperativeKernel((void*)fwd_megakernel, dim3(grid_blocks), dim3(NTHR), args, 0, stream);
  if (e != hipSuccess) fprintf(stderr, "cooperative launch failed: %s (grid %d)\n", hipGetErrorString(e), grid_blocks);
}
```

```cpp
#include <hip/hip_runtime.h>
#include <hip/hip_cooperative_groups.h>
#include <cstdio>
namespace cg = cooperative_groups;

typedef unsigned short u16;
using bf16x8 = __attribute__((ext_vector_type(8))) short;
using f32x16 = __attribute__((ext_vector_type(16))) float;
using f32x4 = __attribute__((ext_vector_type(4))) float;
typedef __attribute__((ext_vector_type(2))) __bf16 bf2_t;
using u32x4 = __attribute__((ext_vector_type(4))) unsigned;
#define DI __device__ __forceinline__
#define MFMA32(a, b, c) __builtin_amdgcn_mfma_f32_32x32x16_bf16((a), (b), (c), 0, 0, 0)
#define MFMA16(a, b, c) __builtin_amdgcn_mfma_f32_16x16x32_bf16((a), (b), (c), 0, 0, 0)

#ifndef GPROBE
#define GPROBE -1
#endif
#ifndef DUP_MASK
#define DUP_MASK 0
#endif
#define DUPN(bit) (((DUP_MASK) >> (bit)) & 1 ? 2 : 1)
constexpr int NTHR = 256;
constexpr int NLAT = 32768, NTOK = 36864, SP = 2304;
constexpr float EPSF = 1e-6f;
constexpr float LOG2E = 1.4426950408889634f;
constexpr int SMEM_BYTES = 73728 + 512;
constexpr int CP = 132;

constexpr size_t SZ_EIN = 1536ull * 1024 * 2, SZ_SQ = 1024ull * 1024 * 2, SZ_OIN = 2432ull * 1024 * 2;
constexpr size_t SZ_UQ = 1024ull * 512 * 2, SZ_UKV = 1024ull * 256 * 2, SZ_GLU = 256ull * 256 * 2;
constexpr size_t OFF_EIN = 0;
constexpr size_t OFF_EOUT = OFF_EIN + 2 * SZ_EIN;
constexpr size_t OFF_OIN = OFF_EOUT + 2 * SZ_SQ;
constexpr size_t OFF_OOUT = OFF_OIN + 2 * SZ_OIN;
constexpr size_t OFF_UQ = OFF_OOUT + 2 * SZ_SQ;
constexpr size_t OFF_UKV = OFF_UQ + 2 * SZ_UQ;
constexpr size_t OFF_GLU = OFF_UKV + 2 * SZ_UKV;
constexpr size_t OFF_FF1 = OFF_GLU + 2 * SZ_GLU;
constexpr size_t OFF_FF2 = OFF_FF1 + 4096ull * 1024 * 2;
constexpr size_t OFF_MODV = OFF_FF2 + 4096ull * 1024 * 2;
constexpr size_t OFF_ROPE = OFF_MODV + 4ull * 17 * 6144 * 4;
constexpr size_t OFF_SA = OFF_ROPE + 16384;
constexpr size_t OFF_SAL = OFF_SA + 4096 * 8;
constexpr size_t OFF_SBB = OFF_SAL + 4096 * 8;
constexpr size_t OFF_BAR = OFF_SBB + 4096ull * 32 * 4;
constexpr size_t OFF_PSN = OFF_BAR + 16384;
constexpr size_t OFF_SW1 = OFF_PSN + 36864ull * 8 * 4;
constexpr size_t OFF_SW2 = OFF_SW1 + 4ull * 17 * 2560 * 4;
constexpr size_t OFF_XC = OFF_SW2 + 4ull * 17 * 4096 * 4;
constexpr size_t OFF_ABUF = OFF_XC + 4096ull * 1024 * 4;
constexpr size_t OFF_R1 = OFF_ABUF + (size_t)NTOK * 1024 * 2;
constexpr size_t E_Q = OFF_R1;
constexpr size_t E_K = E_Q + 16ull * 12 * SP * 64 * 2;
constexpr size_t E_VT = E_K + 16ull * 4 * SP * 64 * 2;
constexpr size_t E_U = E_VT + 16ull * 4 * SP * 64 * 2;
constexpr size_t E_E = E_U + (size_t)NTOK * 256 * 4;
constexpr size_t E_YG = E_E + 16ull * 16 * 2 * 36 * 64 * 8;
constexpr size_t O_CQ = OFF_R1;
constexpr size_t O_CKV = O_CQ + (size_t)NTOK * 512 * 2;
constexpr size_t O_KR = O_CKV + (size_t)NTOK * 256 * 2;
constexpr size_t O_PS = O_KR + (size_t)NTOK * 32 * 4;
constexpr size_t O_NQ = O_PS + (size_t)NTOK * 8 * 4;
constexpr size_t O_NK = O_NQ + 16ull * 8 * SP * 64 * 2;
constexpr size_t O_NVT = O_NK + 16ull * 8 * SP * 64 * 2;
constexpr size_t O_MQ = O_NVT + 16ull * 8 * SP * 64 * 2;
constexpr size_t O_MK = O_MQ + 16ull * 8 * SP * 96 * 2;
constexpr size_t O_MVT = O_MK + 16ull * 8 * SP * 96 * 2;
constexpr size_t O_END = O_MVT + 16ull * 8 * SP * 64 * 2;
constexpr size_t OFF_H = OFF_R1;
constexpr size_t OFF_XG2 = OFF_H + (size_t)NTOK * 4096 * 2;
constexpr size_t WS_END = OFF_XG2 + (size_t)NTOK * 1024 * 2;
static_assert(WS_END <= 536870912ull, "workspace map exceeds 512 MiB");

struct P {
  const float *x, *c, *ctx, *c_ctx, *w_mod, *b_mod, *g_norm1, *g_norm2, *w_ff1, *w_ff2;
  const float *e_w_in, *e_w_out, *e_g_q, *e_g_k, *lam_re, *lam_im, *log_dt, *b_re, *b_im, *c_re, *c_im, *ssm_d, *w_glu, *b_glu;
  const float *o_w_in, *o_w_out, *g_cq, *g_ckv, *w_uq, *w_ukv, *g_mq, *g_mk, *g_nq, *g_nk, *rpb;
  float* out;
  char* ws;
};

DI unsigned pack2(float a, float b) { bf2_t v; v[0] = (__bf16)a; v[1] = (__bf16)b; return __builtin_bit_cast(unsigned, v); }
DI u16 f2bf(float a) { __bf16 v = (__bf16)a; return __builtin_bit_cast(u16, v); }
DI float bf2f(u16 v) { return __uint_as_float(((unsigned)v) << 16); }
#define GSYNC() do { for (int dd_ = 0; dd_ < DUPN(4); ++dd_) xcd_barrier(xb); } while (0)
DI int otid() { int t = threadIdx.x; asm volatile("" : "+v"(t)); return t; }
DI int tok_row(int b, int pos) { return pos < 256 ? NLAT + b * 256 + pos : b * 2048 + pos - 256; }


#define XB_TMO      128
#define XB_XCNT(j)  (256  + 64 * (j))
#define XB_XSUB(j)  (1280 + 64 * (j))
#define XB_XGEN(j)  (2304 + 64 * (j))
#define XB_TOP      3328
#define XB_TOPGEN   3392
#define XCD_BAR_WORDS 3456
#define XB_SPIN_CAP (1u << 22)
#define LAS __attribute__((address_space(3)))
DI unsigned xb_ld(unsigned* p) { return __hip_atomic_load(p, __ATOMIC_RELAXED, __HIP_MEMORY_SCOPE_AGENT); }
DI unsigned xb_add(unsigned* p, unsigned v) { return __hip_atomic_fetch_add(p, v, __ATOMIC_RELAXED, __HIP_MEMORY_SCOPE_AGENT); }
DI unsigned xb_xcc_id() { return (unsigned)__builtin_amdgcn_s_getreg((3 << 11) | 20) & 0xFu; }
#define XB_SPIN(cond, bar) do { unsigned _sp = 0; while (cond) { __builtin_amdgcn_s_sleep(1); \
    if ((++_sp & 255u) == 0u) { if (xb_ld(&(bar)[XB_TMO])) break; if (_sp > XB_SPIN_CAP) { atomicAdd(&(bar)[XB_TMO], 1u); break; } } } } while (0)
struct XcdBarrier { unsigned* bar; unsigned x; volatile LAS unsigned* st; };
DI XcdBarrier xcd_barrier_post(unsigned* bar, volatile LAS unsigned* st) {
  XcdBarrier b; b.bar = bar; b.x = xb_xcc_id(); b.st = st;
  if (threadIdx.x == 0) (void)xb_add(&bar[XB_XCNT(b.x)], 1u);
  return b;
}
DI void xcd_barrier_complete(unsigned* bar, unsigned x, unsigned& nloc, unsigned& nx) {
  const unsigned G = gridDim.x * gridDim.y * gridDim.z;
  unsigned sum, cnt, mine, sp = 0u;
  for (;;) {
    sum = 0u; cnt = 0u; mine = 0u;
#pragma unroll
    for (unsigned j = 0; j < 16; ++j) { const unsigned c = xb_ld(&bar[XB_XCNT(j)]); sum += c; cnt += (c > 0u) ? 1u : 0u; mine = (j == x) ? c : mine; }
    if (sum == G) break;
    __builtin_amdgcn_s_sleep(1);
    if ((++sp & 255u) == 0u) { if (xb_ld(&bar[XB_TMO])) break; if (sp > XB_SPIN_CAP) { atomicAdd(&bar[XB_TMO], 1u); break; } }
  }
  nloc = mine > 0u ? mine : 1u; nx = cnt > 0u ? cnt : 1u;
}
DI void xcd_barrier(const XcdBarrier& b) {
  asm volatile("s_waitcnt vmcnt(0)" ::: "memory");
  __syncthreads();
  if (threadIdx.x == 0) {
    unsigned* bar = b.bar;
    __builtin_amdgcn_s_waitcnt(0);
    unsigned nloc = b.st[0], nx = b.st[1];
    if (nloc == 0u) { xcd_barrier_complete(bar, b.x, nloc, nx); b.st[0] = nloc; b.st[1] = nx; }
    const unsigned old = xb_add(&bar[XB_XSUB(b.x)], 1u);
    const unsigned gen = old / nloc;
    if (old + 1u == (gen + 1u) * nloc) {
      __builtin_amdgcn_fence(__ATOMIC_RELEASE, "agent");
      asm volatile("s_waitcnt vmcnt(0)" ::: "memory");
      const unsigned og = xb_add(&bar[XB_TOP], 1u);
      const unsigned tg = og / nx;
      if (og + 1u == (tg + 1u) * nx) xb_add(&bar[XB_TOPGEN], 1u);
      else XB_SPIN(xb_ld(&bar[XB_TOPGEN]) == tg, bar);
      __builtin_amdgcn_fence(__ATOMIC_ACQUIRE, "agent");
      xb_add(&bar[XB_XGEN(b.x)], 1u);
      asm volatile("s_waitcnt vmcnt(0)" ::: "memory");
    } else {
      XB_SPIN(xb_ld(&bar[XB_XGEN(b.x)]) == gen, bar);
      __builtin_amdgcn_fence(__ATOMIC_ACQUIRE, "agent");
      asm volatile("s_waitcnt vmcnt(0)" ::: "memory");
    }
  }
  __syncthreads();
}

DI int map_col(int mapk, int n, int N) {
  if (mapk == 0) return n < N ? n : -1;
  if (mapk == 1) { if (n < 768) return n; if (n < 2304) return n + 32; if (n < 2336) return n - 2304 + 768; return -1; }
  int h = n >> 7, jj = n & 127; return jj < 96 ? h * 96 + jj : -1;
}
DI void tr_tile(const float* __restrict__ src, int K, int N, int Npad, int mapk, const float* __restrict__ ks,
                        u16* __restrict__ dst, int tile, char* smem) {
  float* tl = (float*)smem;
  const int tid = otid();
  const int tnn = Npad >> 6;
  const int n0 = (tile % tnn) * 64, k0 = (tile / tnn) * 64;
  const int nn = tid & 63;
  const int sn = map_col(mapk, n0 + nn, N);
#pragma unroll 4
  for (int i = 0; i < 16; ++i) {
    int kk = (tid >> 6) + 4 * i;
    float v = 0.f;
    if (sn >= 0) { v = src[(size_t)(k0 + kk) * N + sn]; if (ks) v *= ks[k0 + kk]; }
    tl[kk * 65 + nn] = v;
  }
  __syncthreads();
#pragma unroll 4
  for (int i = 0; i < 16; ++i) {
    int n2 = (tid >> 6) + 4 * i, kk = tid & 63;
    dst[(size_t)(n0 + n2) * K + k0 + kk] = f2bf(tl[kk * 65 + n2]);
  }
  __syncthreads();
}

DI void ff_convert(const P& p, int layer, char* smem) {
  u16* f1 = (u16*)(p.ws + OFF_FF1);
  u16* f2 = (u16*)(p.ws + OFF_FF2);
  const float* s1 = p.w_ff1 + (size_t)layer * 1024 * 4096;
  const float* s2 = p.w_ff2 + (size_t)layer * 4096 * 1024;
  for (int t = gridDim.x - 1 - blockIdx.x; t < 2048; t += gridDim.x) {
    if (t < 1024) tr_tile(s1, 1024, 4096, 4096, 0, nullptr, f1, t, smem);
    else tr_tile(s2, 4096, 1024, 1024, 0, nullptr, f2, t - 1024, smem);
  }
}

DI void prologue(const P& p, char* smem) {
  const int tid = otid();
  float* modv = (float*)(p.ws + OFF_MODV);
  for (int it = blockIdx.x; it < 384; it += gridDim.x) {
    float* cond = (float*)smem;
    for (int idx = tid; idx < 17 * 1024; idx += NTHR) {
      int bb = idx >> 10, k = idx & 1023;
      float v = bb < 16 ? p.c[bb * 1024 + k] : p.c_ctx[k];
      cond[idx] = v / (1.f + __expf(-v));
    }
    __syncthreads();
    const int l = it / 96, n = (it % 96) * 64 + (tid & 63), kq = tid >> 6;
    float acc[17];
#pragma unroll
    for (int i = 0; i < 17; ++i) acc[i] = 0.f;
    const float* wp = p.w_mod + ((size_t)l * 1024 + kq * 256) * 6144 + n;
#pragma unroll 4
    for (int k4 = 0; k4 < 64; ++k4) {
      float w0 = wp[(size_t)(k4 * 4 + 0) * 6144], w1 = wp[(size_t)(k4 * 4 + 1) * 6144];
      float w2 = wp[(size_t)(k4 * 4 + 2) * 6144], w3 = wp[(size_t)(k4 * 4 + 3) * 6144];
#pragma unroll
      for (int bb = 0; bb < 17; ++bb) {
        float4 c4 = *(const float4*)(cond + bb * 1024 + kq * 256 + k4 * 4);
        acc[bb] += c4.x * w0 + c4.y * w1 + c4.z * w2 + c4.w * w3;
      }
    }
    __syncthreads();
    float* red = (float*)smem;
#pragma unroll
    for (int bb = 0; bb < 17; ++bb) red[(kq * 17 + bb) * 64 + (tid & 63)] = acc[bb];
    __syncthreads();
    for (int o = tid; o < 17 * 64; o += NTHR) {
      int bb = o >> 6, nn = o & 63;
      int ncol = (it % 96) * 64 + nn;
      float s = red[(0 * 17 + bb) * 64 + nn] + red[(1 * 17 + bb) * 64 + nn] + red[(2 * 17 + bb) * 64 + nn] + red[(3 * 17 + bb) * 64 + nn];
      modv[((size_t)l * 17 + bb) * 6144 + ncol] = s + p.b_mod[l * 6144 + ncol];
    }
    __syncthreads();
  }
  {
    float* rt = (float*)(p.ws + OFF_ROPE);
    for (int idx = blockIdx.x * NTHR + tid; idx < 1024 + 512; idx += gridDim.x * NTHR) {
      if (idx < 1024) {
        int pos = idx >> 4, i = idx & 15;
        float f = powf(10000.f, -(float)(2 * i) / 32.f);
        float a = (float)pos * f;
        rt[idx] = cosf(a); rt[1024 + idx] = sinf(a);
      } else {
        int q = idx - 1024; int pos = q >> 3, i = q & 7;
        float f = powf(10000.f, -(float)(2 * i) / 16.f);
        float a = (float)pos * f;
        rt[2048 + q] = cosf(a); rt[2560 + q] = sinf(a);
      }
    }
    float2* SA = (float2*)(p.ws + OFF_SA);
    float2* SAL = (float2*)(p.ws + OFF_SAL);
    float* SBB = (float*)(p.ws + OFF_SBB);
    for (int idx = blockIdx.x * NTHR + tid; idx < 4096; idx += gridDim.x * NTHR) {
      float lre = p.lam_re[idx], lim = p.lam_im[idx];
      float dt = expf(p.log_dt[idx >> 6]);
      float mag = expf(lre * dt);
      float are = mag * cosf(lim * dt), aim = mag * sinf(lim * dt);
      float den = lre * lre + lim * lim;
      float fre = ((are - 1.f) * lre + aim * lim) / den;
      float fim = (aim * lre - (are - 1.f) * lim) / den;
      SA[idx] = make_float2(are, aim);
      float pr = are, pi = aim;
#pragma unroll
      for (int q = 0; q < 6; ++q) { float nr = pr * pr - pi * pi, ni = 2.f * pr * pi; pr = nr; pi = ni; }
      SAL[idx] = make_float2(pr, pi);
#pragma unroll
      for (int q = 0; q < 16; ++q) {
        float br = p.b_re[(size_t)idx * 16 + q], bi = p.b_im[(size_t)idx * 16 + q];
        SBB[(size_t)idx * 32 + q] = fre * br - fim * bi;
        SBB[(size_t)idx * 32 + 16 + q] = fre * bi + fim * br;
      }
    }
  }
  for (int t = gridDim.x - 1 - blockIdx.x; t < 3424; t += gridDim.x) {
    int j = t / 1712, r = t % 1712;
    if (r < 384) tr_tile(p.e_w_in + (size_t)j * 1024 * 1536, 1024, 1536, 1536, 0, nullptr, (u16*)(p.ws + OFF_EIN + j * SZ_EIN), r, smem);
    else if (r < 640) tr_tile(p.e_w_out + (size_t)j * 1024 * 1024, 1024, 1024, 1024, 0, nullptr, (u16*)(p.ws + OFF_EOUT + j * SZ_SQ), r - 384, smem);
    else if (r < 1248) tr_tile(p.o_w_in + (size_t)j * 1024 * 2336, 1024, 2336, 2432, 1, nullptr, (u16*)(p.ws + OFF_OIN + j * SZ_OIN), r - 640, smem);
    else if (r < 1504) tr_tile(p.o_w_out + (size_t)j * 1024 * 1024, 1024, 1024, 1024, 0, nullptr, (u16*)(p.ws + OFF_OOUT + j * SZ_SQ), r - 1248, smem);
    else if (r < 1632) tr_tile(p.w_uq + (size_t)j * 512 * 768, 512, 768, 1024, 2, p.g_cq + j * 512, (u16*)(p.ws + OFF_UQ + j * SZ_UQ), r - 1504, smem);
    else if (r < 1696) tr_tile(p.w_ukv + (size_t)j * 256 * 1024, 256, 1024, 1024, 0, p.g_ckv + j * 256, (u16*)(p.ws + OFF_UKV + j * SZ_UKV), r - 1632, smem);
    else tr_tile(p.w_glu + (size_t)j * 256 * 256, 256, 256, 256, 0, nullptr, (u16*)(p.ws + OFF_GLU + j * SZ_GLU), r - 1696, smem);
  }
}

DI void norm_phase(const float* __restrict__ xl, const float* __restrict__ xc, const float* __restrict__ g,
                           const float* __restrict__ modl, int shift_i, int scale_i, int nrows, u16* __restrict__ dst, float* __restrict__ psn) {
  const int tid_ = otid();
  const int lane = tid_ & 63;
  const int gw = blockIdx.x * 4 + (tid_ >> 6);
  for (int R = gw; R < nrows; R += gridDim.x * 4) {
    const float* src = R < NLAT ? xl + (size_t)R * 1024 : xc + (size_t)(R - NLAT) * 1024;
    const int mrow = R < NLAT ? (R >> 11) : 16;
    float4 v[4];
    float ss = 0.f;
#pragma unroll
    for (int i = 0; i < 4; ++i) {
      v[i] = *(const float4*)(src + lane * 4 + 256 * i);
      ss += v[i].x * v[i].x + v[i].y * v[i].y + v[i].z * v[i].z + v[i].w * v[i].w;
    }
#pragma unroll
    for (int o = 32; o >= 1; o >>= 1) ss += __shfl_xor(ss, o);
    if (lane < 8) psn[(size_t)R * 8 + lane] = lane == 0 ? ss : 0.f;
    const float* sc = modl + (size_t)mrow * 6144 + scale_i * 1024;
#pragma unroll
    for (int i = 0; i < 4; ++i) {
      int col = lane * 4 + 256 * i;
      float4 gg = *(const float4*)(g + col), c4 = *(const float4*)(sc + col);
      float y0 = v[i].x * gg.x * (1.f + c4.x);
      float y1 = v[i].y * gg.y * (1.f + c4.y);
      float y2 = v[i].z * gg.z * (1.f + c4.z);
      float y3 = v[i].w * gg.w * (1.f + c4.w);
      uint2 o2; o2.x = pack2(y0, y1); o2.y = pack2(y2, y3);
      *(uint2*)(dst + (size_t)R * 1024 + col) = o2;
    }
  }
}

DI void sw_items(const float* __restrict__ shift, const u16* __restrict__ Wt, int N, float* __restrict__ out, int ostride) {
  const int tid_ = otid();
  const int lane = tid_ & 63;
  const int gw = blockIdx.x * 4 + (tid_ >> 6);
  for (int n = gw; n < N; n += gridDim.x * 4) {
    const uint4 w0 = *(const uint4*)(Wt + (size_t)n * 1024 + lane * 16);
    const uint4 w1 = *(const uint4*)(Wt + (size_t)n * 1024 + lane * 16 + 8);
    float wf[16];
    wf[0] = __uint_as_float(w0.x << 16); wf[1] = __uint_as_float(w0.x & 0xffff0000u);
    wf[2] = __uint_as_float(w0.y << 16); wf[3] = __uint_as_float(w0.y & 0xffff0000u);
    wf[4] = __uint_as_float(w0.z << 16); wf[5] = __uint_as_float(w0.z & 0xffff0000u);
    wf[6] = __uint_as_float(w0.w << 16); wf[7] = __uint_as_float(w0.w & 0xffff0000u);
    wf[8] = __uint_as_float(w1.x << 16); wf[9] = __uint_as_float(w1.x & 0xffff0000u);
    wf[10] = __uint_as_float(w1.y << 16); wf[11] = __uint_as_float(w1.y & 0xffff0000u);
    wf[12] = __uint_as_float(w1.z << 16); wf[13] = __uint_as_float(w1.z & 0xffff0000u);
    wf[14] = __uint_as_float(w1.w << 16); wf[15] = __uint_as_float(w1.w & 0xffff0000u);
#pragma unroll 1
    for (int bb = 0; bb < 17; ++bb) {
      const float* sp = shift + (size_t)bb * 6144 + lane * 16;
      float acc = 0.f;
#pragma unroll
      for (int q = 0; q < 4; ++q) {
        float4 t = *(const float4*)(sp + 4 * q);
        acc += t.x * wf[4 * q] + t.y * wf[4 * q + 1] + t.z * wf[4 * q + 2] + t.w * wf[4 * q + 3];
      }
#pragma unroll
      for (int o = 32; o >= 1; o >>= 1) acc += __shfl_xor(acc, o);
      if (lane == 0) out[(size_t)bb * ostride + n] = acc;
    }
  }
}

enum { EPI_EVEN_IN = 0, EPI_ODD_IN, EPI_UQ, EPI_UKV, EPI_GLU, EPI_RESID, EPI_RELU2 };

struct EpiArgs {
  int j;
  const float* gate;
  const float* src_lat; const float* src_ctx; float* dst_lat; float* dst_ctx;
  const float* sw; int sw_stride;
  u16* xg_dst;
  const float* ng; const float* nscale;
};

DI void store16(u16* dst, const float* y) {
  uint4 a, b;
  a.x = pack2(y[0], y[1]); a.y = pack2(y[2], y[3]); a.z = pack2(y[4], y[5]); a.w = pack2(y[6], y[7]);
  b.x = pack2(y[8], y[9]); b.y = pack2(y[10], y[11]); b.z = pack2(y[12], y[13]); b.w = pack2(y[14], y[15]);
  *(uint4*)dst = a; *(uint4*)(dst + 8) = b;
}
DI void load16(const float* s, float* v) {
#pragma unroll
  for (int q = 0; q < 4; ++q) { float4 t = *(const float4*)(s + 4 * q); v[4 * q] = t.x; v[4 * q + 1] = t.y; v[4 * q + 2] = t.z; v[4 * q + 3] = t.w; }
}

DI void epi_head64(const P& p, const float* Cs, int b, int pos0, bool isctx, const float* __restrict__ g, bool rope,
                   u16* __restrict__ dstbase, int H, int head0) {
  const int tid = otid(), sub = tid & 7, hh = sub >> 2, jq = sub & 3;
  const float* rt = (const float*)(p.ws + OFF_ROPE);
#pragma unroll 1
  for (int pass = 0; pass < 4; ++pass) {
    const int row = pass * 32 + (tid >> 3);
    float v[16], pv[16];
    load16(Cs + row * CP + 16 * sub, v);
    float ss = 0.f;
#pragma unroll
    for (int i = 0; i < 16; ++i) ss += v[i] * v[i];
    ss += __shfl_xor(ss, 1); ss += __shfl_xor(ss, 2);
    const float rs = rsqrtf(ss * (1.f / 64.f) + EPSF);
#pragma unroll
    for (int i = 0; i < 16; ++i) v[i] = v[i] * rs * g[16 * jq + i];
    const int pos = pos0 + row;
    if (rope && !isctx) {
      load16(Cs + row * CP + 16 * (sub ^ 1), pv);
      const int lp = pos - 256;
      const int ti = (jq < 2) ? (lp >> 6) : (lp & 63);
      const float sgn = (jq & 1) ? 1.f : -1.f;
#pragma unroll
      for (int i = 0; i < 16; ++i) {
        float pn = pv[i] * rs * g[16 * (jq ^ 1) + i];
        float cs = rt[ti * 16 + i], sn = rt[1024 + ti * 16 + i];
        v[i] = v[i] * cs + sgn * pn * sn;
      }
    }
    store16(dstbase + (((size_t)b * H + head0 + hh) * SP + pos) * 64 + 16 * jq, v);
  }
}

DI void epi_vt(const float* Cs, int b, int pos0, u16* __restrict__ dstbase, int H, int head0, int c0, int ncols, float mul_unused) {
  const int tid = otid();
  const int cl = tid % ncols, tg = tid / ncols, ngrp = NTHR / ncols;
  const int col = c0 + cl;
  const int head = head0 + (cl >> 6), d = cl & 63;
  u16* drow = dstbase + (((size_t)b * H + head) * 64 + d) * SP + pos0;
  for (int tk = tg; tk < 16; tk += ngrp) {
    float y[8];
#pragma unroll
    for (int e = 0; e < 8; ++e) y[e] = Cs[(tk * 8 + e) * CP + col];
    uint4 a; a.x = pack2(y[0], y[1]); a.y = pack2(y[2], y[3]); a.z = pack2(y[4], y[5]); a.w = pack2(y[6], y[7]);
    *(uint4*)(drow + tk * 8) = a;
  }
}

template <int EPI>
DI void epilogue(const P& p, const EpiArgs& ea, float* Cs, int mtile, int ntile) {
  const int tid = otid();
  const int m0 = mtile * 128, n0 = ntile * 128;
  const bool isctx = m0 >= NLAT;
  const int b = isctx ? ((m0 - NLAT) >> 8) : (m0 >> 11);
  const int pos0 = isctx ? ((m0 - NLAT) & 255) : 256 + (m0 & 2047);
  const int mrow = isctx ? 16 : b;
  char* ws = p.ws;
  if (EPI == EPI_RESID) {
    const int c4 = (tid & 31) * 4;
    const int n = n0 + c4;
    const int R0 = m0 + (tid >> 5);
    const float* src = (isctx ? ea.src_ctx + (size_t)(R0 - NLAT) * 1024 : ea.src_lat + (size_t)R0 * 1024) + n;
    float* dst = (isctx ? ea.dst_ctx + (size_t)(R0 - NLAT) * 1024 : ea.dst_lat + (size_t)R0 * 1024) + n;
    const float4 gv = *(const float4*)(ea.gate + (size_t)mrow * 6144 + n);
    float4 gmv = make_float4(0.f, 0.f, 0.f, 0.f);
    if (ea.ng) {
      float4 g4 = *(const float4*)(ea.ng + n), s4 = *(const float4*)(ea.nscale + (size_t)mrow * 6144 + n);
      gmv.x = g4.x * (1.f + s4.x); gmv.y = g4.y * (1.f + s4.y); gmv.z = g4.z * (1.f + s4.z); gmv.w = g4.w * (1.f + s4.w);
    }
    float4 xv[16];
#pragma unroll
    for (int pass = 0; pass < 16; ++pass) xv[pass] = *(const float4*)(src + (size_t)pass * 8 * 1024);
#pragma unroll
    for (int pass = 0; pass < 16; ++pass) {
      const int row = pass * 8 + (tid >> 5);
      float4 a = *(const float4*)(Cs + row * CP + c4);
      float4 o; o.x = xv[pass].x + gv.x * a.x; o.y = xv[pass].y + gv.y * a.y; o.z = xv[pass].z + gv.z * a.z; o.w = xv[pass].w + gv.w * a.w;
      *(float4*)(dst + (size_t)pass * 8 * 1024) = o;
      if (ea.ng) {
        float ss = o.x * o.x + o.y * o.y + o.z * o.z + o.w * o.w;
#pragma unroll
        for (int q = 16; q >= 1; q >>= 1) ss += __shfl_xor(ss, q);
        const int R = m0 + row;
        if ((tid & 31) == 0) ((float*)(ws + OFF_PSN))[(size_t)R * 8 + ntile] = ss;
        uint2 xo; xo.x = pack2(o.x * gmv.x, o.y * gmv.y); xo.y = pack2(o.z * gmv.z, o.w * gmv.w);
        *(uint2*)(ea.xg_dst + (size_t)R * 1024 + n) = xo;
      }
    }
  } else if (EPI == EPI_RELU2 || EPI == EPI_GLU) {
    const int c4 = (tid & 31) * 4;
    const int n = n0 + c4;
#pragma unroll 4
    for (int pass = 0; pass < 16; ++pass) {
      const int row = pass * 8 + (tid >> 5);
      const int R = m0 + row;
      float4 a = *(const float4*)(Cs + row * CP + c4);
      if (EPI == EPI_RELU2) {
        float r0 = fmaxf(a.x, 0.f), r1 = fmaxf(a.y, 0.f), r2 = fmaxf(a.z, 0.f), r3 = fmaxf(a.w, 0.f);
        uint2 o; o.x = pack2(r0 * r0, r1 * r1); o.y = pack2(r2 * r2, r3 * r3);
        *(uint2*)((u16*)(ws + OFF_H) + (size_t)R * 4096 + n) = o;
      } else {
        const u16* yg = (const u16*)(ws + E_YG) + (size_t)R * 256 + n;
        uint2 yv = *(const uint2*)yg;
        float4 bg = *(const float4*)(p.b_glu + ea.j * 256 + n);
        float y0 = __uint_as_float(yv.x << 16), y1 = __uint_as_float(yv.x & 0xffff0000u);
        float y2 = __uint_as_float(yv.y << 16), y3 = __uint_as_float(yv.y & 0xffff0000u);
        float o0 = y0 / (1.f + __expf(-(a.x + bg.x))), o1 = y1 / (1.f + __expf(-(a.y + bg.y)));
        float o2 = y2 / (1.f + __expf(-(a.z + bg.z))), o3 = y3 / (1.f + __expf(-(a.w + bg.w)));
        uint2 o; o.x = pack2(o0, o1); o.y = pack2(o2, o3);
        *(uint2*)((u16*)(ws + OFF_ABUF) + (size_t)R * 1024 + 768 + n) = o;
      }
    }
  } else if (EPI == EPI_EVEN_IN) {
    if (ntile < 6) epi_head64(p, Cs, b, pos0, isctx, p.e_g_q + ea.j * 64, true, (u16*)(ws + E_Q), 12, ntile * 2);
    else if (ntile < 8) epi_head64(p, Cs, b, pos0, isctx, p.e_g_k + ea.j * 64, true, (u16*)(ws + E_K), 4, (ntile - 6) * 2);
    else if (ntile < 10) epi_vt(Cs, b, pos0, (u16*)(ws + E_VT), 4, (ntile - 8) * 2, 0, 128, 1.f);
    else {
      const int c4 = (tid & 31) * 4;
      float* U = (float*)(ws + E_U);
      for (int pass = 0; pass < 16; ++pass) {
        const int row = pass * 8 + (tid >> 5);
        *(float4*)(U + (size_t)(m0 + row) * 256 + (ntile - 10) * 128 + c4) = *(const float4*)(Cs + row * CP + c4);
      }
    }
  } else if (EPI == EPI_ODD_IN) {
    if (ntile < 6) {
      const int c4 = (tid & 31) * 4;
      float* PS = (float*)(ws + O_PS);
      for (int pass = 0; pass < 16; ++pass) {
        const int row = pass * 8 + (tid >> 5);
        const int R = m0 + row;
        float4 a = *(const float4*)(Cs + row * CP + c4);
        float ss = a.x * a.x + a.y * a.y + a.z * a.z + a.w * a.w;
#pragma unroll
        for (int o = 16; o >= 1; o >>= 1) ss += __shfl_xor(ss, o);
        if ((tid & 31) == 0) PS[(size_t)R * 8 + ntile] = ss;
        uint2 o; o.x = pack2(a.x, a.y); o.y = pack2(a.z, a.w);
        if (ntile < 4) *(uint2*)((u16*)(ws + O_CQ) + (size_t)R * 512 + n0 + c4) = o;
        else *(uint2*)((u16*)(ws + O_CKV) + (size_t)R * 256 + (n0 - 512) + c4) = o;
      }
    } else if (ntile < 10) epi_head64(p, Cs, b, pos0, isctx, p.g_nq + ea.j * 64, false, (u16*)(ws + O_NQ), 8, (ntile - 6) * 2);
    else if (ntile < 14) epi_head64(p, Cs, b, pos0, isctx, p.g_nk + ea.j * 64, false, (u16*)(ws + O_NK), 8, (ntile - 10) * 2);
    else if (ntile < 18) epi_vt(Cs, b, pos0, (u16*)(ws + O_NVT), 8, (ntile - 14) * 2, 0, 128, 1.f);
    else {
      float* KR = (float*)(ws + O_KR);
      const int c4 = (tid & 7) * 4;
      for (int pass = 0; pass < 4; ++pass) {
        const int row = pass * 32 + (tid >> 3);
        *(float4*)(KR + (size_t)(m0 + row) * 32 + c4) = *(const float4*)(Cs + row * CP + c4);
      }
    }
  } else if (EPI == EPI_UQ || EPI == EPI_UKV) {
    const int sub = tid & 7;
    const float* PS = (const float*)(ws + O_PS);
    const float* rt = (const float*)(ws + OFF_ROPE);
    const float* gm = (EPI == EPI_UQ ? p.g_mq : p.g_mk) + ea.j * 96;
    u16* dstb = (u16*)(ws + (EPI == EPI_UQ ? O_MQ : O_MK));
    const float* KR = (const float*)(ws + O_KR);
#pragma unroll 1
    for (int pass = 0; pass < 4; ++pass) {
      const int row = pass * 32 + (tid >> 3);
      const int R = m0 + row;
      float rstd;
      if (EPI == EPI_UQ) {
        float4 ps = *(const float4*)(PS + (size_t)R * 8);
        rstd = rsqrtf((ps.x + ps.y + ps.z + ps.w) * (1.f / 512.f) + EPSF);
      } else {
        float2 ps = *(const float2*)(PS + (size_t)R * 8 + 4);
        rstd = rsqrtf((ps.x + ps.y) * (1.f / 256.f) + EPSF);
      }
      float v[16];
      if (EPI == EPI_UQ) {
        load16(Cs + row * CP + 16 * sub, v);
#pragma unroll
        for (int i = 0; i < 16; ++i) v[i] *= rstd;
      } else {
        if (sub < 4) {
          load16(Cs + row * CP + 16 * sub, v);
#pragma unroll
          for (int i = 0; i < 16; ++i) v[i] *= rstd;
        } else if (sub < 6) {
          load16(KR + (size_t)R * 32 + 16 * (sub - 4), v);
        } else {
#pragma unroll
          for (int i = 0; i < 16; ++i) v[i] = 0.f;
        }
      }
      float ss = 0.f;
#pragma unroll
      for (int i = 0; i < 16; ++i) ss += v[i] * v[i];
      ss += __shfl_xor(ss, 1); ss += __shfl_xor(ss, 2); ss += __shfl_xor(ss, 4);
      const float rs = rsqrtf(ss * (1.f / 96.f) + EPSF);
      if (sub < 6) {
#pragma unroll
        for (int i = 0; i < 16; ++i) v[i] = v[i] * rs * gm[16 * sub + i];
        const int pos = pos0 + row;
        if (sub >= 4 && !isctx) {
          const int lp = pos - 256;
          const int ti = (sub == 4) ? (lp >> 6) : (lp & 63);
#pragma unroll
          for (int i = 0; i < 8; ++i) {
            float cs = rt[2048 + ti * 8 + i], sn = rt[2560 + ti * 8 + i];
            float x1 = v[i], x2 = v[i + 8];
            v[i] = x1 * cs - x2 * sn;
            v[i + 8] = x2 * cs + x1 * sn;
          }
        }
        store16(dstb + (((size_t)b * 8 + ntile) * SP + pos) * 96 + 16 * sub, v);
      }
    }
    if (EPI == EPI_UKV) {
      const int cl = tid & 63, tg = tid >> 6;
      u16* drow = (u16*)(ws + O_MVT) + (((size_t)b * 8 + ntile) * 64 + cl) * SP + pos0;
      for (int tk = tg; tk < 16; tk += 4) {
        float y[8];
#pragma unroll
        for (int e = 0; e < 8; ++e) {
          const int R = m0 + tk * 8 + e;
          float2 ps = *(const float2*)(PS + (size_t)R * 8 + 4);
          float rstd = rsqrtf((ps.x + ps.y) * (1.f / 256.f) + EPSF);
          y[e] = Cs[(tk * 8 + e) * CP + 64 + cl] * rstd;
        }
        uint4 a; a.x = pack2(y[0], y[1]); a.y = pack2(y[2], y[3]); a.z = pack2(y[4], y[5]); a.w = pack2(y[6], y[7]);
        *(uint4*)(drow + tk * 8) = a;
      }
    }
  }
}

template <int EPI, int PROBE = 0>
DI void gemm_phase(const P& p, const u16* __restrict__ A, const u16* __restrict__ Bt, int K, int mt, int ntn, int band,
                           const EpiArgs& ea, char* smem) {
  const int tid = otid(), lane = tid & 63, w = tid >> 6, wm = w >> 1, wn = w & 1, r = lane & 31, h = lane >> 5;
  u16* As = (u16*)smem;
  u16* Bs = As + 2 * 9216;
  float* Cs = (float*)smem;
  const int total = mt * ntn;
  const int mper = mt >> 3;
  const int nk = K >> 6;
  const int lrow = tid >> 3, lkc = (tid & 7) * 8;
  for (int t = blockIdx.x; t < total; t += gridDim.x) {
    const int xcd = t & 7, L = t >> 3;
    const int bandsz = band * ntn;
    const int bi = L / bandsz, rr = L - bi * bandsz;
    const int full = (ntn >> 3) * (band * 8);
    int mi_, ni_;
    if (rr < full) { int ch = rr / (band * 8); int wv = rr - ch * (band * 8); mi_ = wv % band; ni_ = ch * 8 + wv / band; }
    else { int r2 = rr - full; mi_ = r2 % band; ni_ = (ntn >> 3) * 8 + r2 / band; }
    const int mtile = xcd * mper + bi * band + mi_;
    const int ntile = ni_;
    constexpr bool AFF = (EPI == EPI_EVEN_IN || EPI == EPI_ODD_IN || EPI == EPI_RELU2);
    float* rsb = (float*)(smem + 73728);
    if (AFF && tid < 128) {
      const float* ps = (const float*)(p.ws + OFF_PSN) + (size_t)(mtile * 128 + tid) * 8;
      float4 p0 = *(const float4*)ps, p1 = *(const float4*)(ps + 4);
      rsb[tid] = rsqrtf((p0.x + p0.y + p0.z + p0.w + p1.x + p1.y + p1.z + p1.w) * (1.f / 1024.f) + EPSF);
    }
    const u16* Ag = A + (size_t)(mtile * 128 + lrow) * K + lkc;
    const u16* Bg = Bt + (size_t)(ntile * 128 + lrow) * K + lkc;
    f32x16 acc[2][2];
#pragma unroll
    for (int a = 0; a < 2; ++a)
#pragma unroll
      for (int c = 0; c < 2; ++c)
#pragma unroll
        for (int i = 0; i < 16; ++i) acc[a][c][i] = 0.f;
    uint4 ra0_0, ra0_1, ra0_2, ra0_3, rb0_0, rb0_1, rb0_2, rb0_3, ra1_0, ra1_1, ra1_2, ra1_3, rb1_0, rb1_1, rb1_2, rb1_3;
#define G_LD1(S, i, kt_) ra##S##_##i = *(const uint4*)(Ag + (size_t)(32 * i) * K + (kt_) * 64); rb##S##_##i = *(const uint4*)(Bg + (size_t)(32 * i) * K + (kt_) * 64);
#define G_LOAD(S, kt_) { G_LD1(S, 0, kt_) G_LD1(S, 1, kt_) G_LD1(S, 2, kt_) G_LD1(S, 3, kt_) }
#define L_ST1(S, i, buf_) *(uint4*)(As + (buf_) * 9216 + (lrow + 32 * i) * 72 + lkc) = ra##S##_##i; *(uint4*)(Bs + (buf_) * 9216 + (lrow + 32 * i) * 72 + lkc) = rb##S##_##i;
#define L_STORE(S, buf_) { L_ST1(S, 0, buf_) L_ST1(S, 1, buf_) L_ST1(S, 2, buf_) L_ST1(S, 3, buf_) }
#define G_COMPUTE(buf_) { \
      const u16* as = As + (buf_) * 9216 + (wm * 64 + r) * 72 + h * 8; \
      const u16* bs = Bs + (buf_) * 9216 + (wn * 64 + r) * 72 + h * 8; \
      _Pragma("unroll") for (int kk = 0; kk < 4; ++kk) { \
        bf16x8 a0 = *(const bf16x8*)(as + kk * 16), a1 = *(const bf16x8*)(as + 32 * 72 + kk * 16); \
        bf16x8 b0 = *(const bf16x8*)(bs + kk * 16), b1 = *(const bf16x8*)(bs + 32 * 72 + kk * 16); \
        acc[0][0] = MFMA32(a0, b0, acc[0][0]); acc[0][1] = MFMA32(a0, b1, acc[0][1]); \
        acc[1][0] = MFMA32(a1, b0, acc[1][0]); acc[1][1] = MFMA32(a1, b1, acc[1][1]); } }
#define LDFRAG(P_, kk) P_##a0 = *(const bf16x8*)(as_ + (kk) * 16); P_##a1 = *(const bf16x8*)(as_ + 32 * 72 + (kk) * 16); \
                       P_##b0 = *(const bf16x8*)(bs_ + (kk) * 16); P_##b1 = *(const bf16x8*)(bs_ + 32 * 72 + (kk) * 16);
#define MFMA4(P_) acc[0][0] = MFMA32(P_##a0, P_##b0, acc[0][0]); acc[0][1] = MFMA32(P_##a0, P_##b1, acc[0][1]); \
                  acc[1][0] = MFMA32(P_##a1, P_##b0, acc[1][0]); acc[1][1] = MFMA32(P_##a1, P_##b1, acc[1][1]);
#define G_PIPE(buf_, SNEXT, nbuf_, dost_) { \
      const u16* as_ = As + (buf_) * 9216 + (wm * 64 + r) * 72 + h * 8; \
      const u16* bs_ = Bs + (buf_) * 9216 + (wn * 64 + r) * 72 + h * 8; \
      bf16x8 f_a0, f_a1, f_b0, f_b1, g_a0, g_a1, g_b0, g_b1; \
      LDFRAG(f_, 0) \
      LDFRAG(g_, 1) \
      __builtin_amdgcn_sched_barrier(0); \
      MFMA4(f_) if (dost_) { L_ST1(SNEXT, 0, nbuf_) } \
      __builtin_amdgcn_sched_barrier(0); \
      LDFRAG(f_, 2) \
      MFMA4(g_) if (dost_) { L_ST1(SNEXT, 1, nbuf_) } \
      __builtin_amdgcn_sched_barrier(0); \
      LDFRAG(g_, 3) \
      MFMA4(f_) if (dost_) { L_ST1(SNEXT, 2, nbuf_) } \
      __builtin_amdgcn_sched_barrier(0); \
      MFMA4(g_) if (dost_) { L_ST1(SNEXT, 3, nbuf_) } }
#define G_COMPUTE_NOLDS() { \
      _Pragma("unroll") for (int kk = 0; kk < 4; ++kk) { \
        acc[0][0] = MFMA32(pa0, pb0, acc[0][0]); acc[0][1] = MFMA32(pa0, pb1, acc[0][1]); \
        acc[1][0] = MFMA32(pa1, pb0, acc[1][0]); acc[1][1] = MFMA32(pa1, pb1, acc[1][1]); } }
    bf16x8 pa0 = *(const bf16x8*)(As + r * 72 + h * 8), pa1 = *(const bf16x8*)(As + (32 + r) * 72 + h * 8);
    bf16x8 pb0 = *(const bf16x8*)(Bs + r * 72 + h * 8), pb1 = *(const bf16x8*)(Bs + (32 + r) * 72 + h * 8);
    (void)pa0; (void)pa1; (void)pb0; (void)pb1;
    G_LOAD(0, 0);
    G_LOAD(1, 1);
    L_STORE(0, 0);
    __syncthreads();
#pragma unroll 4
    for (int kt = 0; kt + 4 <= nk; kt += 2) {
      G_LOAD(0, kt + 2);
      { G_PIPE(0, 1, 1, true) }
      __syncthreads();
      G_LOAD(1, kt + 3);
      { G_PIPE(1, 0, 0, true) }
      __syncthreads();
    }
    { G_PIPE(0, 1, 1, true) }
    __syncthreads();
    { G_PIPE(1, 0, 0, false) }
    __syncthreads();
    if (AFF) {
      const int mrow_ = (mtile * 128 >= NLAT) ? 16 : ((mtile * 128) >> 11);
#pragma unroll
      for (int c = 0; c < 2; ++c) {
        const float swc = ea.sw[(size_t)mrow_ * ea.sw_stride + ntile * 128 + wn * 64 + c * 32 + r];
#pragma unroll
        for (int a = 0; a < 2; ++a)
#pragma unroll
          for (int i = 0; i < 16; ++i) {
            const int row = wm * 64 + a * 32 + (i & 3) + 8 * (i >> 2) + 4 * h;
            Cs[row * CP + wn * 64 + c * 32 + r] = acc[a][c][i] * rsb[row] + swc;
          }
      }
    } else {
#pragma unroll
      for (int a = 0; a < 2; ++a)
#pragma unroll
        for (int c = 0; c < 2; ++c)
#pragma unroll
          for (int i = 0; i < 16; ++i)
            Cs[(wm * 64 + a * 32 + (i & 3) + 8 * (i >> 2) + 4 * h) * CP + wn * 64 + c * 32 + r] = acc[a][c][i];
    }
    __syncthreads();
    epilogue<EPI>(p, ea, Cs, mtile, ntile);
    __syncthreads();
  }
}

template <int DQK, bool NA>
DI void attn_phase(const u16* __restrict__ Q, const u16* __restrict__ Kb, const u16* __restrict__ Vt, int HQ, int HK,
                           float scale, u16* __restrict__ mix, int coloff, bool do_ctx, const float* __restrict__ rpb, char* smem) {
  constexpr int KP = DQK + 8;
  constexpr int NKK = DQK / 16;
  constexpr int KCH = DQK / 32;
  const int tid = otid(), lane = tid & 63, w = tid >> 6, r = lane & 31, h = lane >> 5;
  constexpr int STG = 64 * KP * 2 + 64 * 72 * 2;
  float* rpbs = (float*)(smem + 2 * STG);
  const int grp_heads = HQ / HK;
  const int nlat = 16 * HK * grp_heads * 16;
  const int total = nlat + (do_ctx ? 16 * HK * grp_heads * 2 : 0);
  const float sl2 = scale * LOG2E;
  for (int u = blockIdx.x; u < total; u += gridDim.x) {
    const bool lat = u < nlat;
    const int v_ = lat ? u : u - nlat;
    const int nq_ = lat ? 16 : 2;
    const int upg = grp_heads * nq_;
    const int xcd = v_ & 7, L = v_ >> 3;
    const int grp = (L / upg) * 8 + xcd, wi = L % upg;
    const int b = grp / HK, hk = grp % HK;
    const int hq = hk * grp_heads + wi / nq_, qb = wi % nq_;
    const int qpos0 = lat ? 256 + 128 * qb : 128 * qb;
    int ntiles = lat ? 36 : 4;
    int rs0 = 0, rw = 0, rsw = 0;
    if (NA && lat) {
      int r0 = 2 * qb;
      rs0 = min(max(r0 - 4, 0), 24);
      int rs1 = min(max(r0 + 1 - 4, 0), 24);
      ntiles = 4 + (rs1 + 8 - rs0);
      rw = r0 + (w >> 1);
      rsw = min(max(rw - 4, 0), 24);
    }
    const int qpos = qpos0 + w * 32 + r;
    bf16x8 qf[NKK];
    {
      const u16* qp = Q + (((size_t)b * HQ + hq) * SP + qpos) * DQK + 8 * h;
#pragma unroll
      for (int kk = 0; kk < NKK; ++kk) qf[kk] = *(const bf16x8*)(qp + 16 * kk);
    }
    f32x16 o0, o1;
#pragma unroll
    for (int i = 0; i < 16; ++i) { o0[i] = 0.f; o1[i] = 0.f; }
    float m = -1e30f, l = 0.f;
    const u16* kbase = Kb + ((size_t)b * HK + hk) * SP * DQK;
    const u16* vbase = Vt + ((size_t)b * HK + hk) * 64 * SP;
    uint4 rk0, rk1, rk2 = make_uint4(0, 0, 0, 0), rv0, rv1;
#define KPOS_OF(i) ((NA && lat && (i) >= 4) ? 256 + 64 * (rs0 + (i) - 4) : 64 * (i))
#define ATT_GLOAD(kp) do { \
      rk0 = *(const uint4*)(kbase + (size_t)(kp) * DQK + tid * 8); \
      rk1 = *(const uint4*)(kbase + (size_t)(kp) * DQK + (tid + 256) * 8); \
      if (KCH > 2) rk2 = *(const uint4*)(kbase + (size_t)(kp) * DQK + (tid + 512) * 8); \
      rv0 = *(const uint4*)(vbase + (size_t)(tid >> 3) * SP + (kp) + (tid & 7) * 8); \
      rv1 = *(const uint4*)(vbase + (size_t)((tid >> 3) + 32) * SP + (kp) + (tid & 7) * 8); } while (0)
#define ATT_LSTORE(buf_) do { u16* Ks_ = (u16*)(smem + (buf_) * STG); u16* Vs_ = (u16*)(smem + (buf_) * STG + 64 * KP * 2); \
      { int c = tid; *(uint4*)(Ks_ + (c / (DQK / 8)) * KP + (c % (DQK / 8)) * 8) = rk0; } \
      { int c = tid + 256; *(uint4*)(Ks_ + (c / (DQK / 8)) * KP + (c % (DQK / 8)) * 8) = rk1; } \
      if (KCH > 2) { int c = tid + 512; *(uint4*)(Ks_ + (c / (DQK / 8)) * KP + (c % (DQK / 8)) * 8) = rk2; } \
      *(uint4*)(Vs_ + (tid >> 3) * 72 + (tid & 7) * 8) = rv0; \
      *(uint4*)(Vs_ + ((tid >> 3) + 32) * 72 + (tid & 7) * 8) = rv1; } while (0)
    { const int kp0 = KPOS_OF(0); ATT_GLOAD(kp0); }
    __syncthreads();
    ATT_LSTORE(0);
    if (NA) { for (int q = tid; q < 465; q += NTHR) rpbs[q] = rpb[hq * 465 + q]; }
    if (ntiles > 1) { const int kp1 = KPOS_OF(1); ATT_GLOAD(kp1); }
    __syncthreads();
    for (int ti = 0; ti < ntiles; ++ti) {
      if (ti + 1 < ntiles) ATT_LSTORE((ti + 1) & 1);
      if (ti + 2 < ntiles) { const int kp2 = KPOS_OF(ti + 2); ATT_GLOAD(kp2); }
      const u16* Ks = (const u16*)(smem + (ti & 1) * STG);
      const u16* Vs = (const u16*)(smem + (ti & 1) * STG + 64 * KP * 2);
      bool active = true;
      int jrow = 0;
      if (NA && lat && ti >= 4) { jrow = rs0 + ti - 4; active = (jrow >= rsw) && (jrow < rsw + 8); }
      if (active) {
        f32x16 s0, s1;
#pragma unroll
        for (int i = 0; i < 16; ++i) { s0[i] = 0.f; s1[i] = 0.f; }
#pragma unroll
        for (int kk = 0; kk < NKK; ++kk) {
          bf16x8 k0 = *(const bf16x8*)(Ks + r * KP + 16 * kk + 8 * h);
          bf16x8 k1 = *(const bf16x8*)(Ks + (32 + r) * KP + 16 * kk + 8 * h);
          s0 = MFMA32(k0, qf[kk], s0);
          s1 = MFMA32(k1, qf[kk], s1);
        }
        if (NA && lat && ti >= 4) {
          const int qc = (w & 1) * 32 + r;
          const int cs = min(max(qc - 8, 0), 48);
          const float* brow = rpbs + (jrow - rw + 7) * 31 + (15 - qc);
#pragma unroll
          for (int i = 0; i < 16; ++i) {
            int kc0 = (i & 3) + 8 * (i >> 2) + 4 * h, kc1 = kc0 + 32;
            bool v0 = (kc0 >= cs) && (kc0 < cs + 16), v1 = (kc1 >= cs) && (kc1 < cs + 16);
            float b0 = v0 ? brow[kc0] : 0.f, b1 = v1 ? brow[kc1] : 0.f;
            s0[i] = v0 ? (s0[i] * sl2 + b0 * LOG2E) : -1e30f;
            s1[i] = v1 ? (s1[i] * sl2 + b1 * LOG2E) : -1e30f;
          }
        }
        const float sc = (NA && lat && ti >= 4) ? 1.f : sl2;
        float tm = s0[0];
#pragma unroll
        for (int i = 1; i < 16; ++i) tm = fmaxf(tm, s0[i]);
#pragma unroll
        for (int i = 0; i < 16; ++i) tm = fmaxf(tm, s1[i]);
        tm = fmaxf(tm, __shfl_xor(tm, 32)) * sc;
        if (__any(tm > m + 8.f)) {
          const float mn = fmaxf(m, tm);
          const float alpha = __builtin_amdgcn_exp2f(m - mn);
          m = mn;
          l *= alpha;
#pragma unroll
          for (int i = 0; i < 16; ++i) { o0[i] *= alpha; o1[i] *= alpha; }
        }
        float ps = 0.f;
#pragma unroll
        for (int i = 0; i < 16; ++i) {
          s0[i] = __builtin_amdgcn_exp2f(__builtin_fmaf(s0[i], sc, -m)); ps += s0[i];
          s1[i] = __builtin_amdgcn_exp2f(__builtin_fmaf(s1[i], sc, -m)); ps += s1[i];
        }
        l += ps;
#pragma unroll
        for (int kt = 0; kt < 2; ++kt) {
#pragma unroll
          for (int sp = 0; sp < 2; ++sp) {
            u32x4 pu;
            pu[0] = pack2(kt ? s1[8 * sp + 0] : s0[8 * sp + 0], kt ? s1[8 * sp + 1] : s0[8 * sp + 1]);
            pu[1] = pack2(kt ? s1[8 * sp + 2] : s0[8 * sp + 2], kt ? s1[8 * sp + 3] : s0[8 * sp + 3]);
            pu[2] = pack2(kt ? s1[8 * sp + 4] : s0[8 * sp + 4], kt ? s1[8 * sp + 5] : s0[8 * sp + 5]);
            pu[3] = pack2(kt ? s1[8 * sp + 6] : s0[8 * sp + 6], kt ? s1[8 * sp + 7] : s0[8 * sp + 7]);
            const bf16x8 pfv = __builtin_bit_cast(bf16x8, pu);
            const int ko = 32 * kt + 16 * sp + 4 * h;
            const uint2 a0 = *(const uint2*)(Vs + r * 72 + ko), a1 = *(const uint2*)(Vs + r * 72 + ko + 8);
            const uint2 c0 = *(const uint2*)(Vs + (32 + r) * 72 + ko), c1 = *(const uint2*)(Vs + (32 + r) * 72 + ko + 8);
            u32x4 vau, vbu;
            vau[0] = a0.x; vau[1] = a0.y; vau[2] = a1.x; vau[3] = a1.y;
            vbu[0] = c0.x; vbu[1] = c0.y; vbu[2] = c1.x; vbu[3] = c1.y;
            const bf16x8 vav = __builtin_bit_cast(bf16x8, vau), vbv = __builtin_bit_cast(bf16x8, vbu);
            o0 = MFMA32(vav, pfv, o0);
            o1 = MFMA32(vbv, pfv, o1);
          }
        }
      }
      __syncthreads();
    }
    l += __shfl_xor(l, 32);
    const float inv = 1.f / l;
    const int R = tok_row(b, qpos);
    u16* op = mix + (size_t)R * 1024 + coloff + hq * 64 + 4 * h;
#pragma unroll
    for (int g4 = 0; g4 < 4; ++g4) {
      uint2 a, c;
      a.x = pack2(o0[4 * g4] * inv, o0[4 * g4 + 1] * inv); a.y = pack2(o0[4 * g4 + 2] * inv, o0[4 * g4 + 3] * inv);
      c.x = pack2(o1[4 * g4] * inv, o1[4 * g4 + 1] * inv); c.y = pack2(o1[4 * g4 + 2] * inv, o1[4 * g4 + 3] * inv);
      *(uint2*)(op + 8 * g4) = a;
      *(uint2*)(op + 32 + 8 * g4) = c;
    }
  }
  __syncthreads();
}

DI void s5_bfrags(const float* __restrict__ SBB, int tbase, int lane, bf16x8* bfrag) {
  const int col = lane & 15, fq = lane >> 4;
#pragma unroll
  for (int nt = 0; nt < 8; ++nt) {
    const float* src = SBB + (size_t)(tbase + 16 * (nt & 3) + col) * 32 + (nt >> 2) * 16 + 8 * (fq & 1);
    float4 t0 = *(const float4*)src, t1 = *(const float4*)(src + 4);
    u32x4 cu;
    cu[0] = pack2(t0.x, t0.y); cu[1] = pack2(t0.z, t0.w); cu[2] = pack2(t1.x, t1.y); cu[3] = pack2(t1.z, t1.w);
    bfrag[nt] = __builtin_bit_cast(bf16x8, cu);
  }
}
DI void s5_bu16(const float* __restrict__ urow, int lane, const bf16x8* bfrag, float* Bus) {
  const int col = lane & 15, fq = lane >> 4;
  float4 u0 = *(const float4*)(urow + 8 * (fq & 1)), u1 = *(const float4*)(urow + 8 * (fq & 1) + 4);
  float uv[8] = {u0.x, u0.y, u0.z, u0.w, u1.x, u1.y, u1.z, u1.w};
  u32x4 au;
#pragma unroll
  for (int q = 0; q < 4; ++q) {
    float h0 = bf2f(f2bf(uv[2 * q])), h1 = bf2f(f2bf(uv[2 * q + 1]));
    float x0 = fq < 2 ? uv[2 * q] : uv[2 * q] - h0;
    float x1 = fq < 2 ? uv[2 * q + 1] : uv[2 * q + 1] - h1;
    au[q] = pack2(x0, x1);
  }
  const bf16x8 af = __builtin_bit_cast(bf16x8, au);
  f32x4 a0 = {0.f, 0.f, 0.f, 0.f}, a1 = a0, a2 = a0, a3 = a0, a4 = a0, a5 = a0, a6 = a0, a7 = a0;
  a0 = MFMA16(af, bfrag[0], a0); a1 = MFMA16(af, bfrag[1], a1); a2 = MFMA16(af, bfrag[2], a2); a3 = MFMA16(af, bfrag[3], a3);
  a4 = MFMA16(af, bfrag[4], a4); a5 = MFMA16(af, bfrag[5], a5); a6 = MFMA16(af, bfrag[6], a6); a7 = MFMA16(af, bfrag[7], a7);
  asm volatile("s_nop 15\n\ts_nop 15" : "+v"(a0), "+v"(a1), "+v"(a2), "+v"(a3), "+v"(a4), "+v"(a5), "+v"(a6), "+v"(a7));
#define BUS_ST(nt_, A_) _Pragma("unroll") for (int jj = 0; jj < 4; ++jj) Bus[(4 * fq + jj) * 132 + 16 * (nt_) + col] = A_[jj];
  BUS_ST(0, a0) BUS_ST(1, a1) BUS_ST(2, a2) BUS_ST(3, a3) BUS_ST(4, a4) BUS_ST(5, a5) BUS_ST(6, a6) BUS_ST(7, a7)
}

DI void s5_pass1(const P& p, int j, char* smem) {
  const int tid = otid(), lane = tid & 63, w = tid >> 6;
  const float* U = (const float*)(p.ws + E_U);
  float2* E = (float2*)(p.ws + E_E);
  const float2* SA = (const float2*)(p.ws + OFF_SA);
  const float* SBB = (const float*)(p.ws + OFF_SBB);
  float* Bus = (float*)(smem + w * 16896);
  for (int item = blockIdx.x; item < 4608; item += gridDim.x) {
    const int unit = item * 4 + w;
    const int c = unit % 36; const int t1 = unit / 36; const int dir = t1 & 1; const int t2 = t1 >> 1; const int g = t2 & 15; const int b = t2 >> 4;
    const int tbase = ((j * 2 + dir) * 16 + g) * 64;
    const float2 a = SA[tbase + lane];
    bf16x8 bfrag[8];
    s5_bfrags(SBB, tbase, lane, bfrag);
    float hr = 0.f, hi = 0.f;
#pragma unroll 1
    for (int sub = 0; sub < 4; ++sub) {
      const int tau = 64 * c + sub * 16 + (lane & 15);
      const int pos = dir ? (tau < 256 ? 255 - tau : 2559 - tau) : tau;
      s5_bu16(U + (size_t)tok_row(b, pos) * 256 + 16 * g, lane, bfrag, Bus);
      asm volatile("s_waitcnt lgkmcnt(0)" ::: "memory");
#pragma unroll
      for (int k16 = 0; k16 < 16; ++k16) {
        const float bur = Bus[k16 * 132 + lane], bui = Bus[k16 * 132 + 64 + lane];
        const float nr = a.x * hr - a.y * hi + bur;
        const float ni = a.x * hi + a.y * hr + bui;
        hr = nr; hi = ni;
      }
      asm volatile("s_waitcnt lgkmcnt(0)" ::: "memory");
    }
    E[((((size_t)b * 16 + g) * 2 + dir) * 36 + c) * 64 + lane] = make_float2(hr, hi);
  }
  __syncthreads();
}

DI void s5_pass2(const P& p, int j, char* smem) {
  const int tid = otid(), lane = tid & 63, w = tid >> 6;
  const float* U = (const float*)(p.ws + E_U);
  const float2* E = (const float2*)(p.ws + E_E);
  const float2* SA = (const float2*)(p.ws + OFF_SA);
  const float2* SAL = (const float2*)(p.ws + OFF_SAL);
  const float* SBB = (const float*)(p.ws + OFF_SBB);
  u16* YG = (u16*)(p.ws + E_YG);
  char* wb = smem + w * 16896;
  float* Bus = (float*)wb; u16* Hs = (u16*)(wb + 8448); float* ys = (float*)(wb + 8448 + 4352);
  const int pcol = lane & 15, fq = lane >> 4;
  for (int item = blockIdx.x; item < 4608; item += gridDim.x) {
    const int Pc = item % 36; const int t1 = item / 36; const int gp = t1 & 7; const int b = t1 >> 3;
    const int g = gp * 2 + (w >> 1), dir = w & 1;
    const int tbase = ((j * 2 + dir) * 16 + g) * 64;
    const float2 a = SA[tbase + lane], aL = SAL[tbase + lane];
    bf16x8 bfrag[8];
    s5_bfrags(SBB, tbase, lane, bfrag);
    const int c = dir ? (Pc < 4 ? 3 - Pc : 39 - Pc) : Pc;
    float hr = 0.f, hi = 0.f;
    {
      const float2* Eb = E + ((((size_t)b * 16 + g) * 2 + dir) * 36) * 64 + lane;
      for (int cc = 0; cc < c; ++cc) {
        float2 e = Eb[(size_t)cc * 64];
        float nr = aL.x * hr - aL.y * hi + e.x;
        float ni = aL.x * hi + aL.y * hr + e.y;
        hr = nr; hi = ni;
      }
    }
    bf16x8 cf[4];
    {
      const size_t cbase = ((size_t)((j * 2 + dir) * 16 + g) * 16 + pcol) * 64;
#pragma unroll
      for (int ks = 0; ks < 4; ++ks) {
        const float* src = (ks < 2 ? p.c_re : p.c_im) + cbase + 32 * (ks & 1) + 8 * fq;
        float4 t0 = *(const float4*)src, t1_ = *(const float4*)(src + 4);
        const float sg = ks < 2 ? 1.f : -1.f;
        u32x4 cu;
        cu[0] = pack2(sg * t0.x, sg * t0.y); cu[1] = pack2(sg * t0.z, sg * t0.w);
        cu[2] = pack2(sg * t1_.x, sg * t1_.y); cu[3] = pack2(sg * t1_.z, sg * t1_.w);
        cf[ks] = __builtin_bit_cast(bf16x8, cu);
      }
    }
    const float dsk = p.ssm_d[j * 256 + 16 * g + pcol];
#pragma unroll 1
    for (int sub = 0; sub < 4; ++sub) {
      {
        const int k = sub * 16 + (lane & 15);
        const int lt = dir ? 63 - k : k;
        s5_bu16(U + (size_t)tok_row(b, 64 * Pc + lt) * 256 + 16 * g, lane, bfrag, Bus);
      }
      asm volatile("s_waitcnt lgkmcnt(0)" ::: "memory");
#pragma unroll
      for (int k16 = 0; k16 < 16; ++k16) {
        const float bur = Bus[k16 * 132 + lane], bui = Bus[k16 * 132 + 64 + lane];
        const float nr = a.x * hr - a.y * hi + bur;
        const float ni = a.x * hi + a.y * hr + bui;
        hr = nr; hi = ni;
        Hs[k16 * 136 + lane] = f2bf(hr);
        Hs[k16 * 136 + 64 + lane] = f2bf(hi);
      }
      asm volatile("s_waitcnt lgkmcnt(0)" ::: "memory");
      f32x4 acc = {0.f, 0.f, 0.f, 0.f};
#pragma unroll
      for (int ks = 0; ks < 4; ++ks) {
        bf16x8 af = *(const bf16x8*)(Hs + pcol * 136 + 32 * ks + 8 * fq);
        acc = MFMA16(af, cf[ks], acc);
      }
      asm volatile("s_nop 15\n\ts_nop 15" : "+v"(acc));
#pragma unroll
      for (int jj = 0; jj < 4; ++jj) {
        const int k = sub * 16 + 4 * fq + jj;
        const int lt = dir ? 63 - k : k;
        float yv = acc[jj];
        if (dir == 0) yv += dsk * U[(size_t)tok_row(b, 64 * Pc + lt) * 256 + 16 * g + pcol];
        ys[lt * 16 + pcol] = yv;
      }
      asm volatile("s_waitcnt lgkmcnt(0)" ::: "memory");
    }
    __syncthreads();
#pragma unroll
    for (int i = 0; i < 8; ++i) {
      int idx = tid + 256 * i; int gi = idx >> 10, lt = (idx >> 4) & 63, pp = idx & 15;
      const char* w0 = smem + (2 * gi) * 16896; const char* w1 = smem + (2 * gi + 1) * 16896;
      const int gg = gp * 2 + gi;
      float y = ((const float*)(w0 + 12800))[lt * 16 + pp] + ((const float*)(w1 + 12800))[lt * 16 + pp];
      float t = 0.7978845608028654f * (y + 0.044715f * y * y * y);
      float ge = 0.5f * y * (1.f + tanhf(t));
      int row = tok_row(b, 64 * Pc + lt);
      YG[(size_t)row * 256 + 16 * gg + pp] = f2bf(ge);
    }
    __syncthreads();
  }
}

__global__ void __launch_bounds__(NTHR, 2) fwd_megakernel(P p) {
  __shared__ __attribute__((aligned(16))) char smem[SMEM_BYTES];
  cg::grid_group grid = cg::this_grid();
  char* ws = p.ws;
  float* XC = (float*)(ws + OFF_XC);
  u16* ABUF = (u16*)(ws + OFF_ABUF);
  const float* modv = (const float*)(ws + OFF_MODV);

  __shared__ uint4 xb_words;
  unsigned* barw = (unsigned*)(ws + OFF_BAR);
  if (threadIdx.x == 0) xb_words = make_uint4(0u, 0u, 0u, 0u);
  if (blockIdx.x == 0) { for (int i = threadIdx.x; i < XCD_BAR_WORDS; i += NTHR) barw[i] = 0u; }
  for (int dd = 0; dd < DUPN(3); ++dd) prologue(p, smem);
  grid.sync();
  XcdBarrier xb = xcd_barrier_post(barw, (volatile LAS unsigned*)&xb_words);

  float* PSN = (float*)(ws + OFF_PSN);
  float* SW1 = (float*)(ws + OFF_SW1);
  float* SW2 = (float*)(ws + OFF_SW2);
  norm_phase(p.x, p.ctx, p.g_norm1, modv, 0, 1, NTOK, ABUF, PSN);
  for (int l = 0; l < 4; ++l) {
    const int jj = l >> 1;
    if (l & 1) sw_items(modv + (size_t)l * 17 * 6144, (const u16*)(ws + OFF_OIN + jj * SZ_OIN), 2432, SW1 + (size_t)l * 17 * 2560, 2560);
    else sw_items(modv + (size_t)l * 17 * 6144, (const u16*)(ws + OFF_EIN + jj * SZ_EIN), 1536, SW1 + (size_t)l * 17 * 2560, 2560);
  }
  GSYNC();

  for (int layer = 0; layer < 4; ++layer) {
    const int j = layer >> 1;
    const bool need_ctx = layer < 3;
    const float* xs_lat = layer == 0 ? p.x : p.out;
    const float* xs_ctx = layer == 0 ? p.ctx : XC;
    const float* modl = modv + (size_t)layer * 17 * 6144;
    EpiArgs ea{};
    ea.j = j; ea.gate = modl + 2 * 1024; ea.src_lat = xs_lat; ea.src_ctx = xs_ctx; ea.dst_lat = p.out; ea.dst_ctx = XC;
    ea.sw = SW1 + (size_t)layer * 17 * 2560; ea.sw_stride = 2560;
    ea.ng = p.g_norm2 + layer * 1024; ea.nscale = modl + 4 * 1024; ea.xg_dst = (u16*)(ws + OFF_XG2);

    if ((layer & 1) == 0) {
      for (int dd = 0; dd < DUPN(0); ++dd) gemm_phase<EPI_EVEN_IN>(p, ABUF, (const u16*)(ws + OFF_EIN + j * SZ_EIN), 1024, 288, 12, 6, ea, smem);
      GSYNC();
      for (int dd = 0; dd < DUPN(2); ++dd) s5_pass1(p, j, smem);
      for (int dd = 0; dd < DUPN(1); ++dd) attn_phase<64, false>((const u16*)(ws + E_Q), (const u16*)(ws + E_K), (const u16*)(ws + E_VT), 12, 4, 0.125f, ABUF, 0, need_ctx, nullptr, smem);
      ff_convert(p, layer, smem);
      GSYNC();
      for (int dd = 0; dd < DUPN(2); ++dd) s5_pass2(p, j, smem);
      sw_items(modl + 3 * 1024, (const u16*)(ws + OFF_FF1), 4096, SW2 + (size_t)layer * 17 * 4096, 4096);
      GSYNC();
      for (int dd = 0; dd < DUPN(0); ++dd) gemm_phase<EPI_GLU>(p, (const u16*)(ws + E_YG), (const u16*)(ws + OFF_GLU + j * SZ_GLU), 256, 288, 2, 6, ea, smem);
      GSYNC();
    } else {
      for (int dd = 0; dd < DUPN(0); ++dd) gemm_phase<EPI_ODD_IN>(p, ABUF, (const u16*)(ws + OFF_OIN + j * SZ_OIN), 1024, 288, 19, 6, ea, smem);
      GSYNC();
      for (int dd = 0; dd < DUPN(0); ++dd) gemm_phase<EPI_UQ>(p, (const u16*)(ws + O_CQ), (const u16*)(ws + OFF_UQ + j * SZ_UQ), 512, 288, 8, 6, ea, smem);
      for (int dd = 0; dd < DUPN(0); ++dd) gemm_phase<EPI_UKV>(p, (const u16*)(ws + O_CKV), (const u16*)(ws + OFF_UKV + j * SZ_UKV), 256, 288, 8, 6, ea, smem);
      for (int dd = 0; dd < DUPN(1); ++dd) attn_phase<64, true>((const u16*)(ws + O_NQ), (const u16*)(ws + O_NK), (const u16*)(ws + O_NVT), 8, 8, 0.125f, ABUF, 512, need_ctx,
                           p.rpb + (size_t)j * 8 * 465, smem);
      ff_convert(p, layer, smem);
      GSYNC();
      for (int dd = 0; dd < DUPN(1); ++dd) attn_phase<96, false>((const u16*)(ws + O_MQ), (const u16*)(ws + O_MK), (const u16*)(ws + O_MVT), 8, 8, 0.10206207261596577f, ABUF, 0,
                            need_ctx, nullptr, smem);
      sw_items(modl + 3 * 1024, (const u16*)(ws + OFF_FF1), 4096, SW2 + (size_t)layer * 17 * 4096, 4096);
      GSYNC();
    }
    const int mt = need_ctx ? 288 : 256;
    const int band = need_ctx ? 6 : 8;
    gemm_phase<EPI_RESID>(p, ABUF, (const u16*)(ws + ((layer & 1) ? OFF_OOUT : OFF_EOUT) + j * SZ_SQ), 1024, mt, 8, band, ea, smem);
    GSYNC();
    ea.sw = SW2 + (size_t)layer * 17 * 4096; ea.sw_stride = 4096;
    for (int dd = 0; dd < DUPN(0); ++dd) gemm_phase<EPI_RELU2>(p, (const u16*)(ws + OFF_XG2), (const u16*)(ws + OFF_FF1), 1024, mt, 32, band, ea, smem);
    GSYNC();
    ea.gate = modl + 5 * 1024; ea.src_lat = p.out; ea.src_ctx = XC;
    ea.ng = layer < 3 ? p.g_norm1 + (layer + 1) * 1024 : nullptr; ea.xg_dst = ABUF;
    ea.nscale = modv + (size_t)(layer + 1) * 17 * 6144 + 1 * 1024;
    gemm_phase<EPI_RESID>(p, (const u16*)(ws + OFF_H), (const u16*)(ws + OFF_FF2), 4096, mt, 8, band, ea, smem);
    GSYNC();
  }
  if (GPROBE >= 0) {
    EpiArgs ed{}; ed.j = 0;
    gemm_phase<EPI_RELU2, (GPROBE < 0 ? 0 : GPROBE)>(p, (const u16*)(ws + OFF_ABUF), (const u16*)(ws + OFF_FF1), 1024, 288, 32, 6, ed, smem);
  }
}

extern "C" void kernel_launch(void* const* d_in, const int* in_sizes, int n_in, void* d_out, int out_size, void* d_ws, size_t ws_size,
                              hipStream_t stream) {
  static int grid_blocks = 0;
  if (!grid_blocks) {
    int dev = 0, cus = 0, per_cu = 0;
    hipGetDevice(&dev);
    hipDeviceGetAttribute(&cus, hipDeviceAttributeMultiprocessorCount, dev);
    hipOccupancyMaxActiveBlocksPerMultiprocessor(&per_cu, fwd_megakernel, NTHR, 0);
    if (per_cu > 2) per_cu = 2;
    if (per_cu < 1) per_cu = 1;
    grid_blocks = cus * per_cu;
    grid_blocks &= ~7;
  }
  P p{};
  const float** f = (const float**)&p;
  for (int i = 0; i < 35; ++i) f[i] = (const float*)d_in[i];
  p.out = (float*)d_out;
  p.ws = (char*)d_ws;
  void* args[] = {&p};
  hipError_t e = hipLaunchCooperativeKernel((void*)fwd_megakernel, dim3(grid_blocks), dim3(NTHR), args, 0, stream);
  if (e != hipSuccess) fprintf(stderr, "cooperative launch failed: %s (grid %d)\n", hipGetErrorString(e), grid_blocks);
}
```
